# Optimizing an MI355X kernel written in HIP

```python
import jax, jax.numpy as jnp
from jax import lax
import numpy as np

D_MODEL = 1024
BATCH = 8
SEQ = 8192
DEPTH = 1
DEC_BATCH = 128
DEC_SEQ = 8
PAST_LEN = 8192
PAGE_SIZE = 128

WINDOWS = (128, 512, 2048)
DILATIONS = (1, 4, 16)
N_GROUPS = 3
HEADS_PER_GROUP = 4
HEAD_DIM = D_MODEL // 16
GROUP_WIDTH = HEADS_PER_GROUP * HEAD_DIM
ATTN_WIDTH = N_GROUPS * GROUP_WIDTH
CONV_CH = D_MODEL - ATTN_WIDTH
MIX_WIDTH = ATTN_WIDTH + CONV_CH
CONV_K = 3
IN_WIDTH = 3 * ATTN_WIDTH + 3 * CONV_CH
SPLITS = (ATTN_WIDTH, 2 * ATTN_WIDTH, 3 * ATTN_WIDTH,
          3 * ATTN_WIDTH + CONV_CH, 3 * ATTN_WIDTH + 2 * CONV_CH)
D_FF = 4 * D_MODEL
QBLOCK = 128
EPS = 1e-6

kernel_name = "hybrid_dilated_swa_shortconv_decode_step"


def rmsnorm(x, g):
    xf = x.astype(jnp.float32)
    y = xf * lax.rsqrt(jnp.mean(xf * xf, axis=-1, keepdims=True) + EPS)
    return (y * g.astype(jnp.float32)).astype(x.dtype)


def dilated_group_attn(q, k_ctx, v_ctx, q_idx, dilation, n_keys):
    idx = q_idx[:, None] - dilation * jnp.arange(n_keys, dtype=jnp.int32)[None, :]
    valid = idx >= 0
    idx = jnp.maximum(idx, 0)
    k_g = jnp.take(k_ctx, idx, axis=1)
    v_g = jnp.take(v_ctx, idx, axis=1)
    s = jnp.einsum("bthd,btkhd->bhtk", q, k_g).astype(jnp.float32) * (HEAD_DIM ** -0.5)
    s = jnp.where(valid[None, None], s, -jnp.inf)
    lse = jax.nn.logsumexp(s, axis=-1)
    p = jnp.exp(s - lse[..., None])
    o = jnp.einsum("bhtk,btkhd->bthd", p.astype(v_ctx.dtype), v_g)
    return o, jnp.transpose(lse, (0, 2, 1))


def attend_groups(q, k_ctxs, v_ctxs, q_idxs):
    b, t = q.shape[0], q.shape[1]
    outs, lses = [], []
    for g in range(N_GROUPS):
        o, lse = dilated_group_attn(q[:, :, g], k_ctxs[g], v_ctxs[g], q_idxs[g],
                                    DILATIONS[g], WINDOWS[g] // DILATIONS[g] + 1)
        outs.append(o)
        lses.append(lse)
    o = jnp.stack(outs, axis=2)
    lse = jnp.stack(lses, axis=2)
    alpha = jax.nn.softmax(lse, axis=2)
    return (o * alpha[..., None].astype(o.dtype)).reshape(b, t, ATTN_WIDTH)


def mixing_sublayer(xn, kv_pasts, conv_past, w_in, conv_w, w_out, blocked):
    b, t, _ = xn.shape
    proj = jnp.einsum("btd,de->bte", xn, w_in)
    q, k, v, gate_b, gate_c, h = jnp.split(proj, SPLITS, axis=-1)
    q = q.reshape(b, t, N_GROUPS, HEADS_PER_GROUP, HEAD_DIM)
    k = k.reshape(b, t, N_GROUPS, HEADS_PER_GROUP, HEAD_DIM)
    v = v.reshape(b, t, N_GROUPS, HEADS_PER_GROUP, HEAD_DIM)

    k_ctxs, v_ctxs, q_idxs, new_kv = [], [], [], []
    for g in range(N_GROUPS):
        kv_new = jnp.stack([k[:, :, g], v[:, :, g]], axis=2)
        if kv_pasts is None:
            ctx = kv_new
            base = 0
        else:
            ctx = jnp.concatenate([kv_pasts[g], kv_new], axis=1)
            base = kv_pasts[g].shape[1]
        n_ctx = ctx.shape[1]
        k_ctxs.append(ctx[:, :, 0])
        v_ctxs.append(ctx[:, :, 1])
        q_idxs.append(base + jnp.arange(t, dtype=jnp.int32))
        new_kv.append(ctx[:, n_ctx - min(WINDOWS[g], n_ctx):])

    if blocked:
        def block_fn(start):
            qb = lax.dynamic_slice_in_dim(q, start, QBLOCK, axis=1)
            idx = start + jnp.arange(QBLOCK, dtype=jnp.int32)
            return attend_groups(qb, k_ctxs, v_ctxs, [idx] * N_GROUPS)
        starts = jnp.arange(t // QBLOCK, dtype=jnp.int32) * QBLOCK
        attn = lax.map(block_fn, starts)
        attn = jnp.transpose(attn, (1, 0, 2, 3)).reshape(b, t, ATTN_WIDTH)
    else:
        attn = attend_groups(q, k_ctxs, v_ctxs, q_idxs)

    u = gate_c * h
    past = jnp.zeros((b, CONV_K - 1, CONV_CH), u.dtype) if conv_past is None else conv_past
    cctx = jnp.concatenate([past, u], axis=1)
    y = conv_w[0] * cctx[:, 0:t]
    for j in range(1, CONV_K):
        y = y + conv_w[j] * cctx[:, j:j + t]
    conv_out = gate_b * y
    new_conv = cctx[:, cctx.shape[1] - (CONV_K - 1):]

    mixed = jnp.concatenate([attn, conv_out], axis=-1)
    return jnp.einsum("bte,ed->btd", mixed, w_out), new_kv, new_conv


def squared_relu_mlp(x, w_up, w_down):
    hdn = jnp.square(jax.nn.relu(jnp.einsum("btd,df->btf", x, w_up)))
    return jnp.einsum("btf,fd->btd", hdn, w_down)


def run_trunk(x, kv_caches, conv_state, norm_attn_g, w_in, conv_w, w_out,
              norm_mlp_g, w_up, w_down, norm_final_g, blocked):
    new_kv = [[], [], []]
    new_conv = []
    for l in range(DEPTH):
        kv_pasts = None if kv_caches is None else [c[l] for c in kv_caches]
        cpast = None if conv_state is None else conv_state[l]
        mix, kv_l, conv_l = mixing_sublayer(rmsnorm(x, norm_attn_g[l]), kv_pasts, cpast,
                                            w_in[l], conv_w[l], w_out[l], blocked)
        x = x + mix
        x = x + squared_relu_mlp(rmsnorm(x, norm_mlp_g[l]), w_up[l], w_down[l])
        for g in range(N_GROUPS):
            new_kv[g].append(kv_l[g])
        new_conv.append(conv_l)
    y = rmsnorm(x, norm_final_g)
    return (y, jnp.stack(new_kv[0]), jnp.stack(new_kv[1]), jnp.stack(new_kv[2]), jnp.stack(new_conv))


def setup_inputs(seed: int = 0) -> dict:
    key = jax.random.key(seed)
    ks = jax.random.split(key, 16)
    f32 = jnp.float32
    lens = [min(w, PAST_LEN) for w in WINDOWS]
    return {
        "x_prompt": jax.random.normal(ks[0], (BATCH, SEQ, D_MODEL), f32),
        "x_sample": jax.random.normal(ks[1], (DEC_BATCH, DEC_SEQ, D_MODEL), f32),
        "cache_kv_w128": jax.random.normal(ks[2], (DEPTH, DEC_BATCH, lens[0], 2, HEADS_PER_GROUP, HEAD_DIM), f32),
        "cache_kv_w512": jax.random.normal(ks[3], (DEPTH, DEC_BATCH, lens[1], 2, HEADS_PER_GROUP, HEAD_DIM), f32),
        "cache_kv_w2048": jax.random.normal(ks[4], (DEPTH, DEC_BATCH, lens[2], 2, HEADS_PER_GROUP, HEAD_DIM), f32),
        "state_conv": 0.5 * jax.random.normal(ks[5], (DEPTH, DEC_BATCH, CONV_K - 1, CONV_CH), f32),
        "norm_attn_g": 1.0 + 0.02 * jax.random.normal(ks[6], (DEPTH, D_MODEL), f32),
        "w_in": jax.random.normal(ks[7], (DEPTH, D_MODEL, IN_WIDTH), f32) * D_MODEL ** -0.5,
        "conv_w": jax.random.normal(ks[8], (DEPTH, CONV_K, CONV_CH), f32) * CONV_K ** -0.5,
        "w_out": jax.random.normal(ks[9], (DEPTH, MIX_WIDTH, D_MODEL), f32) * MIX_WIDTH ** -0.5,
        "norm_mlp_g": 1.0 + 0.02 * jax.random.normal(ks[10], (DEPTH, D_MODEL), f32),
        "w_up": jax.random.normal(ks[11], (DEPTH, D_MODEL, D_FF), f32) * D_MODEL ** -0.5,
        "w_down": jax.random.normal(ks[12], (DEPTH, D_FF, D_MODEL), f32) * D_FF ** -0.5,
        "norm_final_g": 1.0 + 0.02 * jax.random.normal(ks[13], (D_MODEL,), f32),
    }


def reference(x_prompt, x_sample, cache_kv_w128, cache_kv_w512, cache_kv_w2048, state_conv,
              norm_attn_g, w_in, conv_w, w_out, norm_mlp_g, w_up, w_down, norm_final_g):
    y_prompt, kv128_p, kv512_p, kv2048_p, conv_p = run_trunk(
        x_prompt, None, None, norm_attn_g, w_in, conv_w, w_out,
        norm_mlp_g, w_up, w_down, norm_final_g, True)
    y_sample, kv128_s, kv512_s, kv2048_s, conv_s = run_trunk(
        x_sample, [cache_kv_w128, cache_kv_w512, cache_kv_w2048], state_conv,
        norm_attn_g, w_in, conv_w, w_out, norm_mlp_g, w_up, w_down, norm_final_g, False)
    return (y_prompt, y_sample, kv128_p, kv512_p, kv2048_p, conv_p,
            kv128_s, kv512_s, kv2048_s, conv_s)
```

```cpp
#include <hip/hip_runtime.h>
#include <cstdio>
#include <cstdint>
#include <hip/hip_cooperative_groups.h>
namespace cg = cooperative_groups;
namespace pg8 {
#define PG8_LAS __attribute__((address_space(3)))
typedef unsigned short bf16_t;
typedef short bf16x8 __attribute__((ext_vector_type(8)));
typedef float f32x4 __attribute__((ext_vector_type(4)));
typedef unsigned u32x4 __attribute__((ext_vector_type(4)));
constexpr int BM = 256, BK = 64, HALF = 128, HTB = HALF * BK * 2  , STAGE_BYTES = 8 * HTB, NXCD = 8, WGM = 8;

__host__ __device__ __forceinline__ int lds_byte(int r, int c) { const int st = (r >> 4) * 2 + (c >> 5), rr = r & 15, cc = c & 31, ob = rr * 64 + cc * 2; return st * 1024 + (ob ^ (((ob >> 9) & 1) << 5)); }
__host__ __device__ __forceinline__ void stage_rc(int b, int& R, int& C) { const int st = b / 1024, sb = b % 1024, swz = sb ^ (((sb >> 9) & 1) << 5); R = (st >> 1) * 16 + swz / 64; C = (st & 1) * 32 + (swz % 64) / 2; }
__host__ __device__ __forceinline__ int perm32(int rho) { const int n = rho >> 4, i = rho & 15; return 8 * (i >> 2) + 4 * n + (i & 3); }

struct Unit { int pm, pn; };
struct Gemm { const bf16_t* A; const bf16_t* Bt; int M, N, K; };

struct StaticOrder {
    int nM, nN, nwg, G, c;
    __host__ __device__ void init(int M, int N, int G_, int c_) { nM = M / BM; nN = N / BM; nwg = nM * nN; G = G_; c = c_; }
    __host__ __device__ bool next(int i, Unit& u) const {
        const long L = (long)i * G + c; if (L >= nwg) return false;
        int wgid = (int)L; { const int q = nwg / NXCD, r = nwg % NXCD, xcd = wgid % NXCD, off = wgid / NXCD; wgid = (xcd < r ? xcd * (q + 1) : r * (q + 1) + (xcd - r) * q) + off; }
        const int nig = WGM * nN, gid = wgid / nig, fm = gid * WGM, gsz = (nM - fm) < WGM ? (nM - fm) : WGM;
        u.pm = fm + ((wgid % nig) % gsz); u.pn = (wgid % nig) / gsz; return true;
    }
    __device__ __forceinline__ void a_ready(const Unit&) const {}
    __device__ __forceinline__ void done(const Unit&) const {}
};

__device__ __forceinline__ unsigned cvt_pk_bf16(float lo, float hi) { unsigned r; asm volatile("v_cvt_pk_bf16_f32 %0, %1, %2" : "=v"(r) : "v"(lo), "v"(hi)); return r; }
typedef float f32x2 __attribute__((ext_vector_type(2)));
template <int MODE> struct EpiScaleBf16 {
    static constexpr bool PERM = true, AFTER_DRAIN = false;
    bf16_t* O; int ldc; const float* rs; float eps;
    __device__ __forceinline__ void operator()(const f32x4 (&acc)[2][2][4][2], const Unit& u, int wr, int wc, int fr, int fq) const {
        const int row0 = u.pm * BM + wr * 64 + fr; const int col0 = u.pn * BM + wc * 32 + 8 * fq;
#pragma unroll
        for (int ai = 0; ai < 2; ++ai)
#pragma unroll
            for (int m = 0; m < 4; ++m) { const int row = row0 + ai * HALF + m * 16; float sc;
                if (MODE == 0) sc = rs[row];
                else { const f32x4* p = (const f32x4*)(rs + (size_t)row * 16); const f32x4 a = p[0], b = p[1], c = p[2], d = p[3];
                    const float ss = ((a[0] + a[1]) + (a[2] + a[3])) + ((b[0] + b[1]) + (b[2] + b[3])) + ((c[0] + c[1]) + (c[2] + c[3])) + ((d[0] + d[1]) + (d[2] + d[3]));
                    sc = __builtin_amdgcn_rsqf(ss * (1.0f / 1024.0f) + eps); }
                bf16_t* rowp = O + (size_t)row * ldc + col0;
#pragma unroll
                for (int bj = 0; bj < 2; ++bj) { f32x4 v0 = acc[ai][bj][m][0] * sc, v1 = acc[ai][bj][m][1] * sc;
                    if (MODE == 1) {
#pragma unroll
                        for (int e = 0; e < 4; ++e) { const float x0 = fmaxf(v0[e], 0.f), x1 = fmaxf(v1[e], 0.f); v0[e] = x0 * x0; v1[e] = x1 * x1; } }
                    u32x4 w; w.x = cvt_pk_bf16(v0[0], v0[1]); w.y = cvt_pk_bf16(v0[2], v0[3]); w.z = cvt_pk_bf16(v1[0], v1[1]); w.w = cvt_pk_bf16(v1[2], v1[3]);
                    *(u32x4*)(rowp + bj * HALF) = w; } }
    }
};
template <bool WB> struct EpiRes {
    static constexpr bool PERM = false, AFTER_DRAIN = false;
    const float* base0; const float* base1; int split_row; float* out; bf16_t* xb; float* stats;
    __device__ __forceinline__ void operator()(const f32x4 (&acc)[2][2][4][2], const Unit& u, int wr, int wc, int fr, int fq) const {
        typedef unsigned u32x2v __attribute__((ext_vector_type(2)));
        const int col0 = u.pn * BM + wc * 32 + 4 * fq; const int rt0 = u.pm * BM;
        const float* base = rt0 < split_row ? base0 : base1; const int rsub = rt0 < split_row ? 0 : split_row;
#pragma unroll
        for (int ai = 0; ai < 2; ++ai)
#pragma unroll
            for (int m = 0; m < 4; ++m) { const int r = rt0 + ai * HALF + wr * 64 + m * 16 + fr; const size_t off = (size_t)r * 1024 + col0, offb = (size_t)(r - rsub) * 1024 + col0; float ss = 0.f;
#pragma unroll
                for (int bj = 0; bj < 2; ++bj)
#pragma unroll
                    for (int n = 0; n < 2; ++n) { const f32x4 bs = *(const f32x4*)(base + offb + bj * HALF + n * 16); const f32x4 o = bs + acc[ai][bj][m][n];
                        *(f32x4*)(out + off + bj * HALF + n * 16) = o;
                        if (WB) { u32x2v w; w.x = cvt_pk_bf16(o[0], o[1]); w.y = cvt_pk_bf16(o[2], o[3]); *(u32x2v*)(xb + off + bj * HALF + n * 16) = w; }
                        ss += (o[0] * o[0] + o[1] * o[1]) + (o[2] * o[2] + o[3] * o[3]); }
                ss += __shfl_xor(ss, 16); ss += __shfl_xor(ss, 32);
                if (fq == 0) stats[(size_t)r * 16 + u.pn * 4 + wc] = ss;
                if (m & 1) asm volatile("" ::: "memory"); }
    }
};

template <class Epi, class Sched, bool ALIGN_EPI = false, bool SP2 = false>
__device__ __forceinline__ void gemm_phase(PG8_LAS unsigned char* lds, const Gemm g, const Sched& S, const Epi& E) {
    const int tid = threadIdx.x, wid = __builtin_amdgcn_readfirstlane(tid >> 6), lane = tid & 63, wr = wid >> 2, wc = wid & 3, fr = lane & 15, fq = lane >> 4;
    const int K = g.K, nt = K / BK;
    unsigned voffA[2], voffB[2];
#pragma unroll
    for (int i = 0; i < 2; ++i) { int R, C; stage_rc(tid * 16 + i * 8192, R, C); const int Rb = Epi::PERM ? ((R & ~31) + perm32(R & 31)) : R;
        voffA[i] = (unsigned)(R * K + C) * 2u; voffB[i] = (unsigned)(Rb * K + C) * 2u; }
    const size_t kstep = (size_t)(BK * 2);
    const size_t hstep = (size_t)HALF * K * 2;
    const size_t tstep = 2 * hstep;
    const unsigned ldsw = (unsigned)wid * 1024u;
    const int aoff = lds_byte(wr * 64 + fr, fq * 8), boff = lds_byte(wc * 32 + fr, fq * 8);
#define PG8_SA(b, h) (((b) * 2 + (h)) * HTB)
#define PG8_SB(b, h) ((4 + (b) * 2 + (h)) * HTB)
#define PG8_STAGE(bufoff, gbase, voff) do { _Pragma("unroll") for (int _i = 0; _i < 2; ++_i) \
        __builtin_amdgcn_global_load_lds((const unsigned*)((const char*)(gbase) + (voff)[_i]), (PG8_LAS unsigned*)(lds + (bufoff) + ldsw + _i * 8192), 16, 0, 0); } while (0)
#define PG8_LDA(dst, b, h) do { _Pragma("unroll") for (int m = 0; m < 4; ++m) _Pragma("unroll") for (int k = 0; k < 2; ++k) dst[m][k] = *(const PG8_LAS bf16x8*)(lds + PG8_SA(b, h) + aoff + m * 2048 + k * 1024); } while (0)
#define PG8_LDB(dst, b, h) do { _Pragma("unroll") for (int n = 0; n < 2; ++n) _Pragma("unroll") for (int k = 0; k < 2; ++k) dst[n][k] = *(const PG8_LAS bf16x8*)(lds + PG8_SB(b, h) + boff + n * 2048 + k * 1024); } while (0)
#define PG8_MMA(ai, bj, At, Bt) do { __builtin_amdgcn_s_setprio(1); _Pragma("unroll") for (int m = 0; m < 4; ++m) _Pragma("unroll") for (int n = 0; n < 2; ++n) _Pragma("unroll") for (int k = 0; k < 2; ++k) \
        acc[ai][bj][m][n] = __builtin_amdgcn_mfma_f32_16x16x32_bf16(Bt[n][k], At[m][k], acc[ai][bj][m][n], 0, 0, 0); __builtin_amdgcn_s_setprio(0); } while (0)
#define PG8_WAIT_V(n) asm volatile("s_waitcnt vmcnt(" #n ")" ::: "memory")
#define PG8_WAIT_L(n) asm volatile("s_waitcnt lgkmcnt(" #n ")" ::: "memory")
#define PG8_BAR __builtin_amdgcn_s_barrier()
#define PG8_SCHED __builtin_amdgcn_sched_barrier(0)
    Unit cur, nxt; int ui = 0;
    if (!S.next(0, cur)) return;
    f32x4 acc[2][2][4][2];
#pragma unroll
    for (int a = 0; a < 2; ++a)
#pragma unroll
        for (int b = 0; b < 2; ++b)
#pragma unroll
            for (int m = 0; m < 4; ++m)
#pragma unroll
                for (int n = 0; n < 2; ++n) acc[a][b][m][n] = (f32x4){0.f, 0.f, 0.f, 0.f};
    bf16x8 At[4][2], B0[2][2], B1[2][2];
    const char* cA = (const char*)g.A + (size_t)cur.pm * tstep; const char* cB = (const char*)g.Bt + (size_t)cur.pn * tstep;
    S.a_ready(cur);
    if constexpr (SP2) {
        PG8_STAGE(PG8_SB(0, 0), cB, voffB); PG8_STAGE(PG8_SB(0, 1), cB + hstep, voffB); PG8_STAGE(PG8_SA(0, 0), cA, voffA); PG8_STAGE(PG8_SA(0, 1), cA + hstep, voffA);
        if (wr == 1) PG8_BAR;
        PG8_WAIT_V(2); PG8_BAR;
        PG8_STAGE(PG8_SB(1, 0), cB + kstep, voffB); PG8_STAGE(PG8_SA(1, 0), cA + kstep, voffA); PG8_STAGE(PG8_SB(1, 1), cB + hstep + kstep, voffB);
        PG8_WAIT_V(6); PG8_BAR;
    } else {
        PG8_STAGE(PG8_SB(0, 0), cB, voffB); PG8_STAGE(PG8_SA(0, 0), cA, voffA); PG8_STAGE(PG8_SB(0, 1), cB + hstep, voffB); PG8_STAGE(PG8_SA(0, 1), cA + hstep, voffA);
        if (wr == 1) PG8_BAR;
        PG8_WAIT_V(4); PG8_BAR;
        PG8_STAGE(PG8_SB(1, 0), cB + kstep, voffB); PG8_STAGE(PG8_SA(1, 0), cA + kstep, voffA); PG8_STAGE(PG8_SB(1, 1), cB + hstep + kstep, voffB);
        PG8_WAIT_V(6); PG8_BAR;
    }
    for (;;) {
        const bool has_next = S.next(ui + 1, nxt);
        const char* nA = has_next ? (const char*)g.A + (size_t)nxt.pm * tstep : cA; const char* nB = has_next ? (const char*)g.Bt + (size_t)nxt.pn * tstep : cB;
        for (int t = 0; t < nt; t += 2) {
            const bool last = (t == nt - 2);
            const char* a1 = cA + (size_t)(t + 1) * kstep;
            const char* a2 = last ? nA : cA + (size_t)(t + 2) * kstep; const char* b2 = last ? nB : cB + (size_t)(t + 2) * kstep;
            const char* a3 = a2 + kstep; const char* b3 = b2 + kstep;
            if (last && has_next) S.a_ready(nxt);
            if constexpr (SP2) {
            PG8_LDB(B0, 0, 0); PG8_LDB(B1, 0, 1); PG8_SCHED; PG8_LDA(At, 0, 0); PG8_STAGE(PG8_SA(1, 1), a1 + hstep, voffA);
            PG8_WAIT_V(8); PG8_WAIT_L(0); PG8_BAR; PG8_MMA(0, 0, At, B0); PG8_MMA(0, 1, At, B1); PG8_BAR; PG8_SCHED;
            PG8_LDA(At, 0, 1); PG8_STAGE(PG8_SB(0, 0), b2, voffB); PG8_STAGE(PG8_SB(0, 1), b2 + hstep, voffB); PG8_STAGE(PG8_SA(0, 0), a2, voffA);
            PG8_WAIT_V(8); PG8_WAIT_L(0); PG8_BAR; PG8_MMA(1, 0, At, B0); PG8_MMA(1, 1, At, B1); PG8_BAR; PG8_SCHED;
            PG8_LDB(B0, 1, 0); PG8_LDB(B1, 1, 1); PG8_SCHED; PG8_LDA(At, 1, 0); PG8_STAGE(PG8_SA(0, 1), a2 + hstep, voffA);
            PG8_WAIT_V(8); PG8_WAIT_L(0); PG8_BAR; PG8_MMA(0, 0, At, B0); PG8_MMA(0, 1, At, B1); PG8_BAR; PG8_SCHED;
            PG8_LDA(At, 1, 1); PG8_STAGE(PG8_SB(1, 0), b3, voffB); PG8_STAGE(PG8_SB(1, 1), b3 + hstep, voffB); PG8_STAGE(PG8_SA(1, 0), a3, voffA);
            PG8_WAIT_V(8); PG8_WAIT_L(0); PG8_BAR; PG8_MMA(1, 0, At, B0); PG8_MMA(1, 1, At, B1); PG8_BAR; PG8_SCHED;
            } else {
            PG8_LDB(B0, 0, 0); PG8_SCHED; PG8_LDA(At, 0, 0); PG8_STAGE(PG8_SA(1, 1), a1 + hstep, voffA);
            PG8_WAIT_L(8); PG8_BAR; PG8_WAIT_L(0); PG8_MMA(0, 0, At, B0); PG8_BAR; PG8_SCHED;
            PG8_LDB(B1, 0, 1); PG8_STAGE(PG8_SB(0, 0), b2, voffB);
            PG8_BAR; PG8_WAIT_L(0); PG8_MMA(0, 1, At, B1); PG8_BAR;
            PG8_LDA(At, 0, 1); PG8_STAGE(PG8_SA(0, 0), a2, voffA);
            PG8_BAR; PG8_WAIT_L(0); PG8_MMA(1, 0, At, B0); PG8_BAR; PG8_SCHED;
            PG8_STAGE(PG8_SB(0, 1), b2 + hstep, voffB);
            PG8_WAIT_V(6); PG8_BAR; PG8_MMA(1, 1, At, B1); PG8_BAR;
            PG8_LDB(B0, 1, 0); PG8_SCHED; PG8_LDA(At, 1, 0); PG8_STAGE(PG8_SA(0, 1), a2 + hstep, voffA);
            PG8_WAIT_L(8); PG8_BAR; PG8_WAIT_L(0); PG8_MMA(0, 0, At, B0); PG8_BAR; PG8_SCHED;
            PG8_LDB(B1, 1, 1); PG8_STAGE(PG8_SB(1, 0), b3, voffB);
            PG8_BAR; PG8_WAIT_L(0); PG8_MMA(0, 1, At, B1); PG8_BAR;
            PG8_LDA(At, 1, 1); PG8_STAGE(PG8_SA(1, 0), a3, voffA);
            PG8_BAR; PG8_WAIT_L(0); PG8_MMA(1, 0, At, B0); PG8_BAR; PG8_SCHED;
            PG8_STAGE(PG8_SB(1, 1), b3 + hstep, voffB);
            PG8_WAIT_V(6); PG8_BAR; PG8_MMA(1, 1, At, B1); PG8_BAR;
            }
        }
        if constexpr (ALIGN_EPI) { if (wr == 0) PG8_BAR; }
        if constexpr (!Epi::AFTER_DRAIN) { E(acc, cur, wr, wc, fr, fq); S.done(cur); }
        if (!has_next) break;
#pragma unroll
        for (int a = 0; a < 2; ++a)
#pragma unroll
            for (int b = 0; b < 2; ++b)
#pragma unroll
                for (int m = 0; m < 4; ++m)
#pragma unroll
                    for (int n = 0; n < 2; ++n) acc[a][b][m][n] = (f32x4){0.f, 0.f, 0.f, 0.f};
        cur = nxt; cA = nA; cB = nB; ++ui;
        if constexpr (ALIGN_EPI) { if (wr == 1) PG8_BAR; }
    }
    PG8_WAIT_V(0);
    if constexpr (!ALIGN_EPI) { if (wr == 0) PG8_BAR; }
    PG8_BAR;
    if constexpr (Epi::AFTER_DRAIN) { E.fused(acc, cur, wr, wc, fr, fq, lds, wid, lane); S.done(cur); }
#undef PG8_SA
#undef PG8_SB
#undef PG8_STAGE
#undef PG8_LDA
#undef PG8_LDB
#undef PG8_MMA
#undef PG8_WAIT_V
#undef PG8_WAIT_L
#undef PG8_BAR
#undef PG8_SCHED
}
}
#ifndef PG8_SP2
#define PG8_SP2 true
#endif
#ifndef PG8_ALIGN
#define PG8_ALIGN true
#endif
#ifndef MK_N_LAUNCHES
#define MK_N_LAUNCHES 8
#endif

constexpr int D = 1024, FF = 4096, NIN = 3072;
constexpr int MP = 8 * 8192, MS = 128 * 8, M = MP + MS;
constexpr int TP = 8192;
constexpr float EPS = 1e-6f;
constexpr int NWAVES = 8;
#define GAS __attribute__((address_space(1)))
#define LAS __attribute__((address_space(3)))
typedef unsigned short bf16;
typedef unsigned v4u __attribute__((ext_vector_type(4)));
typedef unsigned v2u __attribute__((ext_vector_type(2)));
typedef float f32x4 __attribute__((ext_vector_type(4)));
typedef short bf16x8 __attribute__((ext_vector_type(8)));
typedef short s16x4 __attribute__((ext_vector_type(4)));
typedef float f32x16 __attribute__((ext_vector_type(16)));

constexpr size_t MiB = 1u << 20;
constexpr size_t WS_WIN = 0, WS_WOUT = 6 * MiB, WS_WUP = 8 * MiB, WS_WDN = 16 * MiB;
constexpr size_t WS_RSTD0 = 24 * MiB;
constexpr size_t WS_ST1 = 25 * MiB, WS_ST2 = 30 * MiB;
constexpr size_t WS_LSE = 35 * MiB;
constexpr size_t WS_XB = 40 * MiB;
constexpr size_t WS_PROJ = 172 * MiB;
constexpr size_t WS_MIX = 564 * MiB;
constexpr size_t WS_HB = 696 * MiB;
constexpr size_t WS_END = 1220 * MiB;
static_assert(WS_XB + (size_t)M * D * 2 <= WS_PROJ && WS_PROJ + (size_t)M * NIN * 2 <= WS_MIX && WS_MIX + (size_t)M * D * 2 <= WS_HB && WS_HB + (size_t)M * FF * 2 <= WS_END, "d_ws map");
static_assert(WS_ST1 + (size_t)M * 64 <= WS_ST2 && WS_ST2 + (size_t)M * 64 <= WS_LSE && WS_LSE + (size_t)M * 48 <= WS_XB, "d_ws map 2");

constexpr size_t O_Y = 0;
constexpr size_t O_KVP0 = (size_t)M * D;
constexpr size_t O_KVP1 = O_KVP0 + 8ull * 128 * 512;
constexpr size_t O_KVP2 = O_KVP1 + 8ull * 512 * 512;
constexpr size_t O_CVP = O_KVP2 + 8ull * 2048 * 512;
constexpr size_t O_KVS0 = O_CVP + 8ull * 2 * 256;
constexpr size_t O_KVS1 = O_KVS0 + 128ull * 128 * 512;
constexpr size_t O_KVS2 = O_KVS1 + 128ull * 512 * 512;
constexpr size_t O_CVS = O_KVS2 + 128ull * 2048 * 512;
constexpr size_t O_END = O_CVS + 128ull * 2 * 256;

constexpr int LDS_BYTES = 147456;

__device__ __forceinline__ unsigned f2bf(float f) { unsigned u = __builtin_bit_cast(unsigned, f); return (u + 0x7fffu + ((u >> 16) & 1u)) >> 16; }
__device__ __forceinline__ unsigned pk2(float lo, float hi) { return f2bf(lo) | (f2bf(hi) << 16); }
__device__ __forceinline__ float bflo(unsigned w) { return __builtin_bit_cast(float, w << 16); }
__device__ __forceinline__ float bfhi(unsigned w) { return __builtin_bit_cast(float, w & 0xffff0000u); }
__device__ __forceinline__ float wave_sum(float v) {
#pragma unroll
    for (int o = 1; o < 64; o <<= 1) v += __shfl_xor(v, o);
    return v;
}

__device__ __forceinline__ const float* pick3(int g, const float* a, const float* b, const float* c) { return g == 0 ? a : (g == 1 ? b : c); }
struct Frame {
    LAS unsigned char* lds;
    int tid, lane, wave, vcu, G;
    const float *xp, *xs, *c0, *c1, *c2, *sconv, *g_attn, *w_in, *conv_w, *w_out, *g_mlp, *w_up, *w_down, *g_fin;
    float* out;
    bf16 *Win_t, *Wout_t, *Wup_t, *Wdn_t, *XB, *PROJ, *MIX, *HB;
    float *RSTD0, *ST1, *ST2, *LSE;
};

__device__ __forceinline__ void p0_transpose_item(const float* W, const float* gk, int K, int N, bf16* WT, LAS float* scr, int item, int lane) {
    const int nblk = N / 32, kb = item / nblk, nb = item % nblk, k0 = 64 * kb, n0 = 32 * nb;
#pragma unroll 8
    for (int i = 0; i < 32; ++i) { const int kk = 2 * i + (lane >> 5); float v = W[(size_t)(k0 + kk) * N + n0 + (lane & 31)]; if (gk) v *= gk[k0 + kk]; scr[kk * 33 + (lane & 31)] = v; }
    asm volatile("s_waitcnt lgkmcnt(0)" ::: "memory");
    const int c = lane & 7;
#pragma unroll
    for (int j = 0; j < 4; ++j) { const int n = (lane >> 3) + 8 * j; const LAS float* s = scr + (8 * c) * 33 + n;
        v4u o; o.x = pk2(s[0 * 33], s[1 * 33]); o.y = pk2(s[2 * 33], s[3 * 33]); o.z = pk2(s[4 * 33], s[5 * 33]); o.w = pk2(s[6 * 33], s[7 * 33]);
        *(v4u*)(WT + (size_t)(n0 + n) * K + k0 + 8 * c) = o; }
    asm volatile("s_waitcnt lgkmcnt(0)" ::: "memory");
}
__device__ __forceinline__ void p0_prologue(Frame& F) {
    LAS float* scr = (LAS float*)(F.lds + F.wave * 16384);
    const int gw = F.vcu * NWAVES + F.wave, NGW = F.G * NWAVES;
    constexpr int I_IN = (D / 64) * (NIN / 32), I_O = (D / 64) * (D / 32), I_UP = (D / 64) * (FF / 32), I_DN = (FF / 64) * (D / 32);
    constexpr int NITEMS = I_IN + I_O + I_UP + I_DN;
    for (int it = gw; it < NITEMS; it += NGW) {
        int r = it;
        if (r < I_IN) { p0_transpose_item(F.w_in, F.g_attn, D, NIN, F.Win_t, scr, r, F.lane); continue; } r -= I_IN;
        if (r < I_O) { p0_transpose_item(F.w_out, nullptr, D, D, F.Wout_t, scr, r, F.lane); continue; } r -= I_O;
        if (r < I_UP) { p0_transpose_item(F.w_up, F.g_mlp, D, FF, F.Wup_t, scr, r, F.lane); continue; } r -= I_UP;
        p0_transpose_item(F.w_down, nullptr, FF, D, F.Wdn_t, scr, r, F.lane);
    }
    for (int m = gw; m < M; m += NGW) {
        const float* xrow = m < MP ? F.xp + (size_t)m * D : F.xs + (size_t)(m - MP) * D;
        const f32x4* xr = (const f32x4*)xrow + F.lane;
        f32x4 v[4]; float s = 0.f;
#pragma unroll
        for (int j = 0; j < 4; ++j) { v[j] = xr[64 * j]; s += (v[j].x * v[j].x + v[j].y * v[j].y) + (v[j].z * v[j].z + v[j].w * v[j].w); }
        s = wave_sum(s);
        v2u* o8 = (v2u*)(F.XB + (size_t)m * D) + F.lane;
#pragma unroll
        for (int j = 0; j < 4; ++j) { v2u w; w.x = pk2(v[j].x, v[j].y); w.y = pk2(v[j].z, v[j].w); o8[64 * j] = w; }
        if (F.lane == 0) F.RSTD0[m] = __builtin_amdgcn_rsqf(s * (1.0f / D) + EPS);
    }
}

namespace att {
constexpr int VP = 144;
constexpr float C2 = 0.125f * 1.4426950408889634f;
__device__ __forceinline__ int crow(int r, int hi) { return (r & 3) + 8 * (r >> 2) + 4 * hi; }
__device__ __forceinline__ s16x4 vtr(const LAS unsigned char* p) { return __builtin_bit_cast(s16x4, __builtin_amdgcn_ds_read_tr16_b64_v4i16((LAS s16x4*)p)); }
__device__ __forceinline__ unsigned cvtpk(float lo, float hi) { typedef float f2 __attribute__((ext_vector_type(2))); typedef __bf16 b2 __attribute__((ext_vector_type(2))); f2 v = {lo, hi}; b2 b = __builtin_convertvector(v, b2); return __builtin_bit_cast(unsigned, b); }

__device__ __forceinline__ void prompt_unit(const bf16* __restrict__ proj, bf16* __restrict__ mixed, float* __restrict__ lse, LAS unsigned char* lds, int b, int g, int h, int r, int c) {
    const int tid = threadIdx.x, lane = tid & 63, wid = __builtin_amdgcn_readfirstlane(tid >> 6), a = lane & 31, hi = lane >> 5;
    const int s = 2 * g, i0 = c * 256;
    const size_t rowb = (size_t)b * TP;
    const int colq = g * 256 + h * 64, colk = 768 + colq, colv = 1536 + colq;
    __syncthreads();
#pragma unroll
    for (int i = 0; i < 6; ++i) {
        const int id = tid + 512 * i, kk = id >> 3, ch = id & 7; int ii = i0 - 128 + kk; ii = ii < 0 ? 0 : ii;
        const v4u v = *(const v4u*)(proj + (rowb + ((size_t)ii << s) + r) * NIN + colv + ch * 8);
        *(LAS v4u*)(lds + kk * VP + ch * 16) = v;
    }
    const int qs = i0 + 32 * wid;
    bf16x8 qf[4];
    { const bf16* qp = proj + (rowb + ((size_t)(qs + a) << s) + r) * NIN + colq + hi * 8;
#pragma unroll
      for (int d0 = 0; d0 < 4; ++d0) qf[d0] = *(const bf16x8*)(qp + d0 * 16); }
    f32x16 S[5];
#pragma unroll
    for (int kb = 0; kb < 5; ++kb) {
        int ii = qs - 128 + 32 * kb + a; ii = ii < 0 ? 0 : ii;
        const bf16* kp = proj + (rowb + ((size_t)ii << s) + r) * NIN + colk + hi * 8;
        bf16x8 kf[4];
#pragma unroll
        for (int d0 = 0; d0 < 4; ++d0) kf[d0] = *(const bf16x8*)(kp + d0 * 16);
        f32x16 acc = {};
#pragma unroll
        for (int d0 = 0; d0 < 4; ++d0) acc = __builtin_amdgcn_mfma_f32_32x32x16_bf16(kf[d0], qf[d0], acc, 0, 0, 0);
        S[kb] = acc;
    }
    float mx = -INFINITY;
#pragma unroll
    for (int kb = 0; kb < 5; ++kb)
#pragma unroll
        for (int rr = 0; rr < 16; ++rr) { const int key = crow(rr, hi), ii = qs - 128 + 32 * kb + key;
            bool valid = ii >= 0; if (kb == 0) valid = valid && (key >= a); if (kb == 4) valid = valid && (key <= a);
            const float v = valid ? S[kb][rr] * C2 : -INFINITY; S[kb][rr] = v; mx = fmaxf(mx, v); }
    mx = fmaxf(mx, __shfl_xor(mx, 32));
    float l = 0.f;
#pragma unroll
    for (int kb = 0; kb < 5; ++kb)
#pragma unroll
        for (int rr = 0; rr < 16; ++rr) { const float p = __builtin_amdgcn_exp2f(S[kb][rr] - mx); S[kb][rr] = p; l += p; }
    l += __shfl_xor(l, 32);
    __syncthreads();
    f32x16 o[2]; o[0] = f32x16{}; o[1] = f32x16{};
    const LAS unsigned char* vbase = lds + (32 * wid + 4 * hi + ((lane & 15) >> 2)) * VP + (16 * ((lane >> 4) & 1) + 4 * (lane & 3)) * 2;
#pragma unroll
    for (int kb = 0; kb < 5; ++kb)
#pragma unroll
        for (int st = 0; st < 2; ++st) {
            v4u pw; pw.x = cvtpk(S[kb][8 * st + 0], S[kb][8 * st + 1]); pw.y = cvtpk(S[kb][8 * st + 2], S[kb][8 * st + 3]); pw.z = cvtpk(S[kb][8 * st + 4], S[kb][8 * st + 5]); pw.w = cvtpk(S[kb][8 * st + 6], S[kb][8 * st + 7]);
            const bf16x8 pa = __builtin_bit_cast(bf16x8, pw);
#pragma unroll
            for (int cc = 0; cc < 2; ++cc) {
                const s16x4 lo = vtr(vbase + (32 * kb + 16 * st) * VP + cc * 64), hh = vtr(vbase + (32 * kb + 16 * st + 8) * VP + cc * 64);
                const bf16x8 vf = (bf16x8){lo[0], lo[1], lo[2], lo[3], hh[0], hh[1], hh[2], hh[3]};
                o[cc] = __builtin_amdgcn_mfma_f32_32x32x16_bf16(pa, vf, o[cc], 0, 0, 0);
            }
        }
    const float linv = 1.0f / l;
#pragma unroll
    for (int rr = 0; rr < 16; ++rr) { const int q = crow(rr, hi); const float li = __shfl(linv, q);
        bf16* op = mixed + (rowb + ((size_t)(qs + q) << s) + r) * D + colq + a;
        op[0] = (bf16)f2bf(o[0][rr] * li); op[32] = (bf16)f2bf(o[1][rr] * li); }
    if (hi == 0) lse[(rowb + ((size_t)(qs + a) << s) + r) * 12 + g * 4 + h] = mx + __builtin_amdgcn_logf(l);
}

__device__ __forceinline__ f32x4 kv_fetch(const float* __restrict__ cache, const bf16* __restrict__ proj, int W, int b, int idx, int sel, int g, int h, int c) {
    if (idx >= W) { const v2u w = *(const v2u*)(proj + (size_t)(MP + b * 8 + (idx - W)) * NIN + 768 + sel * 768 + g * 256 + h * 64 + 4 * c); return (f32x4){bflo(w.x), bfhi(w.x), bflo(w.y), bfhi(w.y)}; }
    return *(const f32x4*)(cache + (((size_t)b * W + idx) * 2 + sel) * 256 + h * 64 + 4 * c);
}
__device__ __forceinline__ void sample_task(Frame& F, int task) {
    const int t = task & 7, h = (task >> 3) & 3, bg = task >> 5, g = bg % 3, b = bg / 3;
    const int lane = F.lane, rg = lane >> 4, c = lane & 15;
    const int W = 128 << (2 * g), d = 1 << (2 * g);
    const float* cache = pick3(g, F.c0, F.c1, F.c2);
    const size_t qrow = (size_t)MP + b * 8 + t;
    f32x4 q; { const v2u w = *(const v2u*)(F.PROJ + qrow * NIN + g * 256 + h * 64 + 4 * c); q = (f32x4){bflo(w.x), bfhi(w.x), bflo(w.y), bfhi(w.y)}; }
    float sc[33];
#pragma unroll
    for (int i0 = 0; i0 < 33; i0 += 11) {
        f32x4 kv[11];
#pragma unroll
        for (int i = 0; i < 11; ++i) { int j = 4 * (i0 + i) + rg; j = j > 128 ? 128 : j; kv[i] = kv_fetch(cache, F.PROJ, W, b, W + t - d * j, 0, g, h, c); }
#pragma unroll
        for (int i = 0; i < 11; ++i) { float p = (kv[i][0] * q[0] + kv[i][1] * q[1]) + (kv[i][2] * q[2] + kv[i][3] * q[3]);
            p += __shfl_xor(p, 1); p += __shfl_xor(p, 2); p += __shfl_xor(p, 4); p += __shfl_xor(p, 8);
            const int j = 4 * (i0 + i) + rg; sc[i0 + i] = j <= 128 ? p * C2 : -INFINITY; }
    }
    float mx = sc[0];
#pragma unroll
    for (int i = 1; i < 33; ++i) mx = fmaxf(mx, sc[i]);
    mx = fmaxf(mx, __shfl_xor(mx, 16)); mx = fmaxf(mx, __shfl_xor(mx, 32));
    float l = 0.f;
#pragma unroll
    for (int i = 0; i < 33; ++i) { sc[i] = __builtin_amdgcn_exp2f(sc[i] - mx); l += sc[i]; }
    l += __shfl_xor(l, 16); l += __shfl_xor(l, 32);
    f32x4 o = {0.f, 0.f, 0.f, 0.f};
#pragma unroll
    for (int i0 = 0; i0 < 33; i0 += 11) {
        f32x4 kv[11];
#pragma unroll
        for (int i = 0; i < 11; ++i) { int j = 4 * (i0 + i) + rg; j = j > 128 ? 128 : j; kv[i] = kv_fetch(cache, F.PROJ, W, b, W + t - d * j, 1, g, h, c); }
#pragma unroll
        for (int i = 0; i < 11; ++i) o += kv[i] * sc[i0 + i];
    }
#pragma unroll
    for (int e = 0; e < 4; ++e) { float v = o[e]; v += __shfl_xor(v, 16); v += __shfl_xor(v, 32); o[e] = v; }
    const float li = 1.0f / l;
    if (rg == 0) { v2u w; w.x = pk2(o[0] * li, o[1] * li); w.y = pk2(o[2] * li, o[3] * li); *(v2u*)(F.MIX + qrow * D + g * 256 + h * 64 + 4 * c) = w; }
    if (lane == 0) F.LSE[qrow * 12 + g * 4 + h] = mx + __builtin_amdgcn_logf(l);
}
}

__device__ __forceinline__ void unpack8(const v4u w, float (&f)[8]) { f[0] = bflo(w.x); f[1] = bfhi(w.x); f[2] = bflo(w.y); f[3] = bfhi(w.y); f[4] = bflo(w.z); f[5] = bfhi(w.z); f[6] = bflo(w.w); f[7] = bfhi(w.w); }
__device__ __forceinline__ void conv_u(const bf16* proj, size_t row, int ch, float (&u)[8]) {
    float cf[8], hf[8]; unpack8(*(const v4u*)(proj + row * NIN + 2560 + 8 * ch), cf); unpack8(*(const v4u*)(proj + row * NIN + 2816 + 8 * ch), hf);
#pragma unroll
    for (int e = 0; e < 8; ++e) u[e] = cf[e] * hf[e];
}
__device__ __forceinline__ void ld8f(const float* p, float (&u)[8]) { const f32x4 a = *(const f32x4*)p, b = *(const f32x4*)(p + 4); u[0] = a[0]; u[1] = a[1]; u[2] = a[2]; u[3] = a[3]; u[4] = b[0]; u[5] = b[1]; u[6] = b[2]; u[7] = b[3]; }

__device__ __forceinline__ void p2_mixers(Frame& F) {
    const int gt = F.vcu * (NWAVES * 64) + F.tid, NGT = F.G * NWAVES * 64;
    for (int u = F.vcu; u < 8 * 12 * 32; u += F.G) {
        const int sub = u & 31, bgh = u >> 5, h = bgh & 3, g = (bgh >> 2) % 3, b = bgh / 12;
        const int cpc = 32 >> (2 * g), r = sub / cpc, c = sub % cpc;
        att::prompt_unit(F.PROJ, F.MIX, F.LSE, F.lds, b, g, h, r, c);
    }
    for (int task = F.vcu * NWAVES + F.wave; task < 128 * 12 * 8; task += F.G * NWAVES) att::sample_task(F, task);
    for (int it = gt; it < M * 32; it += NGT) {
        const int row = it >> 5, ch = it & 31;
        int t, b; const bool smp = row >= MP; if (smp) { const int rs = row - MP; b = rs >> 3; t = rs & 7; } else { b = row >> 13; t = row & (TP - 1); }
        float u0[8], u1[8], u2[8], bg[8], w0[8], w1[8], w2[8];
        conv_u(F.PROJ, row, ch, u0);
        if (t >= 1) conv_u(F.PROJ, row - 1, ch, u1); else if (smp) ld8f(F.sconv + ((size_t)b * 2 + 1) * 256 + 8 * ch, u1); else {
#pragma unroll
            for (int e = 0; e < 8; ++e) u1[e] = 0.f; }
        if (t >= 2) conv_u(F.PROJ, row - 2, ch, u2); else if (smp) ld8f(F.sconv + ((size_t)b * 2 + t) * 256 + 8 * ch, u2); else {
#pragma unroll
            for (int e = 0; e < 8; ++e) u2[e] = 0.f; }
        unpack8(*(const v4u*)(F.PROJ + (size_t)row * NIN + 2304 + 8 * ch), bg);
        ld8f(F.conv_w + 8 * ch, w0); ld8f(F.conv_w + 256 + 8 * ch, w1); ld8f(F.conv_w + 512 + 8 * ch, w2);
        float y[8];
#pragma unroll
        for (int e = 0; e < 8; ++e) y[e] = bg[e] * (w0[e] * u2[e] + w1[e] * u1[e] + w2[e] * u0[e]);
        v4u o; o.x = pk2(y[0], y[1]); o.y = pk2(y[2], y[3]); o.z = pk2(y[4], y[5]); o.w = pk2(y[6], y[7]);
        *(v4u*)(F.MIX + (size_t)row * D + 768 + 8 * ch) = o;
    }
    for (int g = 0; g < 3; ++g) {
        const int W = 128 << (2 * g); float* dst = F.out + (g == 0 ? O_KVP0 : (g == 1 ? O_KVP1 : O_KVP2));
        for (int it = gt; it < 8 * W * 64; it += NGT) { const int ch = it & 31, sel = (it >> 5) & 1, br = it >> 6, rr = br % W, b = br / W;
            float f[8]; unpack8(*(const v4u*)(F.PROJ + ((size_t)b * TP + TP - W + rr) * NIN + 768 + sel * 768 + g * 256 + 8 * ch), f);
            float* o = dst + (size_t)it * 8; *(f32x4*)o = (f32x4){f[0], f[1], f[2], f[3]}; *(f32x4*)(o + 4) = (f32x4){f[4], f[5], f[6], f[7]}; }
        float* dsts = F.out + (g == 0 ? O_KVS0 : (g == 1 ? O_KVS1 : O_KVS2));
        for (int it = gt; it < 128 * 8 * 64; it += NGT) { const int ch = it & 31, sel = (it >> 5) & 1, bt = it >> 6, t = bt & 7, b = bt >> 3;
            float f[8]; unpack8(*(const v4u*)(F.PROJ + ((size_t)MP + b * 8 + t) * NIN + 768 + sel * 768 + g * 256 + 8 * ch), f);
            float* o = dsts + (((size_t)b * W + (W - 8 + t)) * 2 + sel) * 256 + 8 * ch; *(f32x4*)o = (f32x4){f[0], f[1], f[2], f[3]}; *(f32x4*)(o + 4) = (f32x4){f[4], f[5], f[6], f[7]}; }
        const float* src = pick3(g, F.c0, F.c1, F.c2);
        const int per_b = (W - 8) * 128;
        const int total = 128 * per_b;
#pragma unroll 4
        for (int it = gt; it < total; it += NGT) { const int b = it / per_b, k = it - b * per_b;
            const f32x4 v = __builtin_nontemporal_load((const f32x4*)(src + ((size_t)b * W + 8) * 512) + k);
            __builtin_nontemporal_store(v, (f32x4*)(dsts + (size_t)b * W * 512) + k); }
    }
    for (int it = gt; it < 8 * 2 * 32; it += NGT) { const int ch = it & 31, j = (it >> 5) & 1, b = it >> 6; float u[8]; conv_u(F.PROJ, (size_t)b * TP + TP - 2 + j, ch, u);
        float* o = F.out + O_CVP + (size_t)it * 8; *(f32x4*)o = (f32x4){u[0], u[1], u[2], u[3]}; *(f32x4*)(o + 4) = (f32x4){u[4], u[5], u[6], u[7]}; }
    for (int it = gt; it < 128 * 2 * 32; it += NGT) { const int ch = it & 31, j = (it >> 5) & 1, b = it >> 6; float u[8]; conv_u(F.PROJ, (size_t)MP + b * 8 + 6 + j, ch, u);
        float* o = F.out + O_CVS + (size_t)it * 8; *(f32x4*)o = (f32x4){u[0], u[1], u[2], u[3]}; *(f32x4*)(o + 4) = (f32x4){u[4], u[5], u[6], u[7]}; }
}
__device__ __forceinline__ void p2b_alpha(Frame& F) {
    const int gt = F.vcu * (NWAVES * 64) + F.tid, NGT = F.G * NWAVES * 64;
    for (int it = gt; it < M * 32; it += NGT) { const int row = it >> 5, h = (it >> 3) & 3, ch = it & 7;
        const float l0 = F.LSE[(size_t)row * 12 + h], l1 = F.LSE[(size_t)row * 12 + 4 + h], l2 = F.LSE[(size_t)row * 12 + 8 + h];
        const float mx = fmaxf(l0, fmaxf(l1, l2)); const float e0 = __builtin_amdgcn_exp2f(l0 - mx), e1 = __builtin_amdgcn_exp2f(l1 - mx), e2 = __builtin_amdgcn_exp2f(l2 - mx);
        const float inv = 1.0f / (e0 + e1 + e2); const float al[3] = {e0 * inv, e1 * inv, e2 * inv};
#pragma unroll
        for (int g = 0; g < 3; ++g) { v4u* p = (v4u*)(F.MIX + (size_t)row * D + g * 256 + h * 64 + 8 * ch); float f[8]; unpack8(*p, f);
            v4u o; o.x = pk2(f[0] * al[g], f[1] * al[g]); o.y = pk2(f[2] * al[g], f[3] * al[g]); o.z = pk2(f[4] * al[g], f[5] * al[g]); o.w = pk2(f[6] * al[g], f[7] * al[g]); *p = o; }
    }
}
__device__ __forceinline__ void p6_final(Frame& F) {
    const int gw = F.vcu * NWAVES + F.wave, NGW = F.G * NWAVES;
    f32x4 gf[4];
#pragma unroll
    for (int j = 0; j < 4; ++j) gf[j] = ((const f32x4*)F.g_fin)[F.lane + 64 * j];
    for (int m = gw; m < M; m += NGW) {
        const float sp = F.lane < 16 ? F.ST2[(size_t)m * 16 + F.lane] : 0.f;
        float ss = sp; ss += __shfl_xor(ss, 1); ss += __shfl_xor(ss, 2); ss += __shfl_xor(ss, 4); ss += __shfl_xor(ss, 8);
        ss = __shfl(ss, 0);
        const float rstd = __builtin_amdgcn_rsqf(ss * (1.0f / D) + EPS);
        f32x4* xr = (f32x4*)(F.out + (size_t)m * D) + F.lane;
#pragma unroll
        for (int j = 0; j < 4; ++j) { const f32x4 v = xr[64 * j]; xr[64 * j] = v * rstd * gf[j]; }
    }
}

struct Args { const float* in[14]; float* out; unsigned char* ws; int ph_lo, ph_hi; };
__global__ void __launch_bounds__(NWAVES * 64, 2) mega_fwd(Args args) {
    extern __shared__ __attribute__((aligned(16))) unsigned char lds[];
    cg::grid_group grid = cg::this_grid();
    Frame F;
    F.lds = (LAS unsigned char*)lds;
    F.tid = threadIdx.x; F.lane = F.tid & 63; F.wave = __builtin_amdgcn_readfirstlane(F.tid >> 6);
    F.G = gridDim.x; { const int bx = blockIdx.x; F.vcu = (F.G % 8 == 0) ? (bx % 8) * (F.G / 8) + bx / 8 : bx; }
    unsigned char* ws = args.ws;
    F.xp = args.in[0]; F.xs = args.in[1]; F.c0 = args.in[2]; F.c1 = args.in[3]; F.c2 = args.in[4]; F.sconv = args.in[5]; F.g_attn = args.in[6]; F.w_in = args.in[7];
    F.conv_w = args.in[8]; F.w_out = args.in[9]; F.g_mlp = args.in[10]; F.w_up = args.in[11]; F.w_down = args.in[12]; F.g_fin = args.in[13]; F.out = args.out;
    F.Win_t = (bf16*)(ws + WS_WIN); F.Wout_t = (bf16*)(ws + WS_WOUT); F.Wup_t = (bf16*)(ws + WS_WUP); F.Wdn_t = (bf16*)(ws + WS_WDN);
    F.XB = (bf16*)(ws + WS_XB); F.PROJ = (bf16*)(ws + WS_PROJ); F.MIX = (bf16*)(ws + WS_MIX); F.HB = (bf16*)(ws + WS_HB);
    F.RSTD0 = (float*)(ws + WS_RSTD0); F.ST1 = (float*)(ws + WS_ST1); F.ST2 = (float*)(ws + WS_ST2); F.LSE = (float*)(ws + WS_LSE);
    const int lo = args.ph_lo, hi = args.ph_hi;
#define IN(k) (lo <= (k) && (k) < hi)
#define SEAM(k) do { if (IN(k) && IN((k) + 1)) grid.sync(); } while (0)

    if (IN(0)) p0_prologue(F);
    SEAM(0);
    if (IN(1)) {
        pg8::Gemm g{F.XB, F.Win_t, M, NIN, D}; pg8::StaticOrder S; S.init(M, NIN, F.G, (int)blockIdx.x);
        pg8::EpiScaleBf16<0> E{F.PROJ, NIN, F.RSTD0, EPS};
        pg8::gemm_phase<pg8::EpiScaleBf16<0>, pg8::StaticOrder, PG8_ALIGN, PG8_SP2>(F.lds, g, S, E);
    }
    SEAM(1);
    if (IN(2)) p2_mixers(F);
    SEAM(2);
    if (IN(3)) p2b_alpha(F);
    SEAM(3);
    if (IN(4)) {
        pg8::Gemm g{F.MIX, F.Wout_t, M, D, D}; pg8::StaticOrder S; S.init(M, D, F.G, (int)blockIdx.x);
        pg8::EpiRes<true> E{F.xp, F.xs, MP, F.out, F.XB, F.ST1};
        pg8::gemm_phase<pg8::EpiRes<true>, pg8::StaticOrder, PG8_ALIGN, PG8_SP2>(F.lds, g, S, E);
    }
    SEAM(4);
    if (IN(5)) {
        pg8::Gemm g{F.XB, F.Wup_t, M, FF, D}; pg8::StaticOrder S; S.init(M, FF, F.G, (int)blockIdx.x);
        pg8::EpiScaleBf16<1> E{F.HB, FF, F.ST1, EPS};
        pg8::gemm_phase<pg8::EpiScaleBf16<1>, pg8::StaticOrder, PG8_ALIGN, PG8_SP2>(F.lds, g, S, E);
    }
    SEAM(5);
    if (IN(6)) {
        pg8::Gemm g{F.HB, F.Wdn_t, M, D, FF}; pg8::StaticOrder S; S.init(M, D, F.G, (int)blockIdx.x);
        pg8::EpiRes<false> E{F.out, F.out, 1 << 30, F.out, nullptr, F.ST2};
        pg8::gemm_phase<pg8::EpiRes<false>, pg8::StaticOrder, PG8_ALIGN, PG8_SP2>(F.lds, g, S, E);
    }
    SEAM(6);
    if (IN(7)) p6_final(F);
#undef IN
#undef SEAM
}

extern "C" void kernel_launch(void* const* d_in, const int* in_sizes, int n_in, void* d_out, int out_size, void* d_ws, size_t ws_size, hipStream_t stream) {
    static int grid = 0;
    if (grid == 0) {
        if (n_in != 14 || in_sizes[0] != MP * D || (size_t)out_size != O_END || ws_size < WS_END) { fprintf(stderr, "kernel_launch: unexpected shapes (n_in %d, in0 %d, out %d, ws %zu); nothing launched\n", n_in, n_in > 0 ? in_sizes[0] : -1, out_size, ws_size); grid = -1; return; }
        int dev = 0, cus = 0, per_cu = 0;
        if (hipGetDevice(&dev) != hipSuccess || hipDeviceGetAttribute(&cus, hipDeviceAttributeMultiprocessorCount, dev) != hipSuccess) { grid = -1; return; }
        if (hipFuncSetAttribute((const void*)mega_fwd, hipFuncAttributeMaxDynamicSharedMemorySize, LDS_BYTES) != hipSuccess) { fprintf(stderr, "kernel_launch: hipFuncSetAttribute failed\n"); grid = -1; return; }
        if (hipOccupancyMaxActiveBlocksPerMultiprocessor(&per_cu, (const void*)mega_fwd, NWAVES * 64, LDS_BYTES) != hipSuccess || per_cu < 1) { fprintf(stderr, "kernel_launch: occupancy query failed (%d)\n", per_cu); (void)hipGetLastError(); grid = -1; return; }
        grid = cus;
    }
    if (grid < 0) return;
    Args a{};
    for (int i = 0; i < 14; ++i) a.in[i] = (const float*)d_in[i];
    a.out = (float*)d_out; a.ws = (unsigned char*)d_ws;
    if (MK_N_LAUNCHES == 1) {
        a.ph_lo = 0; a.ph_hi = 8;
        void* kargs[] = {&a};
        const hipError_t e = hipLaunchCooperativeKernel((const void*)mega_fwd, dim3(grid), dim3(NWAVES * 64), kargs, LDS_BYTES, stream);
        if (e != hipSuccess) fprintf(stderr, "kernel_launch: cooperative launch failed: %s (grid %d)\n", hipGetErrorString(e), grid);
    } else {
        for (int p = 0; p < 8; ++p) { a.ph_lo = p; a.ph_hi = p + 1; hipLaunchKernelGGL(mega_fwd, dim3(grid), dim3(NWAVES * 64), LDS_BYTES, stream, a); }
    }
}
```

```cpp
#include <hip/hip_runtime.h>
#include <cstdio>
#include <cstdint>
#include <hip/hip_cooperative_groups.h>
namespace cg = cooperative_groups;
namespace pg8 {
#define PG8_LAS __attribute__((address_space(3)))
typedef unsigned short bf16_t;
typedef short bf16x8 __attribute__((ext_vector_type(8)));
typedef float f32x4 __attribute__((ext_vector_type(4)));
typedef unsigned u32x4 __attribute__((ext_vector_type(4)));
constexpr int BM = 256, BK = 64, HALF = 128, HTB = HALF * BK * 2  , STAGE_BYTES = 8 * HTB, NXCD = 8, WGM = 8;

__host__ __device__ __forceinline__ int lds_byte(int r, int c) { const int st = (r >> 4) * 2 + (c >> 5), rr = r & 15, cc = c & 31, ob = rr * 64 + cc * 2; return st * 1024 + (ob ^ (((ob >> 9) & 1) << 5)); }
__host__ __device__ __forceinline__ void stage_rc(int b, int& R, int& C) { const int st = b / 1024, sb = b % 1024, swz = sb ^ (((sb >> 9) & 1) << 5); R = (st >> 1) * 16 + swz / 64; C = (st & 1) * 32 + (swz % 64) / 2; }
__host__ __device__ __forceinline__ int perm32(int rho) { const int n = rho >> 4, i = rho & 15; return 8 * (i >> 2) + 4 * n + (i & 3); }

struct Unit { int pm, pn; };
struct Gemm { const bf16_t* A; const bf16_t* Bt; int M, N, K; };

struct StaticOrder {
    int nM, nN, nwg, G, c;
    __host__ __device__ void init(int M, int N, int G_, int c_) { nM = M / BM; nN = N / BM; nwg = nM * nN; G = G_; c = c_; }
    __host__ __device__ bool next(int i, Unit& u) const {
        const long L = (long)i * G + c; if (L >= nwg) return false;
        int wgid = (int)L; { const int q = nwg / NXCD, r = nwg % NXCD, xcd = wgid % NXCD, off = wgid / NXCD; wgid = (xcd < r ? xcd * (q + 1) : r * (q + 1) + (xcd - r) * q) + off; }
        const int nig = WGM * nN, gid = wgid / nig, fm = gid * WGM, gsz = (nM - fm) < WGM ? (nM - fm) : WGM;
        u.pm = fm + ((wgid % nig) % gsz); u.pn = (wgid % nig) / gsz; return true;
    }
    __device__ __forceinline__ void a_ready(const Unit&) const {}
    __device__ __forceinline__ void done(const Unit&) const {}
};

__device__ __forceinline__ unsigned cvt_pk_bf16(float lo, float hi) { unsigned r; asm volatile("v_cvt_pk_bf16_f32 %0, %1, %2" : "=v"(r) : "v"(lo), "v"(hi)); return r; }
typedef float f32x2 __attribute__((ext_vector_type(2)));
template <int MODE> struct EpiScaleBf16 {
    static constexpr bool PERM = true, AFTER_DRAIN = false;
    bf16_t* O; int ldc; const float* rs; float eps;
    __device__ __forceinline__ void operator()(const f32x4 (&acc)[2][2][4][2], const Unit& u, int wr, int wc, int fr, int fq) const {
        const int row0 = u.pm * BM + wr * 64 + fr; const int col0 = u.pn * BM + wc * 32 + 8 * fq;
#pragma unroll
        for (int ai = 0; ai < 2; ++ai)
#pragma unroll
            for (int m = 0; m < 4; ++m) { const int row = row0 + ai * HALF + m * 16; float sc;
                if (MODE == 0) sc = rs[row];
                else { const f32x4* p = (const f32x4*)(rs + (size_t)row * 16); const f32x4 a = p[0], b = p[1], c = p[2], d = p[3];
                    const float ss = ((a[0] + a[1]) + (a[2] + a[3])) + ((b[0] + b[1]) + (b[2] + b[3])) + ((c[0] + c[1]) + (c[2] + c[3])) + ((d[0] + d[1]) + (d[2] + d[3]));
                    sc = __builtin_amdgcn_rsqf(ss * (1.0f / 1024.0f) + eps); }
                bf16_t* rowp = O + (size_t)row * ldc + col0;
#pragma unroll
                for (int bj = 0; bj < 2; ++bj) { f32x4 v0 = acc[ai][bj][m][0] * sc, v1 = acc[ai][bj][m][1] * sc;
                    if (MODE == 1) {
#pragma unroll
                        for (int e = 0; e < 4; ++e) { const float x0 = fmaxf(v0[e], 0.f), x1 = fmaxf(v1[e], 0.f); v0[e] = x0 * x0; v1[e] = x1 * x1; } }
                    u32x4 w; w.x = cvt_pk_bf16(v0[0], v0[1]); w.y = cvt_pk_bf16(v0[2], v0[3]); w.z = cvt_pk_bf16(v1[0], v1[1]); w.w = cvt_pk_bf16(v1[2], v1[3]);
                    *(u32x4*)(rowp + bj * HALF) = w; } }
    }
};
template <bool WB> struct EpiRes {
    static constexpr bool PERM = false, AFTER_DRAIN = false;
    const float* base0; const float* base1; int split_row; float* out; bf16_t* xb; float* stats;
    __device__ __forceinline__ void operator()(const f32x4 (&acc)[2][2][4][2], const Unit& u, int wr, int wc, int fr, int fq) const {
        typedef unsigned u32x2v __attribute__((ext_vector_type(2)));
        const int col0 = u.pn * BM + wc * 32 + 4 * fq; const int rt0 = u.pm * BM;
        const float* base = rt0 < split_row ? base0 : base1; const int rsub = rt0 < split_row ? 0 : split_row;
#pragma unroll
        for (int ai = 0; ai < 2; ++ai)
#pragma unroll
            for (int m = 0; m < 4; ++m) { const int r = rt0 + ai * HALF + wr * 64 + m * 16 + fr; const size_t off = (size_t)r * 1024 + col0, offb = (size_t)(r - rsub) * 1024 + col0; float ss = 0.f;
#pragma unroll
                for (int bj = 0; bj < 2; ++bj)
#pragma unroll
                    for (int n = 0; n < 2; ++n) { const f32x4 bs = *(const f32x4*)(base + offb + bj * HALF + n * 16); const f32x4 o = bs + acc[ai][bj][m][n];
                        *(f32x4*)(out + off + bj * HALF + n * 16) = o;
                        if (WB) { u32x2v w; w.x = cvt_pk_bf16(o[0], o[1]); w.y = cvt_pk_bf16(o[2], o[3]); *(u32x2v*)(xb + off + bj * HALF + n * 16) = w; }
                        ss += (o[0] * o[0] + o[1] * o[1]) + (o[2] * o[2] + o[3] * o[3]); }
                ss += __shfl_xor(ss, 16); ss += __shfl_xor(ss, 32);
                if (fq == 0) stats[(size_t)r * 16 + u.pn * 4 + wc] = ss;
                if (m & 1) asm volatile("" ::: "memory"); }
    }
};

template <class Epi, class Sched, bool ALIGN_EPI = false, bool SP2 = false>
__device__ __forceinline__ void gemm_phase(PG8_LAS unsigned char* lds, const Gemm g, const Sched& S, const Epi& E) {
    const int tid = threadIdx.x, wid = __builtin_amdgcn_readfirstlane(tid >> 6), lane = tid & 63, wr = wid >> 2, wc = wid & 3, fr = lane & 15, fq = lane >> 4;
    const int K = g.K, nt = K / BK;
    unsigned voffA[2], voffB[2];
#pragma unroll
    for (int i = 0; i < 2; ++i) { int R, C; stage_rc(tid * 16 + i * 8192, R, C); const int Rb = Epi::PERM ? ((R & ~31) + perm32(R & 31)) : R;
        voffA[i] = (unsigned)(R * K + C) * 2u; voffB[i] = (unsigned)(Rb * K + C) * 2u; }
    const size_t kstep = (size_t)(BK * 2);
    const size_t hstep = (size_t)HALF * K * 2;
    const size_t tstep = 2 * hstep;
    const unsigned ldsw = (unsigned)wid * 1024u;
    const int aoff = lds_byte(wr * 64 + fr, fq * 8), boff = lds_byte(wc * 32 + fr, fq * 8);
#define PG8_SA(b, h) (((b) * 2 + (h)) * HTB)
#define PG8_SB(b, h) ((4 + (b) * 2 + (h)) * HTB)
#define PG8_STAGE(bufoff, gbase, voff) do { _Pragma("unroll") for (int _i = 0; _i < 2; ++_i) \
        __builtin_amdgcn_global_load_lds((const unsigned*)((const char*)(gbase) + (voff)[_i]), (PG8_LAS unsigned*)(lds + (bufoff) + ldsw + _i * 8192), 16, 0, 0); } while (0)
#define PG8_LDA(dst, b, h) do { _Pragma("unroll") for (int m = 0; m < 4; ++m) _Pragma("unroll") for (int k = 0; k < 2; ++k) dst[m][k] = *(const PG8_LAS bf16x8*)(lds + PG8_SA(b, h) + aoff + m * 2048 + k * 1024); } while (0)
#define PG8_LDB(dst, b, h) do { _Pragma("unroll") for (int n = 0; n < 2; ++n) _Pragma("unroll") for (int k = 0; k < 2; ++k) dst[n][k] = *(const PG8_LAS bf16x8*)(lds + PG8_SB(b, h) + boff + n * 2048 + k * 1024); } while (0)
#define PG8_MMA(ai, bj, At, Bt) do { __builtin_amdgcn_s_setprio(1); _Pragma("unroll") for (int m = 0; m < 4; ++m) _Pragma("unroll") for (int n = 0; n < 2; ++n) _Pragma("unroll") for (int k = 0; k < 2; ++k) \
        acc[ai][bj][m][n] = __builtin_amdgcn_mfma_f32_16x16x32_bf16(Bt[n][k], At[m][k], acc[ai][bj][m][n], 0, 0, 0); __builtin_amdgcn_s_setprio(0); } while (0)
#define PG8_WAIT_V(n) asm volatile("s_waitcnt vmcnt(" #n ")" ::: "memory")
#define PG8_WAIT_L(n) asm volatile("s_waitcnt lgkmcnt(" #n ")" ::: "memory")
#define PG8_BAR __builtin_amdgcn_s_barrier()
#define PG8_SCHED __builtin_amdgcn_sched_barrier(0)
    Unit cur, nxt; int ui = 0;
    if (!S.next(0, cur)) return;
    f32x4 acc[2][2][4][2];
#pragma unroll
    for (int a = 0; a < 2; ++a)
#pragma unroll
        for (int b = 0; b < 2; ++b)
#pragma unroll
            for (int m = 0; m < 4; ++m)
#pragma unroll
                for (int n = 0; n < 2; ++n) acc[a][b][m][n] = (f32x4){0.f, 0.f, 0.f, 0.f};
    bf16x8 At[4][2], B0[2][2], B1[2][2];
    const char* cA = (const char*)g.A + (size_t)cur.pm * tstep; const char* cB = (const char*)g.Bt + (size_t)cur.pn * tstep;
    S.a_ready(cur);
    if constexpr (SP2) {
        PG8_STAGE(PG8_SB(0, 0), cB, voffB); PG8_STAGE(PG8_SB(0, 1), cB + hstep, voffB); PG8_STAGE(PG8_SA(0, 0), cA, voffA); PG8_STAGE(PG8_SA(0, 1), cA + hstep, voffA);
        if (wr == 1) PG8_BAR;
        PG8_WAIT_V(2); PG8_BAR;
        PG8_STAGE(PG8_SB(1, 0), cB + kstep, voffB); PG8_STAGE(PG8_SA(1, 0), cA + kstep, voffA); PG8_STAGE(PG8_SB(1, 1), cB + hstep + kstep, voffB);
        PG8_WAIT_V(6); PG8_BAR;
    } else {
        PG8_STAGE(PG8_SB(0, 0), cB, voffB); PG8_STAGE(PG8_SA(0, 0), cA, voffA); PG8_STAGE(PG8_SB(0, 1), cB + hstep, voffB); PG8_STAGE(PG8_SA(0, 1), cA + hstep, voffA);
        if (wr == 1) PG8_BAR;
        PG8_WAIT_V(4); PG8_BAR;
        PG8_STAGE(PG8_SB(1, 0), cB + kstep, voffB); PG8_STAGE(PG8_SA(1, 0), cA + kstep, voffA); PG8_STAGE(PG8_SB(1, 1), cB + hstep + kstep, voffB);
        PG8_WAIT_V(6); PG8_BAR;
    }
    for (;;) {
        const bool has_next = S.next(ui + 1, nxt);
        const char* nA = has_next ? (const char*)g.A + (size_t)nxt.pm * tstep : cA; const char* nB = has_next ? (const char*)g.Bt + (size_t)nxt.pn * tstep : cB;
        for (int t = 0; t < nt; t += 2) {
            const bool last = (t == nt - 2);
            const char* a1 = cA + (size_t)(t + 1) * kstep;
            const char* a2 = last ? nA : cA + (size_t)(t + 2) * kstep; const char* b2 = last ? nB : cB + (size_t)(t + 2) * kstep;
            const char* a3 = a2 + kstep; const char* b3 = b2 + kstep;
            if (last && has_next) S.a_ready(nxt);
            if constexpr (SP2) {
            PG8_LDB(B0, 0, 0); PG8_LDB(B1, 0, 1); PG8_SCHED; PG8_LDA(At, 0, 0); PG8_STAGE(PG8_SA(1, 1), a1 + hstep, voffA);
            PG8_WAIT_V(8); PG8_WAIT_L(0); PG8_BAR; PG8_MMA(0, 0, At, B0); PG8_MMA(0, 1, At, B1); PG8_BAR; PG8_SCHED;
            PG8_LDA(At, 0, 1); PG8_STAGE(PG8_SB(0, 0), b2, voffB); PG8_STAGE(PG8_SB(0, 1), b2 + hstep, voffB); PG8_STAGE(PG8_SA(0, 0), a2, voffA);
            PG8_WAIT_V(8); PG8_WAIT_L(0); PG8_BAR; PG8_MMA(1, 0, At, B0); PG8_MMA(1, 1, At, B1); PG8_BAR; PG8_SCHED;
            PG8_LDB(B0, 1, 0); PG8_LDB(B1, 1, 1); PG8_SCHED; PG8_LDA(At, 1, 0); PG8_STAGE(PG8_SA(0, 1), a2 + hstep, voffA);
            PG8_WAIT_V(8); PG8_WAIT_L(0); PG8_BAR; PG8_MMA(0, 0, At, B0); PG8_MMA(0, 1, At, B1); PG8_BAR; PG8_SCHED;
            PG8_LDA(At, 1, 1); PG8_STAGE(PG8_SB(1, 0), b3, voffB); PG8_STAGE(PG8_SB(1, 1), b3 + hstep, voffB); PG8_STAGE(PG8_SA(1, 0), a3, voffA);
            PG8_WAIT_V(8); PG8_WAIT_L(0); PG8_BAR; PG8_MMA(1, 0, At, B0); PG8_MMA(1, 1, At, B1); PG8_BAR; PG8_SCHED;
            } else {
            PG8_LDB(B0, 0, 0); PG8_SCHED; PG8_LDA(At, 0, 0); PG8_STAGE(PG8_SA(1, 1), a1 + hstep, voffA);
            PG8_WAIT_L(8); PG8_BAR; PG8_WAIT_L(0); PG8_MMA(0, 0, At, B0); PG8_BAR; PG8_SCHED;
            PG8_LDB(B1, 0, 1); PG8_STAGE(PG8_SB(0, 0), b2, voffB);
            PG8_BAR; PG8_WAIT_L(0); PG8_MMA(0, 1, At, B1); PG8_BAR;
            PG8_LDA(At, 0, 1); PG8_STAGE(PG8_SA(0, 0), a2, voffA);
            PG8_BAR; PG8_WAIT_L(0); PG8_MMA(1, 0, At, B0); PG8_BAR; PG8_SCHED;
            PG8_STAGE(PG8_SB(0, 1), b2 + hstep, voffB);
            PG8_WAIT_V(6); PG8_BAR; PG8_MMA(1, 1, At, B1); PG8_BAR;
            PG8_LDB(B0, 1, 0); PG8_SCHED; PG8_LDA(At, 1, 0); PG8_STAGE(PG8_SA(0, 1), a2 + hstep, voffA);
            PG8_WAIT_L(8); PG8_BAR; PG8_WAIT_L(0); PG8_MMA(0, 0, At, B0); PG8_BAR; PG8_SCHED;
            PG8_LDB(B1, 1, 1); PG8_STAGE(PG8_SB(1, 0), b3, voffB);
            PG8_BAR; PG8_WAIT_L(0); PG8_MMA(0, 1, At, B1); PG8_BAR;
            PG8_LDA(At, 1, 1); PG8_STAGE(PG8_SA(1, 0), a3, voffA);
            PG8_BAR; PG8_WAIT_L(0); PG8_MMA(1, 0, At, B0); PG8_BAR; PG8_SCHED;
            PG8_STAGE(PG8_SB(1, 1), b3 + hstep, voffB);
            PG8_WAIT_V(6); PG8_BAR; PG8_MMA(1, 1, At, B1); PG8_BAR;
            }
        }
        if constexpr (ALIGN_EPI) { if (wr == 0) PG8_BAR; }
        if constexpr (!Epi::AFTER_DRAIN) { E(acc, cur, wr, wc, fr, fq); S.done(cur); }
        if (!has_next) break;
#pragma unroll
        for (int a = 0; a < 2; ++a)
#pragma unroll
            for (int b = 0; b < 2; ++b)
#pragma unroll
                for (int m = 0; m < 4; ++m)
#pragma unroll
                    for (int n = 0; n < 2; ++n) acc[a][b][m][n] = (f32x4){0.f, 0.f, 0.f, 0.f};
        cur = nxt; cA = nA; cB = nB; ++ui;
        if constexpr (ALIGN_EPI) { if (wr == 1) PG8_BAR; }
    }
    PG8_WAIT_V(0);
    if constexpr (!ALIGN_EPI) { if (wr == 0) PG8_BAR; }
    PG8_BAR;
    if constexpr (Epi::AFTER_DRAIN) { E.fused(acc, cur, wr, wc, fr, fq, lds, wid, lane); S.done(cur); }
#undef PG8_SA
#undef PG8_SB
#undef PG8_STAGE
#undef PG8_LDA
#undef PG8_LDB
#undef PG8_MMA
#undef PG8_WAIT_V
#undef PG8_WAIT_L
#undef PG8_BAR
#undef PG8_SCHED
}
}
#ifndef PG8_SP2
#define PG8_SP2 true
#endif
#ifndef PG8_ALIGN
#define PG8_ALIGN true
#endif
#ifndef MK_N_LAUNCHES
#define MK_N_LAUNCHES 1
#endif

constexpr int D = 1024, FF = 4096, NIN = 3072;
constexpr int MP = 8 * 8192, MS = 128 * 8, M = MP + MS;
constexpr int TP = 8192;
constexpr float EPS = 1e-6f;
constexpr int NWAVES = 8;
#define GAS __attribute__((address_space(1)))
#define LAS __attribute__((address_space(3)))
typedef unsigned short bf16;
typedef unsigned v4u __attribute__((ext_vector_type(4)));
typedef unsigned v2u __attribute__((ext_vector_type(2)));
typedef float f32x4 __attribute__((ext_vector_type(4)));
typedef short bf16x8 __attribute__((ext_vector_type(8)));
typedef short s16x4 __attribute__((ext_vector_type(4)));
typedef float f32x16 __attribute__((ext_vector_type(16)));

constexpr size_t MiB = 1u << 20;
constexpr size_t WS_WIN = 0, WS_WOUT = 6 * MiB, WS_WUP = 8 * MiB, WS_WDN = 16 * MiB;
constexpr size_t WS_RSTD0 = 24 * MiB;
constexpr size_t WS_ST1 = 25 * MiB, WS_ST2 = 30 * MiB;
constexpr size_t WS_LSE = 35 * MiB;
constexpr size_t WS_XB = 40 * MiB;
constexpr size_t WS_PROJ = 172 * MiB;
constexpr size_t WS_MIX = 564 * MiB;
constexpr size_t WS_HB = 696 * MiB;
constexpr size_t WS_END = 1220 * MiB;
static_assert(WS_XB + (size_t)M * D * 2 <= WS_PROJ && WS_PROJ + (size_t)M * NIN * 2 <= WS_MIX && WS_MIX + (size_t)M * D * 2 <= WS_HB && WS_HB + (size_t)M * FF * 2 <= WS_END, "d_ws map");
static_assert(WS_ST1 + (size_t)M * 64 <= WS_ST2 && WS_ST2 + (size_t)M * 64 <= WS_LSE && WS_LSE + (size_t)M * 48 <= WS_XB, "d_ws map 2");

constexpr size_t O_Y = 0;
constexpr size_t O_KVP0 = (size_t)M * D;
constexpr size_t O_KVP1 = O_KVP0 + 8ull * 128 * 512;
constexpr size_t O_KVP2 = O_KVP1 + 8ull * 512 * 512;
constexpr size_t O_CVP = O_KVP2 + 8ull * 2048 * 512;
constexpr size_t O_KVS0 = O_CVP + 8ull * 2 * 256;
constexpr size_t O_KVS1 = O_KVS0 + 128ull * 128 * 512;
constexpr size_t O_KVS2 = O_KVS1 + 128ull * 512 * 512;
constexpr size_t O_CVS = O_KVS2 + 128ull * 2048 * 512;
constexpr size_t O_END = O_CVS + 128ull * 2 * 256;

constexpr int LDS_BYTES = 147456;

__device__ __forceinline__ unsigned f2bf(float f) { unsigned u = __builtin_bit_cast(unsigned, f); return (u + 0x7fffu + ((u >> 16) & 1u)) >> 16; }
__device__ __forceinline__ unsigned pk2(float lo, float hi) { return f2bf(lo) | (f2bf(hi) << 16); }
__device__ __forceinline__ float bflo(unsigned w) { return __builtin_bit_cast(float, w << 16); }
__device__ __forceinline__ float bfhi(unsigned w) { return __builtin_bit_cast(float, w & 0xffff0000u); }
__device__ __forceinline__ float wave_sum(float v) {
#pragma unroll
    for (int o = 1; o < 64; o <<= 1) v += __shfl_xor(v, o);
    return v;
}

__device__ __forceinline__ const float* pick3(int g, const float* a, const float* b, const float* c) { return g == 0 ? a : (g == 1 ? b : c); }
struct Frame {
    LAS unsigned char* lds;
    int tid, lane, wave, vcu, G;
    const float *xp, *xs, *c0, *c1, *c2, *sconv, *g_attn, *w_in, *conv_w, *w_out, *g_mlp, *w_up, *w_down, *g_fin;
    float* out;
    bf16 *Win_t, *Wout_t, *Wup_t, *Wdn_t, *XB, *PROJ, *MIX, *HB;
    float *RSTD0, *ST1, *ST2, *LSE;
};

__device__ __forceinline__ void p0_transpose_item(const float* W, const float* gk, int K, int N, bf16* WT, LAS float* scr, int item, int lane) {
    const int nblk = N / 32, kb = item / nblk, nb = item % nblk, k0 = 64 * kb, n0 = 32 * nb;
#pragma unroll 8
    for (int i = 0; i < 32; ++i) { const int kk = 2 * i + (lane >> 5); float v = W[(size_t)(k0 + kk) * N + n0 + (lane & 31)]; if (gk) v *= gk[k0 + kk]; scr[kk * 33 + (lane & 31)] = v; }
    asm volatile("s_waitcnt lgkmcnt(0)" ::: "memory");
    const int c = lane & 7;
#pragma unroll
    for (int j = 0; j < 4; ++j) { const int n = (lane >> 3) + 8 * j; const LAS float* s = scr + (8 * c) * 33 + n;
        v4u o; o.x = pk2(s[0 * 33], s[1 * 33]); o.y = pk2(s[2 * 33], s[3 * 33]); o.z = pk2(s[4 * 33], s[5 * 33]); o.w = pk2(s[6 * 33], s[7 * 33]);
        *(v4u*)(WT + (size_t)(n0 + n) * K + k0 + 8 * c) = o; }
    asm volatile("s_waitcnt lgkmcnt(0)" ::: "memory");
}
__device__ __forceinline__ void p0_prologue(Frame& F) {
    LAS float* scr = (LAS float*)(F.lds + F.wave * 16384);
    const int gw = F.vcu * NWAVES + F.wave, NGW = F.G * NWAVES;
    constexpr int I_IN = (D / 64) * (NIN / 32), I_O = (D / 64) * (D / 32), I_UP = (D / 64) * (FF / 32), I_DN = (FF / 64) * (D / 32);
    constexpr int NITEMS = I_IN + I_O + I_UP + I_DN;
    for (int it = gw; it < NITEMS; it += NGW) {
        int r = it;
        if (r < I_IN) { p0_transpose_item(F.w_in, F.g_attn, D, NIN, F.Win_t, scr, r, F.lane); continue; } r -= I_IN;
        if (r < I_O) { p0_transpose_item(F.w_out, nullptr, D, D, F.Wout_t, scr, r, F.lane); continue; } r -= I_O;
        if (r < I_UP) { p0_transpose_item(F.w_up, F.g_mlp, D, FF, F.Wup_t, scr, r, F.lane); continue; } r -= I_UP;
        p0_transpose_item(F.w_down, nullptr, FF, D, F.Wdn_t, scr, r, F.lane);
    }
    for (int m = gw; m < M; m += NGW) {
        const float* xrow = m < MP ? F.xp + (size_t)m * D : F.xs + (size_t)(m - MP) * D;
        const f32x4* xr = (const f32x4*)xrow + F.lane;
        f32x4 v[4]; float s = 0.f;
#pragma unroll
        for (int j = 0; j < 4; ++j) { v[j] = xr[64 * j]; s += (v[j].x * v[j].x + v[j].y * v[j].y) + (v[j].z * v[j].z + v[j].w * v[j].w); }
        s = wave_sum(s);
        v2u* o8 = (v2u*)(F.XB + (size_t)m * D) + F.lane;
#pragma unroll
        for (int j = 0; j < 4; ++j) { v2u w; w.x = pk2(v[j].x, v[j].y); w.y = pk2(v[j].z, v[j].w); o8[64 * j] = w; }
        if (F.lane == 0) F.RSTD0[m] = __builtin_amdgcn_rsqf(s * (1.0f / D) + EPS);
    }
}

namespace att {
constexpr int VP = 144;
constexpr float C2 = 0.125f * 1.4426950408889634f;
__device__ __forceinline__ int crow(int r, int hi) { return (r & 3) + 8 * (r >> 2) + 4 * hi; }
__device__ __forceinline__ s16x4 vtr(const LAS unsigned char* p) { return __builtin_bit_cast(s16x4, __builtin_amdgcn_ds_read_tr16_b64_v4i16((LAS s16x4*)p)); }
__device__ __forceinline__ unsigned cvtpk(float lo, float hi) { typedef float f2 __attribute__((ext_vector_type(2))); typedef __bf16 b2 __attribute__((ext_vector_type(2))); f2 v = {lo, hi}; b2 b = __builtin_convertvector(v, b2); return __builtin_bit_cast(unsigned, b); }

__device__ __forceinline__ void prompt_unit(const bf16* __restrict__ proj, bf16* __restrict__ mixed, float* __restrict__ lse, LAS unsigned char* lds, int b, int g, int h, int r, int c) {
    const int tid = threadIdx.x, lane = tid & 63, wid = __builtin_amdgcn_readfirstlane(tid >> 6), a = lane & 31, hi = lane >> 5;
    const int s = 2 * g, i0 = c * 256;
    const size_t rowb = (size_t)b * TP;
    const int colq = g * 256 + h * 64, colk = 768 + colq, colv = 1536 + colq;
    __syncthreads();
#pragma unroll
    for (int i = 0; i < 6; ++i) {
        const int id = tid + 512 * i, kk = id >> 3, ch = id & 7; int ii = i0 - 128 + kk; ii = ii < 0 ? 0 : ii;
        const v4u v = *(const v4u*)(proj + (rowb + ((size_t)ii << s) + r) * NIN + colv + ch * 8);
        *(LAS v4u*)(lds + kk * VP + ch * 16) = v;
    }
    const int qs = i0 + 32 * wid;
    bf16x8 qf[4];
    { const bf16* qp = proj + (rowb + ((size_t)(qs + a) << s) + r) * NIN + colq + hi * 8;
#pragma unroll
      for (int d0 = 0; d0 < 4; ++d0) qf[d0] = *(const bf16x8*)(qp + d0 * 16); }
    f32x16 S[5];
#pragma unroll
    for (int kb = 0; kb < 5; ++kb) {
        int ii = qs - 128 + 32 * kb + a; ii = ii < 0 ? 0 : ii;
        const bf16* kp = proj + (rowb + ((size_t)ii << s) + r) * NIN + colk + hi * 8;
        bf16x8 kf[4];
#pragma unroll
        for (int d0 = 0; d0 < 4; ++d0) kf[d0] = *(const bf16x8*)(kp + d0 * 16);
        f32x16 acc = {};
#pragma unroll
        for (int d0 = 0; d0 < 4; ++d0) acc = __builtin_amdgcn_mfma_f32_32x32x16_bf16(kf[d0], qf[d0], acc, 0, 0, 0);
        S[kb] = acc;
    }
    float mx = -INFINITY;
#pragma unroll
    for (int kb = 0; kb < 5; ++kb)
#pragma unroll
        for (int rr = 0; rr < 16; ++rr) { const int key = crow(rr, hi), ii = qs - 128 + 32 * kb + key;
            bool valid = ii >= 0; if (kb == 0) valid = valid && (key >= a); if (kb == 4) valid = valid && (key <= a);
            const float v = valid ? S[kb][rr] * C2 : -INFINITY; S[kb][rr] = v; mx = fmaxf(mx, v); }
    mx = fmaxf(mx, __shfl_xor(mx, 32));
    float l = 0.f;
#pragma unroll
    for (int kb = 0; kb < 5; ++kb)
#pragma unroll
        for (int rr = 0; rr < 16; ++rr) { const float p = __builtin_amdgcn_exp2f(S[kb][rr] - mx); S[kb][rr] = p; l += p; }
    l += __shfl_xor(l, 32);
    __syncthreads();
    f32x16 o[2]; o[0] = f32x16{}; o[1] = f32x16{};
    const LAS unsigned char* vbase = lds + (32 * wid + 4 * hi + ((lane & 15) >> 2)) * VP + (16 * ((lane >> 4) & 1) + 4 * (lane & 3)) * 2;
#pragma unroll
    for (int kb = 0; kb < 5; ++kb)
#pragma unroll
        for (int st = 0; st < 2; ++st) {
            v4u pw; pw.x = cvtpk(S[kb][8 * st + 0], S[kb][8 * st + 1]); pw.y = cvtpk(S[kb][8 * st + 2], S[kb][8 * st + 3]); pw.z = cvtpk(S[kb][8 * st + 4], S[kb][8 * st + 5]); pw.w = cvtpk(S[kb][8 * st + 6], S[kb][8 * st + 7]);
            const bf16x8 pa = __builtin_bit_cast(bf16x8, pw);
#pragma unroll
            for (int cc = 0; cc < 2; ++cc) {
                const s16x4 lo = vtr(vbase + (32 * kb + 16 * st) * VP + cc * 64), hh = vtr(vbase + (32 * kb + 16 * st + 8) * VP + cc * 64);
                const bf16x8 vf = (bf16x8){lo[0], lo[1], lo[2], lo[3], hh[0], hh[1], hh[2], hh[3]};
                o[cc] = __builtin_amdgcn_mfma_f32_32x32x16_bf16(pa, vf, o[cc], 0, 0, 0);
            }
        }
    const float linv = 1.0f / l;
#pragma unroll
    for (int rr = 0; rr < 16; ++rr) { const int q = crow(rr, hi); const float li = __shfl(linv, q);
        bf16* op = mixed + (rowb + ((size_t)(qs + q) << s) + r) * D + colq + a;
        op[0] = (bf16)f2bf(o[0][rr] * li); op[32] = (bf16)f2bf(o[1][rr] * li); }
    if (hi == 0) lse[(rowb + ((size_t)(qs + a) << s) + r) * 12 + g * 4 + h] = mx + __builtin_amdgcn_logf(l);
}

__device__ __forceinline__ f32x4 kv_fetch(const float* __restrict__ cache, const bf16* __restrict__ proj, int W, int b, int idx, int sel, int g, int h, int c) {
    if (idx >= W) { const v2u w = *(const v2u*)(proj + (size_t)(MP + b * 8 + (idx - W)) * NIN + 768 + sel * 768 + g * 256 + h * 64 + 4 * c); return (f32x4){bflo(w.x), bfhi(w.x), bflo(w.y), bfhi(w.y)}; }
    return *(const f32x4*)(cache + (((size_t)b * W + idx) * 2 + sel) * 256 + h * 64 + 4 * c);
}
__device__ __forceinline__ void sample_task(Frame& F, int task) {
    const int t = task & 7, h = (task >> 3) & 3, bg = task >> 5, g = bg % 3, b = bg / 3;
    const int lane = F.lane, rg = lane >> 4, c = lane & 15;
    const int W = 128 << (2 * g), d = 1 << (2 * g);
    const float* cache = pick3(g, F.c0, F.c1, F.c2);
    const size_t qrow = (size_t)MP + b * 8 + t;
    f32x4 q; { const v2u w = *(const v2u*)(F.PROJ + qrow * NIN + g * 256 + h * 64 + 4 * c); q = (f32x4){bflo(w.x), bfhi(w.x), bflo(w.y), bfhi(w.y)}; }
    float sc[33];
#pragma unroll
    for (int i0 = 0; i0 < 33; i0 += 11) {
        f32x4 kv[11];
#pragma unroll
        for (int i = 0; i < 11; ++i) { int j = 4 * (i0 + i) + rg; j = j > 128 ? 128 : j; kv[i] = kv_fetch(cache, F.PROJ, W, b, W + t - d * j, 0, g, h, c); }
#pragma unroll
        for (int i = 0; i < 11; ++i) { float p = (kv[i][0] * q[0] + kv[i][1] * q[1]) + (kv[i][2] * q[2] + kv[i][3] * q[3]);
            p += __shfl_xor(p, 1); p += __shfl_xor(p, 2); p += __shfl_xor(p, 4); p += __shfl_xor(p, 8);
            const int j = 4 * (i0 + i) + rg; sc[i0 + i] = j <= 128 ? p * C2 : -INFINITY; }
    }
    float mx = sc[0];
#pragma unroll
    for (int i = 1; i < 33; ++i) mx = fmaxf(mx, sc[i]);
    mx = fmaxf(mx, __shfl_xor(mx, 16)); mx = fmaxf(mx, __shfl_xor(mx, 32));
    float l = 0.f;
#pragma unroll
    for (int i = 0; i < 33; ++i) { sc[i] = __builtin_amdgcn_exp2f(sc[i] - mx); l += sc[i]; }
    l += __shfl_xor(l, 16); l += __shfl_xor(l, 32);
    f32x4 o = {0.f, 0.f, 0.f, 0.f};
#pragma unroll
    for (int i0 = 0; i0 < 33; i0 += 11) {
        f32x4 kv[11];
#pragma unroll
        for (int i = 0; i < 11; ++i) { int j = 4 * (i0 + i) + rg; j = j > 128 ? 128 : j; kv[i] = kv_fetch(cache, F.PROJ, W, b, W + t - d * j, 1, g, h, c); }
#pragma unroll
        for (int i = 0; i < 11; ++i) o += kv[i] * sc[i0 + i];
    }
#pragma unroll
    for (int e = 0; e < 4; ++e) { float v = o[e]; v += __shfl_xor(v, 16); v += __shfl_xor(v, 32); o[e] = v; }
    const float li = 1.0f / l;
    if (rg == 0) { v2u w; w.x = pk2(o[0] * li, o[1] * li); w.y = pk2(o[2] * li, o[3] * li); *(v2u*)(F.MIX + qrow * D + g * 256 + h * 64 + 4 * c) = w; }
    if (lane == 0) F.LSE[qrow * 12 + g * 4 + h] = mx + __builtin_amdgcn_logf(l);
}
}

__device__ __forceinline__ void unpack8(const v4u w, float (&f)[8]) { f[0] = bflo(w.x); f[1] = bfhi(w.x); f[2] = bflo(w.y); f[3] = bfhi(w.y); f[4] = bflo(w.z); f[5] = bfhi(w.z); f[6] = bflo(w.w); f[7] = bfhi(w.w); }
__device__ __forceinline__ void conv_u(const bf16* proj, size_t row, int ch, float (&u)[8]) {
    float cf[8], hf[8]; unpack8(*(const v4u*)(proj + row * NIN + 2560 + 8 * ch), cf); unpack8(*(const v4u*)(proj + row * NIN + 2816 + 8 * ch), hf);
#pragma unroll
    for (int e = 0; e < 8; ++e) u[e] = cf[e] * hf[e];
}
__device__ __forceinline__ void ld8f(const float* p, float (&u)[8]) { const f32x4 a = *(const f32x4*)p, b = *(const f32x4*)(p + 4); u[0] = a[0]; u[1] = a[1]; u[2] = a[2]; u[3] = a[3]; u[4] = b[0]; u[5] = b[1]; u[6] = b[2]; u[7] = b[3]; }

__device__ __forceinline__ void p2_mixers(Frame& F) {
    const int gt = F.vcu * (NWAVES * 64) + F.tid, NGT = F.G * NWAVES * 64;
    for (int u = F.vcu; u < 8 * 12 * 32; u += F.G) {
        const int sub = u & 31, bgh = u >> 5, h = bgh & 3, g = (bgh >> 2) % 3, b = bgh / 12;
        const int cpc = 32 >> (2 * g), r = sub / cpc, c = sub % cpc;
        att::prompt_unit(F.PROJ, F.MIX, F.LSE, F.lds, b, g, h, r, c);
    }
    for (int task = F.vcu * NWAVES + F.wave; task < 128 * 12 * 8; task += F.G * NWAVES) att::sample_task(F, task);
    for (int it = gt; it < M * 32; it += NGT) {
        const int row = it >> 5, ch = it & 31;
        int t, b; const bool smp = row >= MP; if (smp) { const int rs = row - MP; b = rs >> 3; t = rs & 7; } else { b = row >> 13; t = row & (TP - 1); }
        float u0[8], u1[8], u2[8], bg[8], w0[8], w1[8], w2[8];
        conv_u(F.PROJ, row, ch, u0);
        if (t >= 1) conv_u(F.PROJ, row - 1, ch, u1); else if (smp) ld8f(F.sconv + ((size_t)b * 2 + 1) * 256 + 8 * ch, u1); else {
#pragma unroll
            for (int e = 0; e < 8; ++e) u1[e] = 0.f; }
        if (t >= 2) conv_u(F.PROJ, row - 2, ch, u2); else if (smp) ld8f(F.sconv + ((size_t)b * 2 + t) * 256 + 8 * ch, u2); else {
#pragma unroll
            for (int e = 0; e < 8; ++e) u2[e] = 0.f; }
        unpack8(*(const v4u*)(F.PROJ + (size_t)row * NIN + 2304 + 8 * ch), bg);
        ld8f(F.conv_w + 8 * ch, w0); ld8f(F.conv_w + 256 + 8 * ch, w1); ld8f(F.conv_w + 512 + 8 * ch, w2);
        float y[8];
#pragma unroll
        for (int e = 0; e < 8; ++e) y[e] = bg[e] * (w0[e] * u2[e] + w1[e] * u1[e] + w2[e] * u0[e]);
        v4u o; o.x = pk2(y[0], y[1]); o.y = pk2(y[2], y[3]); o.z = pk2(y[4], y[5]); o.w = pk2(y[6], y[7]);
        *(v4u*)(F.MIX + (size_t)row * D + 768 + 8 * ch) = o;
    }
    for (int g = 0; g < 3; ++g) {
        const int W = 128 << (2 * g); float* dst = F.out + (g == 0 ? O_KVP0 : (g == 1 ? O_KVP1 : O_KVP2));
        for (int it = gt; it < 8 * W * 64; it += NGT) { const int ch = it & 31, sel = (it >> 5) & 1, br = it >> 6, rr = br % W, b = br / W;
            float f[8]; unpack8(*(const v4u*)(F.PROJ + ((size_t)b * TP + TP - W + rr) * NIN + 768 + sel * 768 + g * 256 + 8 * ch), f);
            float* o = dst + (size_t)it * 8; *(f32x4*)o = (f32x4){f[0], f[1], f[2], f[3]}; *(f32x4*)(o + 4) = (f32x4){f[4], f[5], f[6], f[7]}; }
        float* dsts = F.out + (g == 0 ? O_KVS0 : (g == 1 ? O_KVS1 : O_KVS2));
        for (int it = gt; it < 128 * 8 * 64; it += NGT) { const int ch = it & 31, sel = (it >> 5) & 1, bt = it >> 6, t = bt & 7, b = bt >> 3;
            float f[8]; unpack8(*(const v4u*)(F.PROJ + ((size_t)MP + b * 8 + t) * NIN + 768 + sel * 768 + g * 256 + 8 * ch), f);
            float* o = dsts + (((size_t)b * W + (W - 8 + t)) * 2 + sel) * 256 + 8 * ch; *(f32x4*)o = (f32x4){f[0], f[1], f[2], f[3]}; *(f32x4*)(o + 4) = (f32x4){f[4], f[5], f[6], f[7]}; }
        const float* src = pick3(g, F.c0, F.c1, F.c2);
        const int per_b = (W - 8) * 128;
        const int total = 128 * per_b;
#pragma unroll 4
        for (int it = gt; it < total; it += NGT) { const int b = it / per_b, k = it - b * per_b;
            const f32x4 v = __builtin_nontemporal_load((const f32x4*)(src + ((size_t)b * W + 8) * 512) + k);
            __builtin_nontemporal_store(v, (f32x4*)(dsts + (size_t)b * W * 512) + k); }
    }
    for (int it = gt; it < 8 * 2 * 32; it += NGT) { const int ch = it & 31, j = (it >> 5) & 1, b = it >> 6; float u[8]; conv_u(F.PROJ, (size_t)b * TP + TP - 2 + j, ch, u);
        float* o = F.out + O_CVP + (size_t)it * 8; *(f32x4*)o = (f32x4){u[0], u[1], u[2], u[3]}; *(f32x4*)(o + 4) = (f32x4){u[4], u[5], u[6], u[7]}; }
    for (int it = gt; it < 128 * 2 * 32; it += NGT) { const int ch = it & 31, j = (it >> 5) & 1, b = it >> 6; float u[8]; conv_u(F.PROJ, (size_t)MP + b * 8 + 6 + j, ch, u);
        float* o = F.out + O_CVS + (size_t)it * 8; *(f32x4*)o = (f32x4){u[0], u[1], u[2], u[3]}; *(f32x4*)(o + 4) = (f32x4){u[4], u[5], u[6], u[7]}; }
}
__device__ __forceinline__ void p2b_alpha(Frame& F) {
    const int gt = F.vcu * (NWAVES * 64) + F.tid, NGT = F.G * NWAVES * 64;
    for (int it = gt; it < M * 32; it += NGT) { const int row = it >> 5, h = (it >> 3) & 3, ch = it & 7;
        const float l0 = F.LSE[(size_t)row * 12 + h], l1 = F.LSE[(size_t)row * 12 + 4 + h], l2 = F.LSE[(size_t)row * 12 + 8 + h];
        const float mx = fmaxf(l0, fmaxf(l1, l2)); const float e0 = __builtin_amdgcn_exp2f(l0 - mx), e1 = __builtin_amdgcn_exp2f(l1 - mx), e2 = __builtin_amdgcn_exp2f(l2 - mx);
        const float inv = 1.0f / (e0 + e1 + e2); const float al[3] = {e0 * inv, e1 * inv, e2 * inv};
#pragma unroll
        for (int g = 0; g < 3; ++g) { v4u* p = (v4u*)(F.MIX + (size_t)row * D + g * 256 + h * 64 + 8 * ch); float f[8]; unpack8(*p, f);
            v4u o; o.x = pk2(f[0] * al[g], f[1] * al[g]); o.y = pk2(f[2] * al[g], f[3] * al[g]); o.z = pk2(f[4] * al[g], f[5] * al[g]); o.w = pk2(f[6] * al[g], f[7] * al[g]); *p = o; }
    }
}
__device__ __forceinline__ void p6_final(Frame& F) {
    const int gw = F.vcu * NWAVES + F.wave, NGW = F.G * NWAVES;
    f32x4 gf[4];
#pragma unroll
    for (int j = 0; j < 4; ++j) gf[j] = ((const f32x4*)F.g_fin)[F.lane + 64 * j];
    for (int m = gw; m < M; m += NGW) {
        const float sp = F.lane < 16 ? F.ST2[(size_t)m * 16 + F.lane] : 0.f;
        float ss = sp; ss += __shfl_xor(ss, 1); ss += __shfl_xor(ss, 2); ss += __shfl_xor(ss, 4); ss += __shfl_xor(ss, 8);
        ss = __shfl(ss, 0);
        const float rstd = __builtin_amdgcn_rsqf(ss * (1.0f / D) + EPS);
        f32x4* xr = (f32x4*)(F.out + (size_t)m * D) + F.lane;
#pragma unroll
        for (int j = 0; j < 4; ++j) { const f32x4 v = xr[64 * j]; xr[64 * j] = v * rstd * gf[j]; }
    }
}

struct Args { const float* in[14]; float* out; unsigned char* ws; int ph_lo, ph_hi; };
__global__ void __launch_bounds__(NWAVES * 64, 2) mega_fwd(Args args) {
    extern __shared__ __attribute__((aligned(16))) unsigned char lds[];
    cg::grid_group grid = cg::this_grid();
    Frame F;
    F.lds = (LAS unsigned char*)lds;
    F.tid = threadIdx.x; F.lane = F.tid & 63; F.wave = __builtin_amdgcn_readfirstlane(F.tid >> 6);
    F.G = gridDim.x; { const int bx = blockIdx.x; F.vcu = (F.G % 8 == 0) ? (bx % 8) * (F.G / 8) + bx / 8 : bx; }
    unsigned char* ws = args.ws;
    F.xp = args.in[0]; F.xs = args.in[1]; F.c0 = args.in[2]; F.c1 = args.in[3]; F.c2 = args.in[4]; F.sconv = args.in[5]; F.g_attn = args.in[6]; F.w_in = args.in[7];
    F.conv_w = args.in[8]; F.w_out = args.in[9]; F.g_mlp = args.in[10]; F.w_up = args.in[11]; F.w_down = args.in[12]; F.g_fin = args.in[13]; F.out = args.out;
    F.Win_t = (bf16*)(ws + WS_WIN); F.Wout_t = (bf16*)(ws + WS_WOUT); F.Wup_t = (bf16*)(ws + WS_WUP); F.Wdn_t = (bf16*)(ws + WS_WDN);
    F.XB = (bf16*)(ws + WS_XB); F.PROJ = (bf16*)(ws + WS_PROJ); F.MIX = (bf16*)(ws + WS_MIX); F.HB = (bf16*)(ws + WS_HB);
    F.RSTD0 = (float*)(ws + WS_RSTD0); F.ST1 = (float*)(ws + WS_ST1); F.ST2 = (float*)(ws + WS_ST2); F.LSE = (float*)(ws + WS_LSE);
    const int lo = args.ph_lo, hi = args.ph_hi;
#define IN(k) (lo <= (k) && (k) < hi)
#define SEAM(k) do { if (IN(k) && IN((k) + 1)) grid.sync(); } while (0)

    if (IN(0)) p0_prologue(F);
    SEAM(0);
    if (IN(1)) {
        pg8::Gemm g{F.XB, F.Win_t, M, NIN, D}; pg8::StaticOrder S; S.init(M, NIN, F.G, (int)blockIdx.x);
        pg8::EpiScaleBf16<0> E{F.PROJ, NIN, F.RSTD0, EPS};
        pg8::gemm_phase<pg8::EpiScaleBf16<0>, pg8::StaticOrder, PG8_ALIGN, PG8_SP2>(F.lds, g, S, E);
    }
    SEAM(1);
    if (IN(2)) p2_mixers(F);
    SEAM(2);
    if (IN(3)) p2b_alpha(F);
    SEAM(3);
    if (IN(4)) {
        pg8::Gemm g{F.MIX, F.Wout_t, M, D, D}; pg8::StaticOrder S; S.init(M, D, F.G, (int)blockIdx.x);
        pg8::EpiRes<true> E{F.xp, F.xs, MP, F.out, F.XB, F.ST1};
        pg8::gemm_phase<pg8::EpiRes<true>, pg8::StaticOrder, PG8_ALIGN, PG8_SP2>(F.lds, g, S, E);
    }
    SEAM(4);
    if (IN(5)) {
        pg8::Gemm g{F.XB, F.Wup_t, M, FF, D}; pg8::StaticOrder S; S.init(M, FF, F.G, (int)blockIdx.x);
        pg8::EpiScaleBf16<1> E{F.HB, FF, F.ST1, EPS};
        pg8::gemm_phase<pg8::EpiScaleBf16<1>, pg8::StaticOrder, PG8_ALIGN, PG8_SP2>(F.lds, g, S, E);
    }
    SEAM(5);
    if (IN(6)) {
        pg8::Gemm g{F.HB, F.Wdn_t, M, D, FF}; pg8::StaticOrder S; S.init(M, D, F.G, (int)blockIdx.x);
        pg8::EpiRes<false> E{F.out, F.out, 1 << 30, F.out, nullptr, F.ST2};
        pg8::gemm_phase<pg8::EpiRes<false>, pg8::StaticOrder, PG8_ALIGN, PG8_SP2>(F.lds, g, S, E);
    }
    SEAM(6);
    if (IN(7)) p6_final(F);
#undef IN
#undef SEAM
}

extern "C" void kernel_launch(void* const* d_in, const int* in_sizes, int n_in, void* d_out, int out_size, void* d_ws, size_t ws_size, hipStream_t stream) {
    static int grid = 0;
    if (grid == 0) {
        if (n_in != 14 || in_sizes[0] != MP * D || (size_t)out_size != O_END || ws_size < WS_END) { fprintf(stderr, "kernel_launch: unexpected shapes (n_in %d, in0 %d, out %d, ws %zu); nothing launched\n", n_in, n_in > 0 ? in_sizes[0] : -1, out_size, ws_size); grid = -1; return; }
        int dev = 0, cus = 0, per_cu = 0;
        if (hipGetDevice(&dev) != hipSuccess || hipDeviceGetAttribute(&cus, hipDeviceAttributeMultiprocessorCount, dev) != hipSuccess) { grid = -1; return; }
        if (hipFuncSetAttribute((const void*)mega_fwd, hipFuncAttributeMaxDynamicSharedMemorySize, LDS_BYTES) != hipSuccess) { fprintf(stderr, "kernel_launch: hipFuncSetAttribute failed\n"); grid = -1; return; }
        if (hipOccupancyMaxActiveBlocksPerMultiprocessor(&per_cu, (const void*)mega_fwd, NWAVES * 64, LDS_BYTES) != hipSuccess || per_cu < 1) { fprintf(stderr, "kernel_launch: occupancy query failed (%d)\n", per_cu); (void)hipGetLastError(); grid = -1; return; }
        grid = cus;
    }
    if (grid < 0) return;
    Args a{};
    for (int i = 0; i < 14; ++i) a.in[i] = (const float*)d_in[i];
    a.out = (float*)d_out; a.ws = (unsigned char*)d_ws;
    if (MK_N_LAUNCHES == 1) {
        a.ph_lo = 0; a.ph_hi = 8;
        void* kargs[] = {&a};
        const hipError_t e = hipLaunchCooperativeKernel((const void*)mega_fwd, dim3(grid), dim3(NWAVES * 64), kargs, LDS_BYTES, stream);
        if (e != hipSuccess) fprintf(stderr, "kernel_launch: cooperative launch failed: %s (grid %d)\n", hipGetErrorString(e), grid);
    } else {
        for (int p = 0; p < 8; ++p) { a.ph_lo = p; a.ph_hi = p + 1; hipLaunchKernelGGL(mega_fwd, dim3(grid), dim3(NWAVES * 64), LDS_BYTES, stream, a); }
    }
}
```

```cpp
#include <hip/hip_runtime.h>
#include <cstdio>
#include <cstdint>
#include <hip/hip_cooperative_groups.h>
namespace cg = cooperative_groups;
namespace pg8 {
#define PG8_LAS __attribute__((address_space(3)))
typedef unsigned short bf16_t;
typedef short bf16x8 __attribute__((ext_vector_type(8)));
typedef float f32x4 __attribute__((ext_vector_type(4)));
typedef unsigned u32x4 __attribute__((ext_vector_type(4)));
constexpr int BM = 256, BK = 64, HALF = 128, HTB = HALF * BK * 2  , STAGE_BYTES = 8 * HTB, NXCD = 8, WGM = 8;

__host__ __device__ __forceinline__ int lds_byte(int r, int c) { const int st = (r >> 4) * 2 + (c >> 5), rr = r & 15, cc = c & 31, ob = rr * 64 + cc * 2; return st * 1024 + (ob ^ (((ob >> 9) & 1) << 5)); }
__host__ __device__ __forceinline__ void stage_rc(int b, int& R, int& C) { const int st = b / 1024, sb = b % 1024, swz = sb ^ (((sb >> 9) & 1) << 5); R = (st >> 1) * 16 + swz / 64; C = (st & 1) * 32 + (swz % 64) / 2; }
__host__ __device__ __forceinline__ int perm32(int rho) { const int n = rho >> 4, i = rho & 15; return 8 * (i >> 2) + 4 * n + (i & 3); }

struct Unit { int pm, pn, lin; };
struct Gemm { const bf16_t* A; const bf16_t* Bt; int M, N, K; };

struct StaticOrder {
    int nM, nN, nwg, G, c;
    __host__ __device__ void init(int M, int N, int G_, int c_) { nM = M / BM; nN = N / BM; nwg = nM * nN; G = G_; c = c_; }
    __host__ __device__ bool next(int i, Unit& u) const {
        const long L = (long)i * G + c; if (L >= nwg) return false;
        int wgid = (int)L; { const int q = nwg / NXCD, r = nwg % NXCD, xcd = wgid % NXCD, off = wgid / NXCD; wgid = (xcd < r ? xcd * (q + 1) : r * (q + 1) + (xcd - r) * q) + off; }
        const int nig = WGM * nN, gid = wgid / nig, fm = gid * WGM, gsz = (nM - fm) < WGM ? (nM - fm) : WGM;
        u.pm = fm + ((wgid % nig) % gsz); u.pn = (wgid % nig) / gsz; u.lin = (int)L; return true;
    }
    __device__ __forceinline__ void a_ready(const Unit&) const {}
    __device__ __forceinline__ void done(const Unit&) const {}
};

__device__ __forceinline__ unsigned cvt_pk_bf16(float lo, float hi) { unsigned r; asm volatile("v_cvt_pk_bf16_f32 %0, %1, %2" : "=v"(r) : "v"(lo), "v"(hi)); return r; }
typedef float f32x2 __attribute__((ext_vector_type(2)));
constexpr int NCP = 6, CP_CHUNK = 512 * NCP;
constexpr int CP_C0 = 128 * 5, CP_C1 = 128 * 21, CP_C2 = 128 * 85, CP_NCHUNK = CP_C0 + CP_C1 + CP_C2;
struct CopyJob { const float *s0, *s1, *s2; float *d0, *d1, *d2; int base; };
__device__ __forceinline__ void cp_chunk(const CopyJob& cj, int chunk, const float*& sp, float*& dp, int& so, int& dof) {
    chunk = chunk >= CP_NCHUNK ? CP_NCHUNK - 1 : chunk;
    if (chunk < CP_C0) { const int b = chunk / 5, k = (chunk - b * 5) * CP_CHUNK; sp = cj.s0; dp = cj.d0; so = ((b * 128 + 8) * 128 + k) * 16; dof = (b * 128 * 128 + k) * 16; }
    else if (chunk < CP_C0 + CP_C1) { const int i = chunk - CP_C0, b = i / 21, k = (i - b * 21) * CP_CHUNK; sp = cj.s1; dp = cj.d1; so = ((b * 512 + 8) * 128 + k) * 16; dof = (b * 512 * 128 + k) * 16; }
    else { const int i = chunk - CP_C0 - CP_C1, b = i / 85, k = (i - b * 85) * CP_CHUNK; sp = cj.s2; dp = cj.d2; so = ((b * 2048 + 8) * 128 + k) * 16; dof = (b * 2048 * 128 + k) * 16; }
}
template <int MODE> struct EpiScaleBf16 {
    static constexpr bool PERM = true, AFTER_DRAIN = false;
    bf16_t* O; int ldc; const float* rs; float eps; CopyJob cj;
    __device__ __forceinline__ void operator()(const f32x4 (&acc)[2][2][4][2], const Unit& u, int wr, int wc, int fr, int fq) const {
        const int row0 = u.pm * BM + wr * 64 + fr; const int col0 = u.pn * BM + wc * 32 + 8 * fq;
        float sc[8];
        if (MODE == 0) {
#pragma unroll
            for (int i = 0; i < 8; ++i) sc[i] = rs[row0 + (i >> 2) * HALF + (i & 3) * 16];
        } else {
            f32x4 pv[8];
#pragma unroll
            for (int i = 0; i < 8; ++i) pv[i] = *(const f32x4*)(rs + (size_t)(row0 + (i >> 2) * HALF + (i & 3) * 16) * 16 + 4 * fq);
#pragma unroll
            for (int i = 0; i < 8; ++i) { float ss = (pv[i][0] + pv[i][1]) + (pv[i][2] + pv[i][3]); ss += __shfl_xor(ss, 16); ss += __shfl_xor(ss, 32);
                sc[i] = __builtin_amdgcn_rsqf(ss * (1.0f / 1024.0f) + eps); }
        }
        u32x4 cpa[NCP], cpb[NCP]; const float *spa, *spb; float *dpa, *dpb; int soa, sob, doa, dob;
        { const int ch = __builtin_amdgcn_readfirstlane(2 * (cj.base + u.lin)); cp_chunk(cj, ch, spa, dpa, soa, doa); cp_chunk(cj, ch + 1, spb, dpb, sob, dob); }
        const int toff = threadIdx.x * 16;
        { const __amdgpu_buffer_rsrc_t ra = __builtin_amdgcn_make_buffer_rsrc((void*)spa, 0, 0x7fffffff, 0x00020000), rb = __builtin_amdgcn_make_buffer_rsrc((void*)spb, 0, 0x7fffffff, 0x00020000);
#pragma unroll
          for (int j = 0; j < NCP; ++j) cpa[j] = __builtin_amdgcn_raw_buffer_load_b128(ra, toff, soa + j * 8192, 0);
#pragma unroll
          for (int j = 0; j < NCP; ++j) cpb[j] = __builtin_amdgcn_raw_buffer_load_b128(rb, toff, sob + j * 8192, 0); }
        asm volatile("" ::: "memory");
#pragma unroll
        for (int ai = 0; ai < 2; ++ai)
#pragma unroll
            for (int m = 0; m < 4; ++m) { const int row = row0 + ai * HALF + m * 16; const float s1 = sc[ai * 4 + m];
                bf16_t* rowp = O + (size_t)row * ldc + col0;
#pragma unroll
                for (int bj = 0; bj < 2; ++bj) { f32x4 v0 = acc[ai][bj][m][0] * s1, v1 = acc[ai][bj][m][1] * s1;
                    if (MODE == 1) {
#pragma unroll
                        for (int e = 0; e < 4; ++e) { const float x0 = fmaxf(v0[e], 0.f), x1 = fmaxf(v1[e], 0.f); v0[e] = x0 * x0; v1[e] = x1 * x1; } }
                    u32x4 w; w.x = cvt_pk_bf16(v0[0], v0[1]); w.y = cvt_pk_bf16(v0[2], v0[3]); w.z = cvt_pk_bf16(v1[0], v1[1]); w.w = cvt_pk_bf16(v1[2], v1[3]);
                    *(u32x4*)(rowp + bj * HALF) = w; } }
        asm volatile("" ::: "memory");
        { const __amdgpu_buffer_rsrc_t ra = __builtin_amdgcn_make_buffer_rsrc((void*)dpa, 0, 0x7fffffff, 0x00020000), rb = __builtin_amdgcn_make_buffer_rsrc((void*)dpb, 0, 0x7fffffff, 0x00020000);
#pragma unroll
          for (int j = 0; j < NCP; ++j) __builtin_amdgcn_raw_buffer_store_b128(cpa[j], ra, toff, doa + j * 8192, 0);
#pragma unroll
          for (int j = 0; j < NCP; ++j) __builtin_amdgcn_raw_buffer_store_b128(cpb[j], rb, toff, dob + j * 8192, 0); }
    }
};
template <bool WB> struct EpiRes {
    static constexpr bool PERM = false, AFTER_DRAIN = false;
    const float* base0; const float* base1; int split_row; float* out; bf16_t* xb; float* stats;
    __device__ __forceinline__ void operator()(const f32x4 (&acc)[2][2][4][2], const Unit& u, int wr, int wc, int fr, int fq) const {
        typedef unsigned u32x2v __attribute__((ext_vector_type(2)));
        const int col0 = u.pn * BM + wc * 32 + 4 * fq; const int rt0 = u.pm * BM;
        const float* base = rt0 < split_row ? base0 : base1; const int rsub = rt0 < split_row ? 0 : split_row;
#pragma unroll
        for (int ai = 0; ai < 2; ++ai)
#pragma unroll
            for (int m = 0; m < 4; ++m) { const int r = rt0 + ai * HALF + wr * 64 + m * 16 + fr; const size_t off = (size_t)r * 1024 + col0, offb = (size_t)(r - rsub) * 1024 + col0; float ss = 0.f;
#pragma unroll
                for (int bj = 0; bj < 2; ++bj)
#pragma unroll
                    for (int n = 0; n < 2; ++n) { const f32x4 bs = *(const f32x4*)(base + offb + bj * HALF + n * 16); const f32x4 o = bs + acc[ai][bj][m][n];
                        *(f32x4*)(out + off + bj * HALF + n * 16) = o;
                        if (WB) { u32x2v w; w.x = cvt_pk_bf16(o[0], o[1]); w.y = cvt_pk_bf16(o[2], o[3]); *(u32x2v*)(xb + off + bj * HALF + n * 16) = w; }
                        ss += (o[0] * o[0] + o[1] * o[1]) + (o[2] * o[2] + o[3] * o[3]); }
                ss += __shfl_xor(ss, 16); ss += __shfl_xor(ss, 32);
                if (fq == 0) stats[(size_t)r * 16 + u.pn * 4 + wc] = ss;
                if (m & 1) asm volatile("" ::: "memory"); }
    }
};

template <class Epi, class Sched, bool ALIGN_EPI = false, bool SP2 = false>
__device__ __forceinline__ void gemm_phase(PG8_LAS unsigned char* lds, const Gemm g, const Sched& S, const Epi& E) {
    const int tid = threadIdx.x, wid = __builtin_amdgcn_readfirstlane(tid >> 6), lane = tid & 63, wr = wid >> 2, wc = wid & 3, fr = lane & 15, fq = lane >> 4;
    const int K = g.K, nt = K / BK;
    unsigned voffA[2], voffB[2];
#pragma unroll
    for (int i = 0; i < 2; ++i) { int R, C; stage_rc(tid * 16 + i * 8192, R, C); const int Rb = Epi::PERM ? ((R & ~31) + perm32(R & 31)) : R;
        voffA[i] = (unsigned)(R * K + C) * 2u; voffB[i] = (unsigned)(Rb * K + C) * 2u; }
    const size_t kstep = (size_t)(BK * 2);
    const size_t hstep = (size_t)HALF * K * 2;
    const size_t tstep = 2 * hstep;
    const unsigned ldsw = (unsigned)wid * 1024u;
    const int aoff = lds_byte(wr * 64 + fr, fq * 8), boff = lds_byte(wc * 32 + fr, fq * 8);
#define PG8_SA(b, h) (((b) * 2 + (h)) * HTB)
#define PG8_SB(b, h) ((4 + (b) * 2 + (h)) * HTB)
#define PG8_STAGE(bufoff, gbase, voff) do { _Pragma("unroll") for (int _i = 0; _i < 2; ++_i) \
        __builtin_amdgcn_global_load_lds((const unsigned*)((const char*)(gbase) + (voff)[_i]), (PG8_LAS unsigned*)(lds + (bufoff) + ldsw + _i * 8192), 16, 0, 0); } while (0)
#define PG8_LDA(dst, b, h) do { _Pragma("unroll") for (int m = 0; m < 4; ++m) _Pragma("unroll") for (int k = 0; k < 2; ++k) dst[m][k] = *(const PG8_LAS bf16x8*)(lds + PG8_SA(b, h) + aoff + m * 2048 + k * 1024); } while (0)
#define PG8_LDB(dst, b, h) do { _Pragma("unroll") for (int n = 0; n < 2; ++n) _Pragma("unroll") for (int k = 0; k < 2; ++k) dst[n][k] = *(const PG8_LAS bf16x8*)(lds + PG8_SB(b, h) + boff + n * 2048 + k * 1024); } while (0)
#define PG8_MMA(ai, bj, At, Bt) do { __builtin_amdgcn_s_setprio(1); _Pragma("unroll") for (int m = 0; m < 4; ++m) _Pragma("unroll") for (int n = 0; n < 2; ++n) _Pragma("unroll") for (int k = 0; k < 2; ++k) \
        acc[ai][bj][m][n] = __builtin_amdgcn_mfma_f32_16x16x32_bf16(Bt[n][k], At[m][k], acc[ai][bj][m][n], 0, 0, 0); __builtin_amdgcn_s_setprio(0); } while (0)
#define PG8_WAIT_V(n) asm volatile("s_waitcnt vmcnt(" #n ")" ::: "memory")
#define PG8_WAIT_L(n) asm volatile("s_waitcnt lgkmcnt(" #n ")" ::: "memory")
#define PG8_BAR __builtin_amdgcn_s_barrier()
#define PG8_SCHED __builtin_amdgcn_sched_barrier(0)
    Unit cur, nxt; int ui = 0;
    if (!S.next(0, cur)) return;
    f32x4 acc[2][2][4][2];
#pragma unroll
    for (int a = 0; a < 2; ++a)
#pragma unroll
        for (int b = 0; b < 2; ++b)
#pragma unroll
            for (int m = 0; m < 4; ++m)
#pragma unroll
                for (int n = 0; n < 2; ++n) acc[a][b][m][n] = (f32x4){0.f, 0.f, 0.f, 0.f};
    bf16x8 At[4][2], B0[2][2], B1[2][2];
    const char* cA = (const char*)g.A + (size_t)cur.pm * tstep; const char* cB = (const char*)g.Bt + (size_t)cur.pn * tstep;
    S.a_ready(cur);
    if constexpr (SP2) {
        PG8_STAGE(PG8_SB(0, 0), cB, voffB); PG8_STAGE(PG8_SB(0, 1), cB + hstep, voffB); PG8_STAGE(PG8_SA(0, 0), cA, voffA); PG8_STAGE(PG8_SA(0, 1), cA + hstep, voffA);
        if (wr == 1) PG8_BAR;
        PG8_WAIT_V(2); PG8_BAR;
        PG8_STAGE(PG8_SB(1, 0), cB + kstep, voffB); PG8_STAGE(PG8_SA(1, 0), cA + kstep, voffA); PG8_STAGE(PG8_SB(1, 1), cB + hstep + kstep, voffB);
        PG8_WAIT_V(6); PG8_BAR;
    } else {
        PG8_STAGE(PG8_SB(0, 0), cB, voffB); PG8_STAGE(PG8_SA(0, 0), cA, voffA); PG8_STAGE(PG8_SB(0, 1), cB + hstep, voffB); PG8_STAGE(PG8_SA(0, 1), cA + hstep, voffA);
        if (wr == 1) PG8_BAR;
        PG8_WAIT_V(4); PG8_BAR;
        PG8_STAGE(PG8_SB(1, 0), cB + kstep, voffB); PG8_STAGE(PG8_SA(1, 0), cA + kstep, voffA); PG8_STAGE(PG8_SB(1, 1), cB + hstep + kstep, voffB);
        PG8_WAIT_V(6); PG8_BAR;
    }
    for (;;) {
        const bool has_next = S.next(ui + 1, nxt);
        const char* nA = has_next ? (const char*)g.A + (size_t)nxt.pm * tstep : cA; const char* nB = has_next ? (const char*)g.Bt + (size_t)nxt.pn * tstep : cB;
        for (int t = 0; t < nt; t += 2) {
            const bool last = (t == nt - 2);
            const char* a1 = cA + (size_t)(t + 1) * kstep;
            const char* a2 = last ? nA : cA + (size_t)(t + 2) * kstep; const char* b2 = last ? nB : cB + (size_t)(t + 2) * kstep;
            const char* a3 = a2 + kstep; const char* b3 = b2 + kstep;
            if (last && has_next) S.a_ready(nxt);
            if constexpr (SP2) {
            PG8_LDB(B0, 0, 0); PG8_LDB(B1, 0, 1); PG8_SCHED; PG8_LDA(At, 0, 0); PG8_STAGE(PG8_SA(1, 1), a1 + hstep, voffA);
            PG8_WAIT_V(8); PG8_WAIT_L(0); PG8_BAR; PG8_MMA(0, 0, At, B0); PG8_MMA(0, 1, At, B1); PG8_BAR; PG8_SCHED;
            PG8_LDA(At, 0, 1); PG8_STAGE(PG8_SB(0, 0), b2, voffB); PG8_STAGE(PG8_SB(0, 1), b2 + hstep, voffB); PG8_STAGE(PG8_SA(0, 0), a2, voffA);
            PG8_WAIT_V(8); PG8_WAIT_L(0); PG8_BAR; PG8_MMA(1, 0, At, B0); PG8_MMA(1, 1, At, B1); PG8_BAR; PG8_SCHED;
            PG8_LDB(B0, 1, 0); PG8_LDB(B1, 1, 1); PG8_SCHED; PG8_LDA(At, 1, 0); PG8_STAGE(PG8_SA(0, 1), a2 + hstep, voffA);
            PG8_WAIT_V(8); PG8_WAIT_L(0); PG8_BAR; PG8_MMA(0, 0, At, B0); PG8_MMA(0, 1, At, B1); PG8_BAR; PG8_SCHED;
            PG8_LDA(At, 1, 1); PG8_STAGE(PG8_SB(1, 0), b3, voffB); PG8_STAGE(PG8_SB(1, 1), b3 + hstep, voffB); PG8_STAGE(PG8_SA(1, 0), a3, voffA);
            PG8_WAIT_V(8); PG8_WAIT_L(0); PG8_BAR; PG8_MMA(1, 0, At, B0); PG8_MMA(1, 1, At, B1); PG8_BAR; PG8_SCHED;
            } else {
            PG8_LDB(B0, 0, 0); PG8_SCHED; PG8_LDA(At, 0, 0); PG8_STAGE(PG8_SA(1, 1), a1 + hstep, voffA);
            PG8_WAIT_L(8); PG8_BAR; PG8_WAIT_L(0); PG8_MMA(0, 0, At, B0); PG8_BAR; PG8_SCHED;
            PG8_LDB(B1, 0, 1); PG8_STAGE(PG8_SB(0, 0), b2, voffB);
            PG8_BAR; PG8_WAIT_L(0); PG8_MMA(0, 1, At, B1); PG8_BAR;
            PG8_LDA(At, 0, 1); PG8_STAGE(PG8_SA(0, 0), a2, voffA);
            PG8_BAR; PG8_WAIT_L(0); PG8_MMA(1, 0, At, B0); PG8_BAR; PG8_SCHED;
            PG8_STAGE(PG8_SB(0, 1), b2 + hstep, voffB);
            PG8_WAIT_V(6); PG8_BAR; PG8_MMA(1, 1, At, B1); PG8_BAR;
            PG8_LDB(B0, 1, 0); PG8_SCHED; PG8_LDA(At, 1, 0); PG8_STAGE(PG8_SA(0, 1), a2 + hstep, voffA);
            PG8_WAIT_L(8); PG8_BAR; PG8_WAIT_L(0); PG8_MMA(0, 0, At, B0); PG8_BAR; PG8_SCHED;
            PG8_LDB(B1, 1, 1); PG8_STAGE(PG8_SB(1, 0), b3, voffB);
            PG8_BAR; PG8_WAIT_L(0); PG8_MMA(0, 1, At, B1); PG8_BAR;
            PG8_LDA(At, 1, 1); PG8_STAGE(PG8_SA(1, 0), a3, voffA);
            PG8_BAR; PG8_WAIT_L(0); PG8_MMA(1, 0, At, B0); PG8_BAR; PG8_SCHED;
            PG8_STAGE(PG8_SB(1, 1), b3 + hstep, voffB);
            PG8_WAIT_V(6); PG8_BAR; PG8_MMA(1, 1, At, B1); PG8_BAR;
            }
        }
        if constexpr (ALIGN_EPI) { if (wr == 0) PG8_BAR; }
        if constexpr (!Epi::AFTER_DRAIN) { E(acc, cur, wr, wc, fr, fq); S.done(cur); }
        if (!has_next) break;
#pragma unroll
        for (int a = 0; a < 2; ++a)
#pragma unroll
            for (int b = 0; b < 2; ++b)
#pragma unroll
                for (int m = 0; m < 4; ++m)
#pragma unroll
                    for (int n = 0; n < 2; ++n) acc[a][b][m][n] = (f32x4){0.f, 0.f, 0.f, 0.f};
        cur = nxt; cA = nA; cB = nB; ++ui;
        if constexpr (ALIGN_EPI) { if (wr == 1) PG8_BAR; }
    }
    PG8_WAIT_V(0);
    if constexpr (!ALIGN_EPI) { if (wr == 0) PG8_BAR; }
    PG8_BAR;
    if constexpr (Epi::AFTER_DRAIN) { E.fused(acc, cur, wr, wc, fr, fq, lds, wid, lane); S.done(cur); }
#undef PG8_SA
#undef PG8_SB
#undef PG8_STAGE
#undef PG8_LDA
#undef PG8_LDB
#undef PG8_MMA
#undef PG8_WAIT_V
#undef PG8_WAIT_L
#undef PG8_BAR
#undef PG8_SCHED
}
}
#ifndef PG8_SP2
#define PG8_SP2 true
#endif
#ifndef PG8_ALIGN
#define PG8_ALIGN true
#endif
#ifndef PROBE_REP
#define PROBE_REP -1
#endif
#ifndef MK_N_LAUNCHES
#define MK_N_LAUNCHES 1
#endif

constexpr int D = 1024, FF = 4096, NIN = 3072;
constexpr int MP = 8 * 8192, MS = 128 * 8, M = MP + MS;
constexpr int TP = 8192;
constexpr float EPS = 1e-6f;
constexpr int NWAVES = 8;
#define GAS __attribute__((address_space(1)))
#define LAS __attribute__((address_space(3)))
typedef unsigned short bf16;
typedef unsigned v4u __attribute__((ext_vector_type(4)));
typedef unsigned v2u __attribute__((ext_vector_type(2)));
typedef float f32x4 __attribute__((ext_vector_type(4)));
typedef short bf16x8 __attribute__((ext_vector_type(8)));
typedef short s16x4 __attribute__((ext_vector_type(4)));
typedef float f32x16 __attribute__((ext_vector_type(16)));

constexpr size_t MiB = 1u << 20;
constexpr size_t WS_WIN = 0, WS_WOUT = 6 * MiB, WS_WUP = 8 * MiB, WS_WDN = 16 * MiB;
constexpr size_t WS_RSTD0 = 24 * MiB;
constexpr size_t WS_ST1 = 25 * MiB, WS_ST2 = 30 * MiB;
constexpr size_t WS_LSE = 35 * MiB;
constexpr size_t WS_XB = 40 * MiB;
constexpr size_t WS_PROJ = 172 * MiB;
constexpr size_t WS_MIX = 564 * MiB;
constexpr size_t WS_HB = 696 * MiB;
constexpr size_t WS_END = 1220 * MiB;
static_assert(WS_XB + (size_t)M * D * 2 <= WS_PROJ && WS_PROJ + (size_t)M * NIN * 2 <= WS_MIX && WS_MIX + (size_t)M * D * 2 <= WS_HB && WS_HB + (size_t)M * FF * 2 <= WS_END, "d_ws map");
static_assert(WS_ST1 + (size_t)M * 64 <= WS_ST2 && WS_ST2 + (size_t)M * 64 <= WS_LSE && WS_LSE + (size_t)M * 48 <= WS_XB, "d_ws map 2");

constexpr size_t O_Y = 0;
constexpr size_t O_KVP0 = (size_t)M * D;
constexpr size_t O_KVP1 = O_KVP0 + 8ull * 128 * 512;
constexpr size_t O_KVP2 = O_KVP1 + 8ull * 512 * 512;
constexpr size_t O_CVP = O_KVP2 + 8ull * 2048 * 512;
constexpr size_t O_KVS0 = O_CVP + 8ull * 2 * 256;
constexpr size_t O_KVS1 = O_KVS0 + 128ull * 128 * 512;
constexpr size_t O_KVS2 = O_KVS1 + 128ull * 512 * 512;
constexpr size_t O_CVS = O_KVS2 + 128ull * 2048 * 512;
constexpr size_t O_END = O_CVS + 128ull * 2 * 256;

constexpr int LDS_BYTES = 147456;

__device__ __forceinline__ unsigned f2bf(float f) { unsigned u = __builtin_bit_cast(unsigned, f); return (u + 0x7fffu + ((u >> 16) & 1u)) >> 16; }
__device__ __forceinline__ unsigned pk2(float lo, float hi) { return f2bf(lo) | (f2bf(hi) << 16); }
__device__ __forceinline__ float bflo(unsigned w) { return __builtin_bit_cast(float, w << 16); }
__device__ __forceinline__ float bfhi(unsigned w) { return __builtin_bit_cast(float, w & 0xffff0000u); }
__device__ __forceinline__ float wave_sum(float v) {
#pragma unroll
    for (int o = 1; o < 64; o <<= 1) v += __shfl_xor(v, o);
    return v;
}

__device__ __forceinline__ const float* pick3(int g, const float* a, const float* b, const float* c) { return g == 0 ? a : (g == 1 ? b : c); }
struct Frame {
    LAS unsigned char* lds;
    int tid, lane, wave, vcu, G;
    const float *xp, *xs, *c0, *c1, *c2, *sconv, *g_attn, *w_in, *conv_w, *w_out, *g_mlp, *w_up, *w_down, *g_fin;
    float* out;
    bf16 *Win_t, *Wout_t, *Wup_t, *Wdn_t, *XB, *PROJ, *MIX, *HB;
    float *RSTD0, *ST1, *ST2, *LSE;
};

__device__ __forceinline__ void p0_transpose_item(const float* W, const float* gk, int K, int N, bf16* WT, LAS float* scr, int item, int lane) {
    const int nblk = N / 32, kb = item / nblk, nb = item % nblk, k0 = 64 * kb, n0 = 32 * nb;
#pragma unroll 8
    for (int i = 0; i < 32; ++i) { const int kk = 2 * i + (lane >> 5); float v = W[(size_t)(k0 + kk) * N + n0 + (lane & 31)]; if (gk) v *= gk[k0 + kk]; scr[kk * 33 + (lane & 31)] = v; }
    asm volatile("s_waitcnt lgkmcnt(0)" ::: "memory");
    const int c = lane & 7;
#pragma unroll
    for (int j = 0; j < 4; ++j) { const int n = (lane >> 3) + 8 * j; const LAS float* s = scr + (8 * c) * 33 + n;
        v4u o; o.x = pk2(s[0 * 33], s[1 * 33]); o.y = pk2(s[2 * 33], s[3 * 33]); o.z = pk2(s[4 * 33], s[5 * 33]); o.w = pk2(s[6 * 33], s[7 * 33]);
        *(v4u*)(WT + (size_t)(n0 + n) * K + k0 + 8 * c) = o; }
    asm volatile("s_waitcnt lgkmcnt(0)" ::: "memory");
}
__device__ __forceinline__ void p0_prologue(Frame& F) {
    LAS float* scr = (LAS float*)(F.lds + F.wave * 16384);
    const int gw = F.vcu * NWAVES + F.wave, NGW = F.G * NWAVES;
    constexpr int I_IN = (D / 64) * (NIN / 32), I_O = (D / 64) * (D / 32), I_UP = (D / 64) * (FF / 32), I_DN = (FF / 64) * (D / 32);
    constexpr int NITEMS = I_IN + I_O + I_UP + I_DN;
    for (int it = gw; it < NITEMS; it += NGW) {
        int r = it;
        if (r < I_IN) { p0_transpose_item(F.w_in, F.g_attn, D, NIN, F.Win_t, scr, r, F.lane); continue; } r -= I_IN;
        if (r < I_O) { p0_transpose_item(F.w_out, nullptr, D, D, F.Wout_t, scr, r, F.lane); continue; } r -= I_O;
        if (r < I_UP) { p0_transpose_item(F.w_up, F.g_mlp, D, FF, F.Wup_t, scr, r, F.lane); continue; } r -= I_UP;
        p0_transpose_item(F.w_down, nullptr, FF, D, F.Wdn_t, scr, r, F.lane);
    }
    for (int m = gw; m < M; m += NGW) {
        const float* xrow = m < MP ? F.xp + (size_t)m * D : F.xs + (size_t)(m - MP) * D;
        const f32x4* xr = (const f32x4*)xrow + F.lane;
        f32x4 v[4]; float s = 0.f;
#pragma unroll
        for (int j = 0; j < 4; ++j) { v[j] = xr[64 * j]; s += (v[j].x * v[j].x + v[j].y * v[j].y) + (v[j].z * v[j].z + v[j].w * v[j].w); }
        s = wave_sum(s);
        v2u* o8 = (v2u*)(F.XB + (size_t)m * D) + F.lane;
#pragma unroll
        for (int j = 0; j < 4; ++j) { v2u w; w.x = pk2(v[j].x, v[j].y); w.y = pk2(v[j].z, v[j].w); o8[64 * j] = w; }
        if (F.lane == 0) F.RSTD0[m] = __builtin_amdgcn_rsqf(s * (1.0f / D) + EPS);
    }
}

namespace att {
constexpr int VP = 144;
constexpr float C2 = 0.125f * 1.4426950408889634f;
__device__ __forceinline__ int crow(int r, int hi) { return (r & 3) + 8 * (r >> 2) + 4 * hi; }
__device__ __forceinline__ s16x4 vtr(const LAS unsigned char* p) { return __builtin_bit_cast(s16x4, __builtin_amdgcn_ds_read_tr16_b64_v4i16((LAS s16x4*)p)); }
__device__ __forceinline__ unsigned cvtpk(float lo, float hi) { typedef float f2 __attribute__((ext_vector_type(2))); typedef __bf16 b2 __attribute__((ext_vector_type(2))); f2 v = {lo, hi}; b2 b = __builtin_convertvector(v, b2); return __builtin_bit_cast(unsigned, b); }

__device__ __forceinline__ void prompt_unit(const bf16* __restrict__ proj, bf16* __restrict__ mixed, float* __restrict__ lse, LAS unsigned char* lds, int b, int g, int h, int r, int c) {
    const int tid = threadIdx.x, lane = tid & 63, wid = __builtin_amdgcn_readfirstlane(tid >> 6), a = lane & 31, hi = lane >> 5;
    const int s = 2 * g, i0 = c * 256;
    const size_t rowb = (size_t)b * TP;
    const int colq = g * 256 + h * 64, colk = 768 + colq, colv = 1536 + colq;
    __syncthreads();
#pragma unroll
    for (int i = 0; i < 6; ++i) {
        const int id = tid + 512 * i, kk = id >> 3, ch = id & 7; int ii = i0 - 128 + kk; ii = ii < 0 ? 0 : ii;
        const v4u v = *(const v4u*)(proj + (rowb + ((size_t)ii << s) + r) * NIN + colv + ch * 8);
        *(LAS v4u*)(lds + kk * VP + ch * 16) = v;
    }
    const int qs = i0 + 32 * wid;
    bf16x8 qf[4];
    { const bf16* qp = proj + (rowb + ((size_t)(qs + a) << s) + r) * NIN + colq + hi * 8;
#pragma unroll
      for (int d0 = 0; d0 < 4; ++d0) qf[d0] = *(const bf16x8*)(qp + d0 * 16); }
    f32x16 S[5];
#pragma unroll
    for (int kb = 0; kb < 5; ++kb) {
        int ii = qs - 128 + 32 * kb + a; ii = ii < 0 ? 0 : ii;
        const bf16* kp = proj + (rowb + ((size_t)ii << s) + r) * NIN + colk + hi * 8;
        bf16x8 kf[4];
#pragma unroll
        for (int d0 = 0; d0 < 4; ++d0) kf[d0] = *(const bf16x8*)(kp + d0 * 16);
        f32x16 acc = {};
#pragma unroll
        for (int d0 = 0; d0 < 4; ++d0) acc = __builtin_amdgcn_mfma_f32_32x32x16_bf16(kf[d0], qf[d0], acc, 0, 0, 0);
        S[kb] = acc;
    }
    float mx = -INFINITY;
#pragma unroll
    for (int kb = 0; kb < 5; ++kb)
#pragma unroll
        for (int rr = 0; rr < 16; ++rr) { const int key = crow(rr, hi), ii = qs - 128 + 32 * kb + key;
            bool valid = ii >= 0; if (kb == 0) valid = valid && (key >= a); if (kb == 4) valid = valid && (key <= a);
            const float v = valid ? S[kb][rr] * C2 : -INFINITY; S[kb][rr] = v; mx = fmaxf(mx, v); }
    mx = fmaxf(mx, __shfl_xor(mx, 32));
    float l = 0.f;
#pragma unroll
    for (int kb = 0; kb < 5; ++kb)
#pragma unroll
        for (int rr = 0; rr < 16; ++rr) { const float p = __builtin_amdgcn_exp2f(S[kb][rr] - mx); S[kb][rr] = p; l += p; }
    l += __shfl_xor(l, 32);
    __syncthreads();
    f32x16 o[2]; o[0] = f32x16{}; o[1] = f32x16{};
    const LAS unsigned char* vbase = lds + (32 * wid + 4 * hi + ((lane & 15) >> 2)) * VP + (16 * ((lane >> 4) & 1) + 4 * (lane & 3)) * 2;
#pragma unroll
    for (int kb = 0; kb < 5; ++kb)
#pragma unroll
        for (int st = 0; st < 2; ++st) {
            v4u pw; pw.x = cvtpk(S[kb][8 * st + 0], S[kb][8 * st + 1]); pw.y = cvtpk(S[kb][8 * st + 2], S[kb][8 * st + 3]); pw.z = cvtpk(S[kb][8 * st + 4], S[kb][8 * st + 5]); pw.w = cvtpk(S[kb][8 * st + 6], S[kb][8 * st + 7]);
            const bf16x8 pa = __builtin_bit_cast(bf16x8, pw);
#pragma unroll
            for (int cc = 0; cc < 2; ++cc) {
                const s16x4 lo = vtr(vbase + (32 * kb + 16 * st) * VP + cc * 64), hh = vtr(vbase + (32 * kb + 16 * st + 8) * VP + cc * 64);
                const bf16x8 vf = (bf16x8){lo[0], lo[1], lo[2], lo[3], hh[0], hh[1], hh[2], hh[3]};
                o[cc] = __builtin_amdgcn_mfma_f32_32x32x16_bf16(pa, vf, o[cc], 0, 0, 0);
            }
        }
    const float linv = 1.0f / l;
#pragma unroll
    for (int rr = 0; rr < 16; ++rr) { const int q = crow(rr, hi); const float li = __shfl(linv, q);
        bf16* op = mixed + (rowb + ((size_t)(qs + q) << s) + r) * D + colq + a;
        op[0] = (bf16)f2bf(o[0][rr] * li); op[32] = (bf16)f2bf(o[1][rr] * li); }
    if (hi == 0) lse[(rowb + ((size_t)(qs + a) << s) + r) * 12 + g * 4 + h] = mx + __builtin_amdgcn_logf(l);
}

__device__ __forceinline__ f32x4 kv_fetch(const float* __restrict__ cache, const bf16* __restrict__ proj, int W, int b, int idx, int sel, int g, int h, int c) {
    if (idx >= W) { const v2u w = *(const v2u*)(proj + (size_t)(MP + b * 8 + (idx - W)) * NIN + 768 + sel * 768 + g * 256 + h * 64 + 4 * c); return (f32x4){bflo(w.x), bfhi(w.x), bflo(w.y), bfhi(w.y)}; }
    return *(const f32x4*)(cache + (((size_t)b * W + idx) * 2 + sel) * 256 + h * 64 + 4 * c);
}
__device__ __forceinline__ void sample_task(Frame& F, int task) {
    const int t = task & 7, h = (task >> 3) & 3, bg = task >> 5, g = bg % 3, b = bg / 3;
    const int lane = F.lane, rg = lane >> 4, c = lane & 15;
    const int W = 128 << (2 * g), d = 1 << (2 * g);
    const float* cache = pick3(g, F.c0, F.c1, F.c2);
    const size_t qrow = (size_t)MP + b * 8 + t;
    f32x4 q; { const v2u w = *(const v2u*)(F.PROJ + qrow * NIN + g * 256 + h * 64 + 4 * c); q = (f32x4){bflo(w.x), bfhi(w.x), bflo(w.y), bfhi(w.y)}; }
    float sc[33];
#pragma unroll
    for (int i0 = 0; i0 < 33; i0 += 11) {
        f32x4 kv[11];
#pragma unroll
        for (int i = 0; i < 11; ++i) { int j = 4 * (i0 + i) + rg; j = j > 128 ? 128 : j; kv[i] = kv_fetch(cache, F.PROJ, W, b, W + t - d * j, 0, g, h, c); }
#pragma unroll
        for (int i = 0; i < 11; ++i) { float p = (kv[i][0] * q[0] + kv[i][1] * q[1]) + (kv[i][2] * q[2] + kv[i][3] * q[3]);
            p += __shfl_xor(p, 1); p += __shfl_xor(p, 2); p += __shfl_xor(p, 4); p += __shfl_xor(p, 8);
            const int j = 4 * (i0 + i) + rg; sc[i0 + i] = j <= 128 ? p * C2 : -INFINITY; }
    }
    float mx = sc[0];
#pragma unroll
    for (int i = 1; i < 33; ++i) mx = fmaxf(mx, sc[i]);
    mx = fmaxf(mx, __shfl_xor(mx, 16)); mx = fmaxf(mx, __shfl_xor(mx, 32));
    float l = 0.f;
#pragma unroll
    for (int i = 0; i < 33; ++i) { sc[i] = __builtin_amdgcn_exp2f(sc[i] - mx); l += sc[i]; }
    l += __shfl_xor(l, 16); l += __shfl_xor(l, 32);
    f32x4 o = {0.f, 0.f, 0.f, 0.f};
#pragma unroll
    for (int i0 = 0; i0 < 33; i0 += 11) {
        f32x4 kv[11];
#pragma unroll
        for (int i = 0; i < 11; ++i) { int j = 4 * (i0 + i) + rg; j = j > 128 ? 128 : j; kv[i] = kv_fetch(cache, F.PROJ, W, b, W + t - d * j, 1, g, h, c); }
#pragma unroll
        for (int i = 0; i < 11; ++i) o += kv[i] * sc[i0 + i];
    }
#pragma unroll
    for (int e = 0; e < 4; ++e) { float v = o[e]; v += __shfl_xor(v, 16); v += __shfl_xor(v, 32); o[e] = v; }
    const float li = 1.0f / l;
    if (rg == 0) { v2u w; w.x = pk2(o[0] * li, o[1] * li); w.y = pk2(o[2] * li, o[3] * li); *(v2u*)(F.MIX + qrow * D + g * 256 + h * 64 + 4 * c) = w; }
    if (lane == 0) F.LSE[qrow * 12 + g * 4 + h] = mx + __builtin_amdgcn_logf(l);
}
}

__device__ __forceinline__ void unpack8(const v4u w, float (&f)[8]) { f[0] = bflo(w.x); f[1] = bfhi(w.x); f[2] = bflo(w.y); f[3] = bfhi(w.y); f[4] = bflo(w.z); f[5] = bfhi(w.z); f[6] = bflo(w.w); f[7] = bfhi(w.w); }
__device__ __forceinline__ void conv_u(const bf16* proj, size_t row, int ch, float (&u)[8]) {
    float cf[8], hf[8]; unpack8(*(const v4u*)(proj + row * NIN + 2560 + 8 * ch), cf); unpack8(*(const v4u*)(proj + row * NIN + 2816 + 8 * ch), hf);
#pragma unroll
    for (int e = 0; e < 8; ++e) u[e] = cf[e] * hf[e];
}
__device__ __forceinline__ void ld8f(const float* p, float (&u)[8]) { const f32x4 a = *(const f32x4*)p, b = *(const f32x4*)(p + 4); u[0] = a[0]; u[1] = a[1]; u[2] = a[2]; u[3] = a[3]; u[4] = b[0]; u[5] = b[1]; u[6] = b[2]; u[7] = b[3]; }

__device__ __forceinline__ void p2_mixers(Frame& F) {
    const int gt = F.vcu * (NWAVES * 64) + F.tid, NGT = F.G * NWAVES * 64;
    for (int u = F.vcu; u < 8 * 12 * 32; u += F.G) {
        const int sub = u & 31, bgh = u >> 5, h = bgh & 3, g = (bgh >> 2) % 3, b = bgh / 12;
        const int cpc = 32 >> (2 * g), r = sub / cpc, c = sub % cpc;
        att::prompt_unit(F.PROJ, F.MIX, F.LSE, F.lds, b, g, h, r, c);
    }
    for (int task = F.vcu * NWAVES + F.wave; task < 128 * 12 * 8; task += F.G * NWAVES) att::sample_task(F, task);
    for (int it = gt; it < M * 32; it += NGT) {
        const int row = it >> 5, ch = it & 31;
        int t, b; const bool smp = row >= MP; if (smp) { const int rs = row - MP; b = rs >> 3; t = rs & 7; } else { b = row >> 13; t = row & (TP - 1); }
        float u0[8], u1[8], u2[8], bg[8], w0[8], w1[8], w2[8];
        conv_u(F.PROJ, row, ch, u0);
        if (t >= 1) conv_u(F.PROJ, row - 1, ch, u1); else if (smp) ld8f(F.sconv + ((size_t)b * 2 + 1) * 256 + 8 * ch, u1); else {
#pragma unroll
            for (int e = 0; e < 8; ++e) u1[e] = 0.f; }
        if (t >= 2) conv_u(F.PROJ, row - 2, ch, u2); else if (smp) ld8f(F.sconv + ((size_t)b * 2 + t) * 256 + 8 * ch, u2); else {
#pragma unroll
            for (int e = 0; e < 8; ++e) u2[e] = 0.f; }
        unpack8(*(const v4u*)(F.PROJ + (size_t)row * NIN + 2304 + 8 * ch), bg);
        ld8f(F.conv_w + 8 * ch, w0); ld8f(F.conv_w + 256 + 8 * ch, w1); ld8f(F.conv_w + 512 + 8 * ch, w2);
        float y[8];
#pragma unroll
        for (int e = 0; e < 8; ++e) y[e] = bg[e] * (w0[e] * u2[e] + w1[e] * u1[e] + w2[e] * u0[e]);
        v4u o; o.x = pk2(y[0], y[1]); o.y = pk2(y[2], y[3]); o.z = pk2(y[4], y[5]); o.w = pk2(y[6], y[7]);
        *(v4u*)(F.MIX + (size_t)row * D + 768 + 8 * ch) = o;
    }
    for (int g = 0; g < 3; ++g) {
        const int W = 128 << (2 * g); float* dst = F.out + (g == 0 ? O_KVP0 : (g == 1 ? O_KVP1 : O_KVP2));
        for (int it = gt; it < 8 * W * 64; it += NGT) { const int ch = it & 31, sel = (it >> 5) & 1, br = it >> 6, rr = br % W, b = br / W;
            float f[8]; unpack8(*(const v4u*)(F.PROJ + ((size_t)b * TP + TP - W + rr) * NIN + 768 + sel * 768 + g * 256 + 8 * ch), f);
            float* o = dst + (size_t)it * 8; *(f32x4*)o = (f32x4){f[0], f[1], f[2], f[3]}; *(f32x4*)(o + 4) = (f32x4){f[4], f[5], f[6], f[7]}; }
        float* dsts = F.out + (g == 0 ? O_KVS0 : (g == 1 ? O_KVS1 : O_KVS2));
        for (int it = gt; it < 128 * 8 * 64; it += NGT) { const int ch = it & 31, sel = (it >> 5) & 1, bt = it >> 6, t = bt & 7, b = bt >> 3;
            float f[8]; unpack8(*(const v4u*)(F.PROJ + ((size_t)MP + b * 8 + t) * NIN + 768 + sel * 768 + g * 256 + 8 * ch), f);
            float* o = dsts + (((size_t)b * W + (W - 8 + t)) * 2 + sel) * 256 + 8 * ch; *(f32x4*)o = (f32x4){f[0], f[1], f[2], f[3]}; *(f32x4*)(o + 4) = (f32x4){f[4], f[5], f[6], f[7]}; }
    }
    for (int it = gt; it < 8 * 2 * 32; it += NGT) { const int ch = it & 31, j = (it >> 5) & 1, b = it >> 6; float u[8]; conv_u(F.PROJ, (size_t)b * TP + TP - 2 + j, ch, u);
        float* o = F.out + O_CVP + (size_t)it * 8; *(f32x4*)o = (f32x4){u[0], u[1], u[2], u[3]}; *(f32x4*)(o + 4) = (f32x4){u[4], u[5], u[6], u[7]}; }
    for (int it = gt; it < 128 * 2 * 32; it += NGT) { const int ch = it & 31, j = (it >> 5) & 1, b = it >> 6; float u[8]; conv_u(F.PROJ, (size_t)MP + b * 8 + 6 + j, ch, u);
        float* o = F.out + O_CVS + (size_t)it * 8; *(f32x4*)o = (f32x4){u[0], u[1], u[2], u[3]}; *(f32x4*)(o + 4) = (f32x4){u[4], u[5], u[6], u[7]}; }
}
__device__ __forceinline__ void p2b_alpha(Frame& F) {
    const int gt = F.vcu * (NWAVES * 64) + F.tid, NGT = F.G * NWAVES * 64;
    for (int it = gt; it < M * 32; it += NGT) { const int row = it >> 5, h = (it >> 3) & 3, ch = it & 7;
        const float l0 = F.LSE[(size_t)row * 12 + h], l1 = F.LSE[(size_t)row * 12 + 4 + h], l2 = F.LSE[(size_t)row * 12 + 8 + h];
        const float mx = fmaxf(l0, fmaxf(l1, l2)); const float e0 = __builtin_amdgcn_exp2f(l0 - mx), e1 = __builtin_amdgcn_exp2f(l1 - mx), e2 = __builtin_amdgcn_exp2f(l2 - mx);
        const float inv = 1.0f / (e0 + e1 + e2); const float al[3] = {e0 * inv, e1 * inv, e2 * inv};
#pragma unroll
        for (int g = 0; g < 3; ++g) { v4u* p = (v4u*)(F.MIX + (size_t)row * D + g * 256 + h * 64 + 8 * ch); float f[8]; unpack8(*p, f);
            v4u o; o.x = pk2(f[0] * al[g], f[1] * al[g]); o.y = pk2(f[2] * al[g], f[3] * al[g]); o.z = pk2(f[4] * al[g], f[5] * al[g]); o.w = pk2(f[6] * al[g], f[7] * al[g]); *p = o; }
    }
}
__device__ __forceinline__ void p6_final(Frame& F) {
    const int gw = F.vcu * NWAVES + F.wave, NGW = F.G * NWAVES;
    f32x4 gf[4];
#pragma unroll
    for (int j = 0; j < 4; ++j) gf[j] = ((const f32x4*)F.g_fin)[F.lane + 64 * j];
    for (int m = gw; m < M; m += NGW) {
        const float sp = F.lane < 16 ? F.ST2[(size_t)m * 16 + F.lane] : 0.f;
        float ss = sp; ss += __shfl_xor(ss, 1); ss += __shfl_xor(ss, 2); ss += __shfl_xor(ss, 4); ss += __shfl_xor(ss, 8);
        ss = __shfl(ss, 0);
        const float rstd = __builtin_amdgcn_rsqf(ss * (1.0f / D) + EPS);
        f32x4* xr = (f32x4*)(F.out + (size_t)m * D) + F.lane;
#pragma unroll
        for (int j = 0; j < 4; ++j) { const f32x4 v = xr[64 * j]; xr[64 * j] = v * rstd * gf[j]; }
    }
}

struct Args { const float* in[14]; float* out; unsigned char* ws; int ph_lo, ph_hi; };
__global__ void __launch_bounds__(NWAVES * 64, 2) mega_fwd(Args args) {
    extern __shared__ __attribute__((aligned(16))) unsigned char lds[];
    cg::grid_group grid = cg::this_grid();
    Frame F;
    F.lds = (LAS unsigned char*)lds;
    F.tid = threadIdx.x; F.lane = F.tid & 63; F.wave = __builtin_amdgcn_readfirstlane(F.tid >> 6);
    F.G = gridDim.x; { const int bx = blockIdx.x; F.vcu = (F.G % 8 == 0) ? (bx % 8) * (F.G / 8) + bx / 8 : bx; }
    unsigned char* ws = args.ws;
    F.xp = args.in[0]; F.xs = args.in[1]; F.c0 = args.in[2]; F.c1 = args.in[3]; F.c2 = args.in[4]; F.sconv = args.in[5]; F.g_attn = args.in[6]; F.w_in = args.in[7];
    F.conv_w = args.in[8]; F.w_out = args.in[9]; F.g_mlp = args.in[10]; F.w_up = args.in[11]; F.w_down = args.in[12]; F.g_fin = args.in[13]; F.out = args.out;
    F.Win_t = (bf16*)(ws + WS_WIN); F.Wout_t = (bf16*)(ws + WS_WOUT); F.Wup_t = (bf16*)(ws + WS_WUP); F.Wdn_t = (bf16*)(ws + WS_WDN);
    F.XB = (bf16*)(ws + WS_XB); F.PROJ = (bf16*)(ws + WS_PROJ); F.MIX = (bf16*)(ws + WS_MIX); F.HB = (bf16*)(ws + WS_HB);
    F.RSTD0 = (float*)(ws + WS_RSTD0); F.ST1 = (float*)(ws + WS_ST1); F.ST2 = (float*)(ws + WS_ST2); F.LSE = (float*)(ws + WS_LSE);
    const int lo = args.ph_lo, hi = args.ph_hi;
#define IN(k) (lo <= (k) && (k) < hi)
#define SEAM(k) do { if (IN(k) && IN((k) + 1)) grid.sync(); } while (0)

    if (IN(0)) { p0_prologue(F); if (PROBE_REP == 0) p0_prologue(F); }
    SEAM(0);
    if (IN(1)) {
        pg8::Gemm g{F.XB, F.Win_t, M, NIN, D}; pg8::StaticOrder S; S.init(M, NIN, F.G, (int)blockIdx.x);
        pg8::EpiScaleBf16<0> E{F.PROJ, NIN, F.RSTD0, EPS, pg8::CopyJob{F.c0, F.c1, F.c2, F.out + O_KVS0, F.out + O_KVS1, F.out + O_KVS2, 0}};
        pg8::gemm_phase<pg8::EpiScaleBf16<0>, pg8::StaticOrder, PG8_ALIGN, PG8_SP2>(F.lds, g, S, E);
        if (PROBE_REP == 1) { __syncthreads(); pg8::gemm_phase<pg8::EpiScaleBf16<0>, pg8::StaticOrder, PG8_ALIGN, PG8_SP2>(F.lds, g, S, E); }
    }
    SEAM(1);
    if (IN(2)) { p2_mixers(F); if (PROBE_REP == 2) { __syncthreads(); p2_mixers(F); } }
    SEAM(2);
    if (IN(3)) p2b_alpha(F);
    SEAM(3);
    if (IN(4)) {
        pg8::Gemm g{F.MIX, F.Wout_t, M, D, D}; pg8::StaticOrder S; S.init(M, D, F.G, (int)blockIdx.x);
        pg8::EpiRes<true> E{F.xp, F.xs, MP, F.out, F.XB, F.ST1};
        pg8::gemm_phase<pg8::EpiRes<true>, pg8::StaticOrder, PG8_ALIGN, PG8_SP2>(F.lds, g, S, E);
    }
    SEAM(4);
    if (IN(5)) {
        pg8::Gemm g{F.XB, F.Wup_t, M, FF, D}; pg8::StaticOrder S; S.init(M, FF, F.G, (int)blockIdx.x);
        pg8::EpiScaleBf16<1> E{F.HB, FF, F.ST1, EPS, pg8::CopyJob{F.c0, F.c1, F.c2, F.out + O_KVS0, F.out + O_KVS1, F.out + O_KVS2, (M / 256) * (NIN / 256)}};
        pg8::gemm_phase<pg8::EpiScaleBf16<1>, pg8::StaticOrder, PG8_ALIGN, PG8_SP2>(F.lds, g, S, E);
    }
    SEAM(5);
    if (IN(6)) {
        pg8::Gemm g{F.HB, F.Wdn_t, M, D, FF}; pg8::StaticOrder S; S.init(M, D, F.G, (int)blockIdx.x);
        pg8::EpiRes<false> E{F.out, F.out, 1 << 30, F.out, nullptr, F.ST2};
        pg8::gemm_phase<pg8::EpiRes<false>, pg8::StaticOrder, PG8_ALIGN, PG8_SP2>(F.lds, g, S, E);
    }
    SEAM(6);
    if (IN(7)) p6_final(F);
#undef IN
#undef SEAM
}

extern "C" void kernel_launch(void* const* d_in, const int* in_sizes, int n_in, void* d_out, int out_size, void* d_ws, size_t ws_size, hipStream_t stream) {
    static int grid = 0;
    if (grid == 0) {
        if (n_in != 14 || in_sizes[0] != MP * D || (size_t)out_size != O_END || ws_size < WS_END) { fprintf(stderr, "kernel_launch: unexpected shapes (n_in %d, in0 %d, out %d, ws %zu); nothing launched\n", n_in, n_in > 0 ? in_sizes[0] : -1, out_size, ws_size); grid = -1; return; }
        int dev = 0, cus = 0, per_cu = 0;
        if (hipGetDevice(&dev) != hipSuccess || hipDeviceGetAttribute(&cus, hipDeviceAttributeMultiprocessorCount, dev) != hipSuccess) { grid = -1; return; }
        if (hipFuncSetAttribute((const void*)mega_fwd, hipFuncAttributeMaxDynamicSharedMemorySize, LDS_BYTES) != hipSuccess) { fprintf(stderr, "kernel_launch: hipFuncSetAttribute failed\n"); grid = -1; return; }
        if (hipOccupancyMaxActiveBlocksPerMultiprocessor(&per_cu, (const void*)mega_fwd, NWAVES * 64, LDS_BYTES) != hipSuccess || per_cu < 1) { fprintf(stderr, "kernel_launch: occupancy query failed (%d)\n", per_cu); (void)hipGetLastError(); grid = -1; return; }
        grid = cus;
    }
    if (grid < 0) return;
    Args a{};
    for (int i = 0; i < 14; ++i) a.in[i] = (const float*)d_in[i];
    a.out = (float*)d_out; a.ws = (unsigned char*)d_ws;
    if (MK_N_LAUNCHES == 1) {
        a.ph_lo = 0; a.ph_hi = 8;
        void* kargs[] = {&a};
        const hipError_t e = hipLaunchCooperativeKernel((const void*)mega_fwd, dim3(grid), dim3(NWAVES * 64), kargs, LDS_BYTES, stream);
        if (e != hipSuccess) fprintf(stderr, "kernel_launch: cooperative launch failed: %s (grid %d)\n", hipGetErrorString(e), grid);
    } else {
        for (int p = 0; p < 8; ++p) { a.ph_lo = p; a.ph_hi = p + 1; hipLaunchKernelGGL(mega_fwd, dim3(grid), dim3(NWAVES * 64), LDS_BYTES, stream, a); }
    }
}
```

```cpp
#include <hip/hip_runtime.h>
#include <cstdio>
#include <cstdint>
#include <hip/hip_cooperative_groups.h>
namespace cg = cooperative_groups;
namespace pg8 {
#define PG8_LAS __attribute__((address_space(3)))
typedef unsigned short bf16_t;
typedef short bf16x8 __attribute__((ext_vector_type(8)));
typedef float f32x4 __attribute__((ext_vector_type(4)));
typedef unsigned u32x4 __attribute__((ext_vector_type(4)));
constexpr int BM = 256, BK = 64, HALF = 128, HTB = HALF * BK * 2  , STAGE_BYTES = 8 * HTB, NXCD = 8, WGM = 8;

__host__ __device__ __forceinline__ int lds_byte(int r, int c) { const int st = (r >> 4) * 2 + (c >> 5), rr = r & 15, cc = c & 31, ob = rr * 64 + cc * 2; return st * 1024 + (ob ^ (((ob >> 9) & 1) << 5)); }
__host__ __device__ __forceinline__ void stage_rc(int b, int& R, int& C) { const int st = b / 1024, sb = b % 1024, swz = sb ^ (((sb >> 9) & 1) << 5); R = (st >> 1) * 16 + swz / 64; C = (st & 1) * 32 + (swz % 64) / 2; }
__host__ __device__ __forceinline__ int perm32(int rho) { const int n = rho >> 4, i = rho & 15; return 8 * (i >> 2) + 4 * n + (i & 3); }

struct Unit { int pm, pn, lin; };
struct Gemm { const bf16_t* A; const bf16_t* Bt; int M, N, K; };

struct StaticOrder {
    int nM, nN, nwg, G, c;
    __host__ __device__ void init(int M, int N, int G_, int c_) { nM = M / BM; nN = N / BM; nwg = nM * nN; G = G_; c = c_; }
    __host__ __device__ bool next(int i, Unit& u) const {
        const long L = (long)i * G + c; if (L >= nwg) return false;
        int wgid = (int)L; { const int q = nwg / NXCD, r = nwg % NXCD, xcd = wgid % NXCD, off = wgid / NXCD; wgid = (xcd < r ? xcd * (q + 1) : r * (q + 1) + (xcd - r) * q) + off; }
        const int nig = WGM * nN, gid = wgid / nig, fm = gid * WGM, gsz = (nM - fm) < WGM ? (nM - fm) : WGM;
        u.pm = fm + ((wgid % nig) % gsz); u.pn = (wgid % nig) / gsz; u.lin = (int)L; return true;
    }
    __device__ __forceinline__ void a_ready(const Unit&) const {}
    __device__ __forceinline__ void done(const Unit&) const {}
};

__device__ __forceinline__ unsigned cvt_pk_bf16(float lo, float hi) { unsigned r; asm volatile("v_cvt_pk_bf16_f32 %0, %1, %2" : "=v"(r) : "v"(lo), "v"(hi)); return r; }
typedef float f32x2 __attribute__((ext_vector_type(2)));
constexpr int NCP = 6, CP_CHUNK = 512 * NCP;
constexpr int CP_C0 = 128 * 5, CP_C1 = 128 * 21, CP_C2 = 128 * 85, CP_NCHUNK = CP_C0 + CP_C1 + CP_C2;
struct CopyJob { const float *s0, *s1, *s2; float *d0, *d1, *d2; int base; };
__device__ __forceinline__ void cp_chunk(const CopyJob& cj, int chunk, const float*& sp, float*& dp, int& so, int& dof) {
    chunk = chunk >= CP_NCHUNK ? CP_NCHUNK - 1 : chunk;
    if (chunk < CP_C0) { const int b = chunk / 5, k = (chunk - b * 5) * CP_CHUNK; sp = cj.s0; dp = cj.d0; so = ((b * 128 + 8) * 128 + k) * 16; dof = (b * 128 * 128 + k) * 16; }
    else if (chunk < CP_C0 + CP_C1) { const int i = chunk - CP_C0, b = i / 21, k = (i - b * 21) * CP_CHUNK; sp = cj.s1; dp = cj.d1; so = ((b * 512 + 8) * 128 + k) * 16; dof = (b * 512 * 128 + k) * 16; }
    else { const int i = chunk - CP_C0 - CP_C1, b = i / 85, k = (i - b * 85) * CP_CHUNK; sp = cj.s2; dp = cj.d2; so = ((b * 2048 + 8) * 128 + k) * 16; dof = (b * 2048 * 128 + k) * 16; }
}
template <int MODE> struct EpiScaleBf16 {
    static constexpr bool PERM = true, AFTER_DRAIN = false;
    bf16_t* O; int ldc; const float* rs; float eps; CopyJob cj;
    __device__ __forceinline__ void operator()(const f32x4 (&acc)[2][2][4][2], const Unit& u, int wr, int wc, int fr, int fq) const {
        const int row0 = u.pm * BM + wr * 64 + fr; const int col0 = u.pn * BM + wc * 32 + 8 * fq;
        float sc[8];
        if (MODE == 0) {
#pragma unroll
            for (int i = 0; i < 8; ++i) sc[i] = rs[row0 + (i >> 2) * HALF + (i & 3) * 16];
        } else {
            f32x4 pv[8];
#pragma unroll
            for (int i = 0; i < 8; ++i) pv[i] = *(const f32x4*)(rs + (size_t)(row0 + (i >> 2) * HALF + (i & 3) * 16) * 16 + 4 * fq);
#pragma unroll
            for (int i = 0; i < 8; ++i) { float ss = (pv[i][0] + pv[i][1]) + (pv[i][2] + pv[i][3]); ss += __shfl_xor(ss, 16); ss += __shfl_xor(ss, 32);
                sc[i] = __builtin_amdgcn_rsqf(ss * (1.0f / 1024.0f) + eps); }
        }
        u32x4 cpa[NCP], cpb[NCP]; const float *spa, *spb; float *dpa, *dpb; int soa, sob, doa, dob;
        { const int ch = __builtin_amdgcn_readfirstlane(2 * (cj.base + u.lin)); cp_chunk(cj, ch, spa, dpa, soa, doa); cp_chunk(cj, ch + 1, spb, dpb, sob, dob); }
        const int toff = threadIdx.x * 16;
        { const __amdgpu_buffer_rsrc_t ra = __builtin_amdgcn_make_buffer_rsrc((void*)spa, 0, 0x7fffffff, 0x00020000), rb = __builtin_amdgcn_make_buffer_rsrc((void*)spb, 0, 0x7fffffff, 0x00020000);
#pragma unroll
          for (int j = 0; j < NCP; ++j) cpa[j] = __builtin_amdgcn_raw_buffer_load_b128(ra, toff, soa + j * 8192, 0);
#pragma unroll
          for (int j = 0; j < NCP; ++j) cpb[j] = __builtin_amdgcn_raw_buffer_load_b128(rb, toff, sob + j * 8192, 0); }
        asm volatile("" ::: "memory");
#pragma unroll
        for (int ai = 0; ai < 2; ++ai)
#pragma unroll
            for (int m = 0; m < 4; ++m) { const int row = row0 + ai * HALF + m * 16; const float s1 = sc[ai * 4 + m];
                bf16_t* rowp = O + (size_t)row * ldc + col0;
#pragma unroll
                for (int bj = 0; bj < 2; ++bj) { f32x4 v0 = acc[ai][bj][m][0] * s1, v1 = acc[ai][bj][m][1] * s1;
                    if (MODE == 1) {
#pragma unroll
                        for (int e = 0; e < 4; ++e) { const float x0 = fmaxf(v0[e], 0.f), x1 = fmaxf(v1[e], 0.f); v0[e] = x0 * x0; v1[e] = x1 * x1; } }
                    u32x4 w; w.x = cvt_pk_bf16(v0[0], v0[1]); w.y = cvt_pk_bf16(v0[2], v0[3]); w.z = cvt_pk_bf16(v1[0], v1[1]); w.w = cvt_pk_bf16(v1[2], v1[3]);
                    *(u32x4*)(rowp + bj * HALF) = w; } }
        asm volatile("" ::: "memory");
        { const __amdgpu_buffer_rsrc_t ra = __builtin_amdgcn_make_buffer_rsrc((void*)dpa, 0, 0x7fffffff, 0x00020000), rb = __builtin_amdgcn_make_buffer_rsrc((void*)dpb, 0, 0x7fffffff, 0x00020000);
#pragma unroll
          for (int j = 0; j < NCP; ++j) __builtin_amdgcn_raw_buffer_store_b128(cpa[j], ra, toff, doa + j * 8192, 0);
#pragma unroll
          for (int j = 0; j < NCP; ++j) __builtin_amdgcn_raw_buffer_store_b128(cpb[j], rb, toff, dob + j * 8192, 0); }
    }
};
template <bool WB> struct EpiRes {
    static constexpr bool PERM = false, AFTER_DRAIN = false;
    const float* base0; const float* base1; int split_row; float* out; bf16_t* xb; float* stats;
    __device__ __forceinline__ void operator()(const f32x4 (&acc)[2][2][4][2], const Unit& u, int wr, int wc, int fr, int fq) const {
        typedef unsigned u32x2v __attribute__((ext_vector_type(2)));
        const int col0 = u.pn * BM + wc * 32 + 4 * fq; const int rt0 = u.pm * BM;
        const float* base = rt0 < split_row ? base0 : base1; const int rsub = rt0 < split_row ? 0 : split_row;
#pragma unroll
        for (int ai = 0; ai < 2; ++ai)
#pragma unroll
            for (int m = 0; m < 4; ++m) { const int r = rt0 + ai * HALF + wr * 64 + m * 16 + fr; const size_t off = (size_t)r * 1024 + col0, offb = (size_t)(r - rsub) * 1024 + col0; float ss = 0.f;
#pragma unroll
                for (int bj = 0; bj < 2; ++bj)
#pragma unroll
                    for (int n = 0; n < 2; ++n) { const f32x4 bs = *(const f32x4*)(base + offb + bj * HALF + n * 16); const f32x4 o = bs + acc[ai][bj][m][n];
                        *(f32x4*)(out + off + bj * HALF + n * 16) = o;
                        if (WB) { u32x2v w; w.x = cvt_pk_bf16(o[0], o[1]); w.y = cvt_pk_bf16(o[2], o[3]); *(u32x2v*)(xb + off + bj * HALF + n * 16) = w; }
                        ss += (o[0] * o[0] + o[1] * o[1]) + (o[2] * o[2] + o[3] * o[3]); }
                ss += __shfl_xor(ss, 16); ss += __shfl_xor(ss, 32);
                if (fq == 0) stats[(size_t)r * 16 + u.pn * 4 + wc] = ss;
                if (m & 1) asm volatile("" ::: "memory"); }
    }
};

template <class Epi, class Sched, bool ALIGN_EPI = false, bool SP2 = false>
__device__ __forceinline__ void gemm_phase(PG8_LAS unsigned char* lds, const Gemm g, const Sched& S, const Epi& E) {
    const int tid = threadIdx.x, wid = __builtin_amdgcn_readfirstlane(tid >> 6), lane = tid & 63, wr = wid >> 2, wc = wid & 3, fr = lane & 15, fq = lane >> 4;
    const int K = g.K, nt = K / BK;
    unsigned voffA[2], voffB[2];
#pragma unroll
    for (int i = 0; i < 2; ++i) { int R, C; stage_rc(tid * 16 + i * 8192, R, C); const int Rb = Epi::PERM ? ((R & ~31) + perm32(R & 31)) : R;
        voffA[i] = (unsigned)(R * K + C) * 2u; voffB[i] = (unsigned)(Rb * K + C) * 2u; }
    const size_t kstep = (size_t)(BK * 2);
    const size_t hstep = (size_t)HALF * K * 2;
    const size_t tstep = 2 * hstep;
    const unsigned ldsw = (unsigned)wid * 1024u;
    const int aoff = lds_byte(wr * 64 + fr, fq * 8), boff = lds_byte(wc * 32 + fr, fq * 8);
#define PG8_SA(b, h) (((b) * 2 + (h)) * HTB)
#define PG8_SB(b, h) ((4 + (b) * 2 + (h)) * HTB)
#define PG8_STAGE(bufoff, gbase, voff) do { _Pragma("unroll") for (int _i = 0; _i < 2; ++_i) \
        __builtin_amdgcn_global_load_lds((const unsigned*)((const char*)(gbase) + (voff)[_i]), (PG8_LAS unsigned*)(lds + (bufoff) + ldsw + _i * 8192), 16, 0, 0); } while (0)
#define PG8_LDA(dst, b, h) do { _Pragma("unroll") for (int m = 0; m < 4; ++m) _Pragma("unroll") for (int k = 0; k < 2; ++k) dst[m][k] = *(const PG8_LAS bf16x8*)(lds + PG8_SA(b, h) + aoff + m * 2048 + k * 1024); } while (0)
#define PG8_LDB(dst, b, h) do { _Pragma("unroll") for (int n = 0; n < 2; ++n) _Pragma("unroll") for (int k = 0; k < 2; ++k) dst[n][k] = *(const PG8_LAS bf16x8*)(lds + PG8_SB(b, h) + boff + n * 2048 + k * 1024); } while (0)
#define PG8_MMA(ai, bj, At, Bt) do { __builtin_amdgcn_s_setprio(1); _Pragma("unroll") for (int m = 0; m < 4; ++m) _Pragma("unroll") for (int n = 0; n < 2; ++n) _Pragma("unroll") for (int k = 0; k < 2; ++k) \
        acc[ai][bj][m][n] = __builtin_amdgcn_mfma_f32_16x16x32_bf16(Bt[n][k], At[m][k], acc[ai][bj][m][n], 0, 0, 0); __builtin_amdgcn_s_setprio(0); } while (0)
#define PG8_WAIT_V(n) asm volatile("s_waitcnt vmcnt(" #n ")" ::: "memory")
#define PG8_WAIT_L(n) asm volatile("s_waitcnt lgkmcnt(" #n ")" ::: "memory")
#define PG8_BAR __builtin_amdgcn_s_barrier()
#define PG8_SCHED __builtin_amdgcn_sched_barrier(0)
    Unit cur, nxt; int ui = 0;
    if (!S.next(0, cur)) return;
    f32x4 acc[2][2][4][2];
#pragma unroll
    for (int a = 0; a < 2; ++a)
#pragma unroll
        for (int b = 0; b < 2; ++b)
#pragma unroll
            for (int m = 0; m < 4; ++m)
#pragma unroll
                for (int n = 0; n < 2; ++n) acc[a][b][m][n] = (f32x4){0.f, 0.f, 0.f, 0.f};
    bf16x8 At[4][2], B0[2][2], B1[2][2];
    const char* cA = (const char*)g.A + (size_t)cur.pm * tstep; const char* cB = (const char*)g.Bt + (size_t)cur.pn * tstep;
    S.a_ready(cur);
    if constexpr (SP2) {
        PG8_STAGE(PG8_SB(0, 0), cB, voffB); PG8_STAGE(PG8_SB(0, 1), cB + hstep, voffB); PG8_STAGE(PG8_SA(0, 0), cA, voffA); PG8_STAGE(PG8_SA(0, 1), cA + hstep, voffA);
        if (wr == 1) PG8_BAR;
        PG8_WAIT_V(2); PG8_BAR;
        PG8_STAGE(PG8_SB(1, 0), cB + kstep, voffB); PG8_STAGE(PG8_SA(1, 0), cA + kstep, voffA); PG8_STAGE(PG8_SB(1, 1), cB + hstep + kstep, voffB);
        PG8_WAIT_V(6); PG8_BAR;
    } else {
        PG8_STAGE(PG8_SB(0, 0), cB, voffB); PG8_STAGE(PG8_SA(0, 0), cA, voffA); PG8_STAGE(PG8_SB(0, 1), cB + hstep, voffB); PG8_STAGE(PG8_SA(0, 1), cA + hstep, voffA);
        if (wr == 1) PG8_BAR;
        PG8_WAIT_V(4); PG8_BAR;
        PG8_STAGE(PG8_SB(1, 0), cB + kstep, voffB); PG8_STAGE(PG8_SA(1, 0), cA + kstep, voffA); PG8_STAGE(PG8_SB(1, 1), cB + hstep + kstep, voffB);
        PG8_WAIT_V(6); PG8_BAR;
    }
    for (;;) {
        const bool has_next = S.next(ui + 1, nxt);
        const char* nA = has_next ? (const char*)g.A + (size_t)nxt.pm * tstep : cA; const char* nB = has_next ? (const char*)g.Bt + (size_t)nxt.pn * tstep : cB;
        for (int t = 0; t < nt; t += 2) {
            const bool last = (t == nt - 2);
            const char* a1 = cA + (size_t)(t + 1) * kstep;
            const char* a2 = last ? nA : cA + (size_t)(t + 2) * kstep; const char* b2 = last ? nB : cB + (size_t)(t + 2) * kstep;
            const char* a3 = a2 + kstep; const char* b3 = b2 + kstep;
            if (last && has_next) S.a_ready(nxt);
            if constexpr (SP2) {
            PG8_LDB(B0, 0, 0); PG8_LDB(B1, 0, 1); PG8_SCHED; PG8_LDA(At, 0, 0); PG8_STAGE(PG8_SA(1, 1), a1 + hstep, voffA);
            PG8_WAIT_V(8); PG8_WAIT_L(0); PG8_BAR; PG8_MMA(0, 0, At, B0); PG8_MMA(0, 1, At, B1); PG8_BAR; PG8_SCHED;
            PG8_LDA(At, 0, 1); PG8_STAGE(PG8_SB(0, 0), b2, voffB); PG8_STAGE(PG8_SB(0, 1), b2 + hstep, voffB); PG8_STAGE(PG8_SA(0, 0), a2, voffA);
            PG8_WAIT_V(8); PG8_WAIT_L(0); PG8_BAR; PG8_MMA(1, 0, At, B0); PG8_MMA(1, 1, At, B1); PG8_BAR; PG8_SCHED;
            PG8_LDB(B0, 1, 0); PG8_LDB(B1, 1, 1); PG8_SCHED; PG8_LDA(At, 1, 0); PG8_STAGE(PG8_SA(0, 1), a2 + hstep, voffA);
            PG8_WAIT_V(8); PG8_WAIT_L(0); PG8_BAR; PG8_MMA(0, 0, At, B0); PG8_MMA(0, 1, At, B1); PG8_BAR; PG8_SCHED;
            PG8_LDA(At, 1, 1); PG8_STAGE(PG8_SB(1, 0), b3, voffB); PG8_STAGE(PG8_SB(1, 1), b3 + hstep, voffB); PG8_STAGE(PG8_SA(1, 0), a3, voffA);
            PG8_WAIT_V(8); PG8_WAIT_L(0); PG8_BAR; PG8_MMA(1, 0, At, B0); PG8_MMA(1, 1, At, B1); PG8_BAR; PG8_SCHED;
            } else {
            PG8_LDB(B0, 0, 0); PG8_SCHED; PG8_LDA(At, 0, 0); PG8_STAGE(PG8_SA(1, 1), a1 + hstep, voffA);
            PG8_WAIT_L(8); PG8_BAR; PG8_WAIT_L(0); PG8_MMA(0, 0, At, B0); PG8_BAR; PG8_SCHED;
            PG8_LDB(B1, 0, 1); PG8_STAGE(PG8_SB(0, 0), b2, voffB);
            PG8_BAR; PG8_WAIT_L(0); PG8_MMA(0, 1, At, B1); PG8_BAR;
            PG8_LDA(At, 0, 1); PG8_STAGE(PG8_SA(0, 0), a2, voffA);
            PG8_BAR; PG8_WAIT_L(0); PG8_MMA(1, 0, At, B0); PG8_BAR; PG8_SCHED;
            PG8_STAGE(PG8_SB(0, 1), b2 + hstep, voffB);
            PG8_WAIT_V(6); PG8_BAR; PG8_MMA(1, 1, At, B1); PG8_BAR;
            PG8_LDB(B0, 1, 0); PG8_SCHED; PG8_LDA(At, 1, 0); PG8_STAGE(PG8_SA(0, 1), a2 + hstep, voffA);
            PG8_WAIT_L(8); PG8_BAR; PG8_WAIT_L(0); PG8_MMA(0, 0, At, B0); PG8_BAR; PG8_SCHED;
            PG8_LDB(B1, 1, 1); PG8_STAGE(PG8_SB(1, 0), b3, voffB);
            PG8_BAR; PG8_WAIT_L(0); PG8_MMA(0, 1, At, B1); PG8_BAR;
            PG8_LDA(At, 1, 1); PG8_STAGE(PG8_SA(1, 0), a3, voffA);
            PG8_BAR; PG8_WAIT_L(0); PG8_MMA(1, 0, At, B0); PG8_BAR; PG8_SCHED;
            PG8_STAGE(PG8_SB(1, 1), b3 + hstep, voffB);
            PG8_WAIT_V(6); PG8_BAR; PG8_MMA(1, 1, At, B1); PG8_BAR;
            }
        }
        if constexpr (ALIGN_EPI) { if (wr == 0) PG8_BAR; }
        if constexpr (!Epi::AFTER_DRAIN) { E(acc, cur, wr, wc, fr, fq); S.done(cur); }
        if (!has_next) break;
#pragma unroll
        for (int a = 0; a < 2; ++a)
#pragma unroll
            for (int b = 0; b < 2; ++b)
#pragma unroll
                for (int m = 0; m < 4; ++m)
#pragma unroll
                    for (int n = 0; n < 2; ++n) acc[a][b][m][n] = (f32x4){0.f, 0.f, 0.f, 0.f};
        cur = nxt; cA = nA; cB = nB; ++ui;
        if constexpr (ALIGN_EPI) { if (wr == 1) PG8_BAR; }
    }
    PG8_WAIT_V(0);
    if constexpr (!ALIGN_EPI) { if (wr == 0) PG8_BAR; }
    PG8_BAR;
    if constexpr (Epi::AFTER_DRAIN) { E.fused(acc, cur, wr, wc, fr, fq, lds, wid, lane); S.done(cur); }
#undef PG8_SA
#undef PG8_SB
#undef PG8_STAGE
#undef PG8_LDA
#undef PG8_LDB
#undef PG8_MMA
#undef PG8_WAIT_V
#undef PG8_WAIT_L
#undef PG8_BAR
#undef PG8_SCHED
}
}
#ifndef PG8_SP2
#define PG8_SP2 true
#endif
#ifndef PG8_ALIGN
#define PG8_ALIGN true
#endif
#ifndef PROBE_REP
#define PROBE_REP -1
#endif
#ifndef REP_A
#define REP_A 1
#endif
#ifndef REP_B
#define REP_B 1
#endif
#ifndef REP_C
#define REP_C 1
#endif
#ifndef PROBE_P2MASK
#define PROBE_P2MASK 0
#endif
#ifndef MK_N_LAUNCHES
#define MK_N_LAUNCHES 1
#endif

constexpr int D = 1024, FF = 4096, NIN = 3072;
constexpr int MP = 8 * 8192, MS = 128 * 8, M = MP + MS;
constexpr int TP = 8192;
constexpr float EPS = 1e-6f;
constexpr int NWAVES = 8;
#define GAS __attribute__((address_space(1)))
#define LAS __attribute__((address_space(3)))
typedef unsigned short bf16;
typedef unsigned v4u __attribute__((ext_vector_type(4)));
typedef unsigned v2u __attribute__((ext_vector_type(2)));
typedef float f32x4 __attribute__((ext_vector_type(4)));
typedef short bf16x8 __attribute__((ext_vector_type(8)));
typedef short s16x4 __attribute__((ext_vector_type(4)));
typedef float f32x16 __attribute__((ext_vector_type(16)));

constexpr size_t MiB = 1u << 20;
constexpr size_t WS_WIN = 0, WS_WOUT = 6 * MiB, WS_WUP = 8 * MiB, WS_WDN = 16 * MiB;
constexpr size_t WS_RSTD0 = 24 * MiB;
constexpr size_t WS_ST1 = 25 * MiB, WS_ST2 = 30 * MiB;
constexpr size_t WS_LSE = 35 * MiB;
constexpr size_t WS_XB = 40 * MiB;
constexpr size_t WS_PROJ = 172 * MiB;
constexpr size_t WS_MIX = 564 * MiB;
constexpr size_t WS_HB = 696 * MiB;
constexpr size_t WS_END = 1220 * MiB;
static_assert(WS_XB + (size_t)M * D * 2 <= WS_PROJ && WS_PROJ + (size_t)M * NIN * 2 <= WS_MIX && WS_MIX + (size_t)M * D * 2 <= WS_HB && WS_HB + (size_t)M * FF * 2 <= WS_END, "d_ws map");
static_assert(WS_ST1 + (size_t)M * 64 <= WS_ST2 && WS_ST2 + (size_t)M * 64 <= WS_LSE && WS_LSE + (size_t)M * 48 <= WS_XB, "d_ws map 2");

constexpr size_t O_Y = 0;
constexpr size_t O_KVP0 = (size_t)M * D;
constexpr size_t O_KVP1 = O_KVP0 + 8ull * 128 * 512;
constexpr size_t O_KVP2 = O_KVP1 + 8ull * 512 * 512;
constexpr size_t O_CVP = O_KVP2 + 8ull * 2048 * 512;
constexpr size_t O_KVS0 = O_CVP + 8ull * 2 * 256;
constexpr size_t O_KVS1 = O_KVS0 + 128ull * 128 * 512;
constexpr size_t O_KVS2 = O_KVS1 + 128ull * 512 * 512;
constexpr size_t O_CVS = O_KVS2 + 128ull * 2048 * 512;
constexpr size_t O_END = O_CVS + 128ull * 2 * 256;

constexpr int LDS_BYTES = 163840;

__device__ __forceinline__ unsigned f2bf(float f) { unsigned u = __builtin_bit_cast(unsigned, f); return (u + 0x7fffu + ((u >> 16) & 1u)) >> 16; }
__device__ __forceinline__ unsigned pk2(float lo, float hi) { return f2bf(lo) | (f2bf(hi) << 16); }
__device__ __forceinline__ float bflo(unsigned w) { return __builtin_bit_cast(float, w << 16); }
__device__ __forceinline__ float bfhi(unsigned w) { return __builtin_bit_cast(float, w & 0xffff0000u); }
__device__ __forceinline__ float wave_sum(float v) {
#pragma unroll
    for (int o = 1; o < 64; o <<= 1) v += __shfl_xor(v, o);
    return v;
}

__device__ __forceinline__ unsigned att_cvtpk(float lo, float hi) { typedef float f2 __attribute__((ext_vector_type(2))); typedef __bf16 b2 __attribute__((ext_vector_type(2))); f2 v = {lo, hi}; b2 b = __builtin_convertvector(v, b2); return __builtin_bit_cast(unsigned, b); }
__device__ __forceinline__ const float* pick3(int g, const float* a, const float* b, const float* c) { return g == 0 ? a : (g == 1 ? b : c); }
struct Frame {
    LAS unsigned char* lds;
    int tid, lane, wave, vcu, G;
    const float *xp, *xs, *c0, *c1, *c2, *sconv, *g_attn, *w_in, *conv_w, *w_out, *g_mlp, *w_up, *w_down, *g_fin;
    float* out;
    bf16 *Win_t, *Wout_t, *Wup_t, *Wdn_t, *XB, *PROJ, *MIX, *HB;
    float *RSTD0, *ST1, *ST2, *LSE;
};

__device__ __forceinline__ void p0_transpose_item(const float* W, const float* gk, int K, int N, bf16* WT, LAS float* scr, int item, int lane) {
    const int nblk = N / 32, kb = item / nblk, nb = item % nblk, k0 = 64 * kb, n0 = 32 * nb;
#pragma unroll 8
    for (int i = 0; i < 32; ++i) { const int kk = 2 * i + (lane >> 5); float v = W[(size_t)(k0 + kk) * N + n0 + (lane & 31)]; if (gk) v *= gk[k0 + kk]; scr[kk * 33 + (lane & 31)] = v; }
    asm volatile("s_waitcnt lgkmcnt(0)" ::: "memory");
    const int c = lane & 7;
#pragma unroll
    for (int j = 0; j < 4; ++j) { const int n = (lane >> 3) + 8 * j; const LAS float* s = scr + (8 * c) * 33 + n;
        v4u o; o.x = pk2(s[0 * 33], s[1 * 33]); o.y = pk2(s[2 * 33], s[3 * 33]); o.z = pk2(s[4 * 33], s[5 * 33]); o.w = pk2(s[6 * 33], s[7 * 33]);
        *(v4u*)(WT + (size_t)(n0 + n) * K + k0 + 8 * c) = o; }
    asm volatile("s_waitcnt lgkmcnt(0)" ::: "memory");
}
__device__ __forceinline__ void p0_prologue(Frame& F) {
    LAS float* scr = (LAS float*)(F.lds + F.wave * 16384);
    const int gw = F.vcu * NWAVES + F.wave, NGW = F.G * NWAVES;
    constexpr int I_IN = (D / 64) * (NIN / 32), I_O = (D / 64) * (D / 32), I_UP = (D / 64) * (FF / 32), I_DN = (FF / 64) * (D / 32);
    constexpr int NITEMS = I_IN + I_O + I_UP + I_DN;
    for (int it = gw; it < NITEMS; it += NGW) {
        int r = it;
        if (r < I_IN) { p0_transpose_item(F.w_in, F.g_attn, D, NIN, F.Win_t, scr, r, F.lane); continue; } r -= I_IN;
        if (r < I_O) { p0_transpose_item(F.w_out, nullptr, D, D, F.Wout_t, scr, r, F.lane); continue; } r -= I_O;
        if (r < I_UP) { p0_transpose_item(F.w_up, F.g_mlp, D, FF, F.Wup_t, scr, r, F.lane); continue; } r -= I_UP;
        p0_transpose_item(F.w_down, nullptr, FF, D, F.Wdn_t, scr, r, F.lane);
    }
    for (int m0 = gw * 4; m0 < M; m0 += NGW * 4) {
        const float* xrow = m0 < MP ? F.xp + (size_t)m0 * D : F.xs + (size_t)(m0 - MP) * D;
        f32x4 v[4][4]; float s[4];
#pragma unroll
        for (int r = 0; r < 4; ++r)
#pragma unroll
            for (int j = 0; j < 4; ++j) v[r][j] = ((const f32x4*)(xrow + (size_t)r * D))[F.lane + 64 * j];
#pragma unroll
        for (int r = 0; r < 4; ++r) { float t = 0.f;
#pragma unroll
            for (int j = 0; j < 4; ++j) t += (v[r][j].x * v[r][j].x + v[r][j].y * v[r][j].y) + (v[r][j].z * v[r][j].z + v[r][j].w * v[r][j].w);
            s[r] = wave_sum(t); }
#pragma unroll
        for (int r = 0; r < 4; ++r) { v2u* o8 = (v2u*)(F.XB + (size_t)(m0 + r) * D) + F.lane;
#pragma unroll
            for (int j = 0; j < 4; ++j) { v2u w; w.x = att_cvtpk(v[r][j].x, v[r][j].y); w.y = att_cvtpk(v[r][j].z, v[r][j].w); o8[64 * j] = w; }
            if (F.lane == 0) F.RSTD0[m0 + r] = __builtin_amdgcn_rsqf(s[r] * (1.0f / D) + EPS); }
    }
}

namespace att {
constexpr int VP = 128;
constexpr int WTILE = 160 * VP;
constexpr float C2 = 0.125f * 1.4426950408889634f;
typedef __amdgpu_buffer_rsrc_t rsrc_t;
__device__ __forceinline__ rsrc_t mk_rsrc(const void* p) { return __builtin_amdgcn_make_buffer_rsrc((void*)p, 0, 0x7fffffff, 0x00020000); }
__device__ __forceinline__ v4u bld16(rsrc_t r, int voff, int soff) { return __builtin_amdgcn_raw_buffer_load_b128(r, voff, soff, 0); }
__device__ __forceinline__ v2u bld8(rsrc_t r, int voff, int soff) { return __builtin_amdgcn_raw_buffer_load_b64(r, voff, soff, 0); }
__device__ __forceinline__ int crow(int r, int hi) { return (r & 3) + 8 * (r >> 2) + 4 * hi; }
__device__ __forceinline__ s16x4 vtr(const LAS unsigned char* p) { return __builtin_bit_cast(s16x4, __builtin_amdgcn_ds_read_tr16_b64_v4i16((LAS s16x4*)p)); }
__device__ __forceinline__ unsigned cvtpk(float lo, float hi) { typedef float f2 __attribute__((ext_vector_type(2))); typedef __bf16 b2 __attribute__((ext_vector_type(2))); f2 v = {lo, hi}; b2 b = __builtin_convertvector(v, b2); return __builtin_bit_cast(unsigned, b); }

__device__ __forceinline__ void prompt_tile(const rsrc_t rp, bf16* __restrict__ mixed, float* __restrict__ lse, LAS unsigned char* wl, int b, int g, int h, int r, int j, int lane) {
    const int a = lane & 31, hi = lane >> 5, s = 2 * g, qs = 32 * j, rowb = b * TP, colq = g * 256 + h * 64, l8 = lane >> 3, c8 = lane & 7;
    constexpr int RB = NIN * 2;
    const int vo = (rowb + (l8 << s) + r) * RB + colq * 2 + c8 * 16;
    v4u qraw[4], kraw[20], va[12], vb[8];
#pragma unroll
    for (int i = 0; i < 4; ++i) qraw[i] = bld16(rp, vo, ((qs + 8 * i) << s) * RB);
#pragma unroll
    for (int i = 0; i < 20; ++i) { int ii = qs - 128 + 8 * i; ii = ii < 0 ? 0 : ii;
        kraw[i] = bld16(rp, vo + 768 * 2, (ii << s) * RB); }
    const int wsw = l8 * VP + ((c8 ^ l8) * 16), rsw = a * VP;
#pragma unroll
    for (int i = 0; i < 4; ++i) *(LAS v4u*)(wl + 8 * i * VP + wsw) = qraw[i];
    bf16x8 qf[4];
#pragma unroll
    for (int d0 = 0; d0 < 4; ++d0) qf[d0] = *(const LAS bf16x8*)(wl + rsw + (((2 * d0 + hi) ^ (a & 7)) * 16));
#pragma unroll
    for (int i = 0; i < 20; ++i) *(LAS v4u*)(wl + 8 * i * VP + wsw) = kraw[i];
    asm volatile("" ::: "memory");
#pragma unroll
    for (int i = 0; i < 12; ++i) { int ii = qs - 128 + 8 * i; ii = ii < 0 ? 0 : ii; va[i] = bld16(rp, vo + 1536 * 2, (ii << s) * RB); }
    f32x16 S[5];
#pragma unroll
    for (int kb = 0; kb < 5; ++kb) { f32x16 acc = {};
#pragma unroll
        for (int d0 = 0; d0 < 4; ++d0) { const bf16x8 kf = *(const LAS bf16x8*)(wl + 32 * kb * VP + rsw + (((2 * d0 + hi) ^ (a & 7)) * 16)); acc = __builtin_amdgcn_mfma_f32_32x32x16_bf16(kf, qf[d0], acc, 0, 0, 0); }
        S[kb] = acc; }
    float mr = -INFINITY; float bias[5];
#pragma unroll
    for (int kb = 0; kb < 5; ++kb) { const bool bv = (qs - 128 + 32 * kb) >= 0; bias[kb] = bv ? 0.f : -INFINITY; float bm = -INFINITY;
#pragma unroll
        for (int rr = 0; rr < 16; ++rr) { const int key = crow(rr, hi); float v = S[kb][rr];
            if (kb == 0) { v = key >= a ? v : -INFINITY; S[kb][rr] = v; } if (kb == 4) { v = key <= a ? v : -INFINITY; S[kb][rr] = v; }
            bm = fmaxf(bm, v); }
        mr = bv ? fmaxf(mr, bm) : mr; }
    mr = fmaxf(mr, __shfl_xor(mr, 32));
    const float mxs = mr * C2;
    float l = 0.f; v4u pw[5][2];
#pragma unroll
    for (int kb = 0; kb < 5; ++kb) { const float nb = bias[kb] - mxs; float p[16];
#pragma unroll
        for (int rr = 0; rr < 16; ++rr) { p[rr] = __builtin_amdgcn_exp2f(__builtin_fmaf(S[kb][rr], C2, nb)); l += p[rr]; }
#pragma unroll
        for (int st = 0; st < 2; ++st) { pw[kb][st].x = cvtpk(p[8 * st + 0], p[8 * st + 1]); pw[kb][st].y = cvtpk(p[8 * st + 2], p[8 * st + 3]); pw[kb][st].z = cvtpk(p[8 * st + 4], p[8 * st + 5]); pw[kb][st].w = cvtpk(p[8 * st + 6], p[8 * st + 7]); } }
    l += __shfl_xor(l, 32);
#pragma unroll
    for (int i = 0; i < 8; ++i) { int ii = qs - 32 + 8 * i; ii = ii < 0 ? 0 : ii; vb[i] = bld16(rp, vo + 1536 * 2, (ii << s) * RB); }
#pragma unroll
    for (int i = 0; i < 12; ++i) *(LAS v4u*)(wl + (8 * i + l8) * VP + c8 * 16) = va[i];
    f32x16 o[2]; o[0] = f32x16{}; o[1] = f32x16{};
    const LAS unsigned char* vbase = wl + (4 * hi + ((lane & 15) >> 2)) * VP + (16 * ((lane >> 4) & 1) + 4 * (lane & 3)) * 2;
#pragma unroll
    for (int kb = 0; kb < 5; ++kb) {
        if (kb == 3) {
#pragma unroll
            for (int i = 0; i < 8; ++i) *(LAS v4u*)(wl + (96 + 8 * i + l8) * VP + c8 * 16) = vb[i]; }
#pragma unroll
        for (int st = 0; st < 2; ++st) {
            const bf16x8 pa = __builtin_bit_cast(bf16x8, pw[kb][st]);
#pragma unroll
            for (int cc = 0; cc < 2; ++cc) {
                const s16x4 lo = vtr(vbase + (32 * kb + 16 * st) * VP + cc * 64), hh = vtr(vbase + (32 * kb + 16 * st + 8) * VP + cc * 64);
                const bf16x8 vf = (bf16x8){lo[0], lo[1], lo[2], lo[3], hh[0], hh[1], hh[2], hh[3]};
                o[cc] = __builtin_amdgcn_mfma_f32_32x32x16_bf16(pa, vf, o[cc], 0, 0, 0);
            }
        }
    }
    const float linv = 1.0f / l;
#pragma unroll
    for (int rr = 0; rr < 16; ++rr) { const int q = crow(rr, hi); const float li = __shfl(linv, q);
        const unsigned w = cvtpk(o[0][rr] * li, o[1][rr] * li); LAS bf16* op = (LAS bf16*)(wl + q * VP) + a; op[0] = (bf16)(w & 0xffffu); op[32] = (bf16)(w >> 16); }
#pragma unroll
    for (int i = 0; i < 4; ++i) { const v4u ov = *(const LAS v4u*)(wl + (8 * i + l8) * VP + c8 * 16);
        *(v4u*)(mixed + (size_t)(rowb + ((qs + 8 * i + l8) << s) + r) * D + colq + c8 * 8) = ov; }
    if (hi == 0) lse[(size_t)(rowb + ((qs + a) << s) + r) * 12 + g * 4 + h] = mxs + __builtin_amdgcn_logf(l);
}

__device__ __forceinline__ f32x4 kv_row(const rsrc_t rc, const rsrc_t rp, bool maybe_new, int W, int b, int idx, int sel, int g, int h, int c) {
    if (maybe_new) { const bool nw = idx >= W; const int idc = nw ? W - 1 : idx;
        const f32x4 cv = __builtin_bit_cast(f32x4, bld16(rc, ((b * W + idc) * 2 + sel) * 1024 + (h * 64 + 4 * c) * 4, 0));
        const v2u pw = bld8(rp, (MP + b * 8 + (nw ? idx - W : 0)) * (NIN * 2) + (768 + sel * 768 + g * 256 + h * 64 + 4 * c) * 2, 0);
        const f32x4 pv = {bflo(pw.x), bfhi(pw.x), bflo(pw.y), bfhi(pw.y)};
        return nw ? pv : cv; }
    return __builtin_bit_cast(f32x4, bld16(rc, ((b * W + idx) * 2 + sel) * 1024 + (h * 64 + 4 * c) * 4, 0));
}
__device__ __forceinline__ void sample_task(Frame& F, const rsrc_t rp, int task, const int lane) {
    const int t = task & 7, h = (task >> 3) & 3, bg = task >> 5, g = bg % 3, b = bg / 3;
    const int rg = lane >> 4, c = lane & 15;
    const int W = 128 << (2 * g), sh = 2 * g;
    const rsrc_t rc = mk_rsrc(pick3(g, F.c0, F.c1, F.c2));
    const int qrow = MP + b * 8 + t;
    f32x4 q; { const v2u w = bld8(rp, qrow * (NIN * 2) + (g * 256 + h * 64 + 4 * c) * 2, 0); q = (f32x4){bflo(w.x), bfhi(w.x), bflo(w.y), bfhi(w.y)}; }
    f32x4 kv[33]; float sc[33];
#pragma unroll
    for (int i = 0; i < 33; ++i) { int j = 4 * i + rg; j = j > 128 ? 128 : j; kv[i] = kv_row(rc, rp, i < 2, W, b, W + t - (j << sh), 0, g, h, c); }
#pragma unroll
    for (int i = 0; i < 33; ++i) { float p = (kv[i][0] * q[0] + kv[i][1] * q[1]) + (kv[i][2] * q[2] + kv[i][3] * q[3]);
        p += __shfl_xor(p, 1); p += __shfl_xor(p, 2); p += __shfl_xor(p, 4); p += __shfl_xor(p, 8);
        sc[i] = (4 * i + rg) <= 128 ? p * C2 : -INFINITY; }
#pragma unroll
    for (int i = 0; i < 33; ++i) { int j = 4 * i + rg; j = j > 128 ? 128 : j; kv[i] = kv_row(rc, rp, i < 2, W, b, W + t - (j << sh), 1, g, h, c); }
    float mx = sc[0];
#pragma unroll
    for (int i = 1; i < 33; ++i) mx = fmaxf(mx, sc[i]);
    mx = fmaxf(mx, __shfl_xor(mx, 16)); mx = fmaxf(mx, __shfl_xor(mx, 32));
    float l = 0.f;
#pragma unroll
    for (int i = 0; i < 33; ++i) { sc[i] = __builtin_amdgcn_exp2f(sc[i] - mx); l += sc[i]; }
    l += __shfl_xor(l, 16); l += __shfl_xor(l, 32);
    f32x4 o = {0.f, 0.f, 0.f, 0.f};
#pragma unroll
    for (int i = 0; i < 33; ++i) o += kv[i] * sc[i];
#pragma unroll
    for (int e = 0; e < 4; ++e) { float v = o[e]; v += __shfl_xor(v, 16); v += __shfl_xor(v, 32); o[e] = v; }
    const float li = 1.0f / l;
    if (rg == 0) { v2u w; w.x = cvtpk(o[0] * li, o[1] * li); w.y = cvtpk(o[2] * li, o[3] * li); *(v2u*)(F.MIX + (size_t)qrow * D + g * 256 + h * 64 + 4 * c) = w; }
    if (lane == 0) F.LSE[(size_t)qrow * 12 + g * 4 + h] = mx + __builtin_amdgcn_logf(l);
}
}

__device__ __forceinline__ void unpack8(const v4u w, float (&f)[8]) { f[0] = bflo(w.x); f[1] = bfhi(w.x); f[2] = bflo(w.y); f[3] = bfhi(w.y); f[4] = bflo(w.z); f[5] = bfhi(w.z); f[6] = bflo(w.w); f[7] = bfhi(w.w); }
__device__ __forceinline__ void conv_u(const bf16* proj, size_t row, int ch, float (&u)[8]) {
    float cf[8], hf[8]; unpack8(*(const v4u*)(proj + row * NIN + 2560 + 8 * ch), cf); unpack8(*(const v4u*)(proj + row * NIN + 2816 + 8 * ch), hf);
#pragma unroll
    for (int e = 0; e < 8; ++e) u[e] = cf[e] * hf[e];
}
__device__ __forceinline__ void ld8f(const float* p, float (&u)[8]) { const f32x4 a = *(const f32x4*)p, b = *(const f32x4*)(p + 4); u[0] = a[0]; u[1] = a[1]; u[2] = a[2]; u[3] = a[3]; u[4] = b[0]; u[5] = b[1]; u[6] = b[2]; u[7] = b[3]; }

__device__ __forceinline__ void p2_mixers(Frame& F, const int mask) {
    int tid_ = F.tid; asm volatile("" : "+v"(tid_));
    const int lane_ = tid_ & 63;
    const int gt = F.vcu * (NWAVES * 64) + tid_, NGT = F.G * NWAVES * 64;
    const int gw = F.vcu * NWAVES + F.wave, NGW = F.G * NWAVES;
    const att::rsrc_t rp = att::mk_rsrc(F.PROJ);
    if (mask & 1) { LAS unsigned char* wl = F.lds + F.wave * att::WTILE;
      for (int T_ = gw; T_ < 8 * 12 * 256 * REP_A; T_ += NGW) { const int T = T_ % (8 * 12 * 256);
        const int sub = T & 255, bgh = T >> 8, h = bgh & 3, g = (bgh >> 2) % 3, b = bgh / 12;
        const int tpc = 256 >> (2 * g), r = sub / tpc, j = sub % tpc;
        att::prompt_tile(rp, F.MIX, F.LSE, wl, b, g, h, r, j, lane_);
      } }
    if (mask & 2) for (int task = gw; task < 128 * 12 * 8 * REP_B; task += NGW) att::sample_task(F, rp, task % (128 * 12 * 8), lane_);
    if (mask & 4) for (int it_ = gt; it_ < (M / 4) * 32 * REP_C; it_ += NGT) { const int it = it_ % ((M / 4) * 32);
        const int ch = it & 31, row0 = (it >> 5) * 4; const bool smp = row0 >= MP;
        const int t0 = smp ? ((row0 - MP) & 7) : (row0 & (TP - 1)), b = smp ? ((row0 - MP) >> 3) : (row0 >> 13);
        v4u cw[6], hw[6], bw[4];
#pragma unroll
        for (int k = 0; k < 6; ++k) { const int row = row0 - 2 + k; if (k >= 2 || t0 > 0) { cw[k] = *(const v4u*)(F.PROJ + (size_t)row * NIN + 2560 + 8 * ch); hw[k] = *(const v4u*)(F.PROJ + (size_t)row * NIN + 2816 + 8 * ch); } else { cw[k] = (v4u){0u, 0u, 0u, 0u}; hw[k] = cw[k]; } }
#pragma unroll
        for (int k = 0; k < 4; ++k) bw[k] = *(const v4u*)(F.PROJ + (size_t)(row0 + k) * NIN + 2304 + 8 * ch);
        float w0[8], w1[8], w2[8]; ld8f(F.conv_w + 8 * ch, w0); ld8f(F.conv_w + 256 + 8 * ch, w1); ld8f(F.conv_w + 512 + 8 * ch, w2);
        float u[6][8];
#pragma unroll
        for (int k = 0; k < 6; ++k) { float cf[8], hf[8]; unpack8(cw[k], cf); unpack8(hw[k], hf);
#pragma unroll
            for (int e = 0; e < 8; ++e) u[k][e] = cf[e] * hf[e]; }
        if (smp && t0 == 0) { ld8f(F.sconv + ((size_t)b * 2 + 0) * 256 + 8 * ch, u[0]); ld8f(F.sconv + ((size_t)b * 2 + 1) * 256 + 8 * ch, u[1]); }
#pragma unroll
        for (int k = 0; k < 4; ++k) { float bg[8], y[8]; unpack8(bw[k], bg);
#pragma unroll
            for (int e = 0; e < 8; ++e) y[e] = bg[e] * (w0[e] * u[k][e] + w1[e] * u[k + 1][e] + w2[e] * u[k + 2][e]);
            v4u o; o.x = att::cvtpk(y[0], y[1]); o.y = att::cvtpk(y[2], y[3]); o.z = att::cvtpk(y[4], y[5]); o.w = att::cvtpk(y[6], y[7]);
            *(v4u*)(F.MIX + (size_t)(row0 + k) * D + 768 + 8 * ch) = o; }
    }
    if (mask & 8) for (int g = 0; g < 3; ++g) {
        const int W = 128 << (2 * g); float* dst = F.out + (g == 0 ? O_KVP0 : (g == 1 ? O_KVP1 : O_KVP2));
        { const int NK = 8 * W * 64;
          for (int it0 = gt; it0 < NK; it0 += 4 * NGT) { v4u w[4];
#pragma unroll
            for (int k = 0; k < 4; ++k) { const int it = it0 + k * NGT; if (it < NK) { const int ch = it & 31, sel = (it >> 5) & 1, br = it >> 6, rr = br % W, b = br / W;
                w[k] = *(const v4u*)(F.PROJ + ((size_t)b * TP + TP - W + rr) * NIN + 768 + sel * 768 + g * 256 + 8 * ch); } }
#pragma unroll
            for (int k = 0; k < 4; ++k) { const int it = it0 + k * NGT; if (it < NK) { float f[8]; unpack8(w[k], f);
                float* o = dst + (size_t)it * 8; *(f32x4*)o = (f32x4){f[0], f[1], f[2], f[3]}; *(f32x4*)(o + 4) = (f32x4){f[4], f[5], f[6], f[7]}; } } } }
        float* dsts = F.out + (g == 0 ? O_KVS0 : (g == 1 ? O_KVS1 : O_KVS2));
        for (int it = gt; it < 128 * 8 * 64; it += NGT) { const int ch = it & 31, sel = (it >> 5) & 1, bt = it >> 6, t = bt & 7, b = bt >> 3;
            float f[8]; unpack8(*(const v4u*)(F.PROJ + ((size_t)MP + b * 8 + t) * NIN + 768 + sel * 768 + g * 256 + 8 * ch), f);
            float* o = dsts + (((size_t)b * W + (W - 8 + t)) * 2 + sel) * 256 + 8 * ch; *(f32x4*)o = (f32x4){f[0], f[1], f[2], f[3]}; *(f32x4*)(o + 4) = (f32x4){f[4], f[5], f[6], f[7]}; }
    }
    for (int it = gt; it < 8 * 2 * 32; it += NGT) { const int ch = it & 31, j = (it >> 5) & 1, b = it >> 6; float u[8]; conv_u(F.PROJ, (size_t)b * TP + TP - 2 + j, ch, u);
        float* o = F.out + O_CVP + (size_t)it * 8; *(f32x4*)o = (f32x4){u[0], u[1], u[2], u[3]}; *(f32x4*)(o + 4) = (f32x4){u[4], u[5], u[6], u[7]}; }
    for (int it = gt; it < 128 * 2 * 32; it += NGT) { const int ch = it & 31, j = (it >> 5) & 1, b = it >> 6; float u[8]; conv_u(F.PROJ, (size_t)MP + b * 8 + 6 + j, ch, u);
        float* o = F.out + O_CVS + (size_t)it * 8; *(f32x4*)o = (f32x4){u[0], u[1], u[2], u[3]}; *(f32x4*)(o + 4) = (f32x4){u[4], u[5], u[6], u[7]}; }
}
__device__ __forceinline__ void p2b_alpha(Frame& F) {
    const int gt = F.vcu * (NWAVES * 64) + F.tid, NGT = F.G * NWAVES * 64; constexpr int NIT = M * 32;
    for (int it0 = gt; it0 < NIT; it0 += 4 * NGT) {
        float ls[4][3]; v4u mw[4][3];
#pragma unroll
        for (int k = 0; k < 4; ++k) { const int it = it0 + k * NGT; if (it < NIT) { const int row = it >> 5, h = (it >> 3) & 3, ch = it & 7;
#pragma unroll
            for (int g = 0; g < 3; ++g) { ls[k][g] = F.LSE[(size_t)row * 12 + 4 * g + h]; mw[k][g] = *(const v4u*)(F.MIX + (size_t)row * D + g * 256 + h * 64 + 8 * ch); } } }
#pragma unroll
        for (int k = 0; k < 4; ++k) { const int it = it0 + k * NGT; if (it < NIT) { const int row = it >> 5, h = (it >> 3) & 3, ch = it & 7;
            const float mx = fmaxf(ls[k][0], fmaxf(ls[k][1], ls[k][2])); const float e0 = __builtin_amdgcn_exp2f(ls[k][0] - mx), e1 = __builtin_amdgcn_exp2f(ls[k][1] - mx), e2 = __builtin_amdgcn_exp2f(ls[k][2] - mx);
            const float inv = 1.0f / (e0 + e1 + e2); const float al[3] = {e0 * inv, e1 * inv, e2 * inv};
#pragma unroll
            for (int g = 0; g < 3; ++g) { float f[8]; unpack8(mw[k][g], f);
                v4u o; o.x = att::cvtpk(f[0] * al[g], f[1] * al[g]); o.y = att::cvtpk(f[2] * al[g], f[3] * al[g]); o.z = att::cvtpk(f[4] * al[g], f[5] * al[g]); o.w = att::cvtpk(f[6] * al[g], f[7] * al[g]);
                *(v4u*)(F.MIX + (size_t)row * D + g * 256 + h * 64 + 8 * ch) = o; } } }
    }
}
__device__ __forceinline__ void p6_final(Frame& F) {
    const int gw = F.vcu * NWAVES + F.wave, NGW = F.G * NWAVES;
    f32x4 gf[4];
#pragma unroll
    for (int j = 0; j < 4; ++j) gf[j] = ((const f32x4*)F.g_fin)[F.lane + 64 * j];
    for (int m0 = gw * 4; m0 < M; m0 += NGW * 4) {
        float sp[4]; f32x4 v[4][4];
#pragma unroll
        for (int r = 0; r < 4; ++r) sp[r] = F.ST2[(size_t)(m0 + r) * 16 + (F.lane & 15)];
#pragma unroll
        for (int r = 0; r < 4; ++r)
#pragma unroll
            for (int j = 0; j < 4; ++j) v[r][j] = ((const f32x4*)(F.out + (size_t)(m0 + r) * D))[F.lane + 64 * j];
#pragma unroll
        for (int r = 0; r < 4; ++r) { float ss = sp[r]; ss += __shfl_xor(ss, 1); ss += __shfl_xor(ss, 2); ss += __shfl_xor(ss, 4); ss += __shfl_xor(ss, 8);
            const float rstd = __builtin_amdgcn_rsqf(ss * (1.0f / D) + EPS);
#pragma unroll
            for (int j = 0; j < 4; ++j) ((f32x4*)(F.out + (size_t)(m0 + r) * D))[F.lane + 64 * j] = v[r][j] * rstd * gf[j]; }
    }
}

struct Args { const float* in[14]; float* out; unsigned char* ws; int ph_lo, ph_hi, probe, pad; };
__global__ void __launch_bounds__(NWAVES * 64, 2) mega_fwd(Args args) {
    extern __shared__ __attribute__((aligned(16))) unsigned char lds[];
    cg::grid_group grid = cg::this_grid();
    Frame F;
    F.lds = (LAS unsigned char*)lds;
    F.tid = threadIdx.x; F.lane = F.tid & 63; F.wave = __builtin_amdgcn_readfirstlane(F.tid >> 6);
    F.G = gridDim.x; { const int bx = blockIdx.x; F.vcu = (F.G % 8 == 0) ? (bx % 8) * (F.G / 8) + bx / 8 : bx; }
    unsigned char* ws = args.ws;
    F.xp = args.in[0]; F.xs = args.in[1]; F.c0 = args.in[2]; F.c1 = args.in[3]; F.c2 = args.in[4]; F.sconv = args.in[5]; F.g_attn = args.in[6]; F.w_in = args.in[7];
    F.conv_w = args.in[8]; F.w_out = args.in[9]; F.g_mlp = args.in[10]; F.w_up = args.in[11]; F.w_down = args.in[12]; F.g_fin = args.in[13]; F.out = args.out;
    F.Win_t = (bf16*)(ws + WS_WIN); F.Wout_t = (bf16*)(ws + WS_WOUT); F.Wup_t = (bf16*)(ws + WS_WUP); F.Wdn_t = (bf16*)(ws + WS_WDN);
    F.XB = (bf16*)(ws + WS_XB); F.PROJ = (bf16*)(ws + WS_PROJ); F.MIX = (bf16*)(ws + WS_MIX); F.HB = (bf16*)(ws + WS_HB);
    F.RSTD0 = (float*)(ws + WS_RSTD0); F.ST1 = (float*)(ws + WS_ST1); F.ST2 = (float*)(ws + WS_ST2); F.LSE = (float*)(ws + WS_LSE);
    const int lo = args.ph_lo, hi = args.ph_hi;
#define IN(k) (lo <= (k) && (k) < hi)
#define SEAM(k) do { if (IN(k) && IN((k) + 1)) grid.sync(); } while (0)

    if (IN(0)) { p0_prologue(F); if (PROBE_REP == 0) p0_prologue(F); }
    SEAM(0);
    if (IN(1)) {
        pg8::Gemm g{F.XB, F.Win_t, M, NIN, D}; pg8::StaticOrder S; S.init(M, NIN, F.G, (int)blockIdx.x);
        pg8::EpiScaleBf16<0> E{F.PROJ, NIN, F.RSTD0, EPS, pg8::CopyJob{F.c0, F.c1, F.c2, F.out + O_KVS0, F.out + O_KVS1, F.out + O_KVS2, 0}};
        pg8::gemm_phase<pg8::EpiScaleBf16<0>, pg8::StaticOrder, PG8_ALIGN, PG8_SP2>(F.lds, g, S, E);
        if (PROBE_REP == 1) { __syncthreads(); pg8::gemm_phase<pg8::EpiScaleBf16<0>, pg8::StaticOrder, PG8_ALIGN, PG8_SP2>(F.lds, g, S, E); }
    }
    SEAM(1);
    if (IN(2)) p2_mixers(F, 15);
    SEAM(2);
    if (IN(3)) p2b_alpha(F);
    SEAM(3);
    if (IN(4)) {
        pg8::Gemm g{F.MIX, F.Wout_t, M, D, D}; pg8::StaticOrder S; S.init(M, D, F.G, (int)blockIdx.x);
        pg8::EpiRes<true> E{F.xp, F.xs, MP, F.out, F.XB, F.ST1};
        pg8::gemm_phase<pg8::EpiRes<true>, pg8::StaticOrder, PG8_ALIGN, PG8_SP2>(F.lds, g, S, E);
    }
    SEAM(4);
    if (IN(5)) {
        pg8::Gemm g{F.XB, F.Wup_t, M, FF, D}; pg8::StaticOrder S; S.init(M, FF, F.G, (int)blockIdx.x);
        pg8::EpiScaleBf16<1> E{F.HB, FF, F.ST1, EPS, pg8::CopyJob{F.c0, F.c1, F.c2, F.out + O_KVS0, F.out + O_KVS1, F.out + O_KVS2, (M / 256) * (NIN / 256)}};
        pg8::gemm_phase<pg8::EpiScaleBf16<1>, pg8::StaticOrder, PG8_ALIGN, PG8_SP2>(F.lds, g, S, E);
    }
    SEAM(5);
    if (IN(6)) {
        pg8::Gemm g{F.HB, F.Wdn_t, M, D, FF}; pg8::StaticOrder S; S.init(M, D, F.G, (int)blockIdx.x);
        pg8::EpiRes<false> E{F.out, F.out, 1 << 30, F.out, nullptr, F.ST2};
        pg8::gemm_phase<pg8::EpiRes<false>, pg8::StaticOrder, PG8_ALIGN, PG8_SP2>(F.lds, g, S, E);
    }
    SEAM(6);
    if (IN(7)) p6_final(F);
#undef IN
#undef SEAM
}

extern "C" void kernel_launch(void* const* d_in, const int* in_sizes, int n_in, void* d_out, int out_size, void* d_ws, size_t ws_size, hipStream_t stream) {
    static int grid = 0;
    if (grid == 0) {
        if (n_in != 14 || in_sizes[0] != MP * D || (size_t)out_size != O_END || ws_size < WS_END) { fprintf(stderr, "kernel_launch: unexpected shapes (n_in %d, in0 %d, out %d, ws %zu); nothing launched\n", n_in, n_in > 0 ? in_sizes[0] : -1, out_size, ws_size); grid = -1; return; }
        int dev = 0, cus = 0, per_cu = 0;
        if (hipGetDevice(&dev) != hipSuccess || hipDeviceGetAttribute(&cus, hipDeviceAttributeMultiprocessorCount, dev) != hipSuccess) { grid = -1; return; }
        if (hipFuncSetAttribute((const void*)mega_fwd, hipFuncAttributeMaxDynamicSharedMemorySize, LDS_BYTES) != hipSuccess) { fprintf(stderr, "kernel_launch: hipFuncSetAttribute failed\n"); grid = -1; return; }
        if (hipOccupancyMaxActiveBlocksPerMultiprocessor(&per_cu, (const void*)mega_fwd, NWAVES * 64, LDS_BYTES) != hipSuccess || per_cu < 1) { fprintf(stderr, "kernel_launch: occupancy query failed (%d)\n", per_cu); (void)hipGetLastError(); grid = -1; return; }
        grid = cus;
    }
    if (grid < 0) return;
    Args a{};
    for (int i = 0; i < 14; ++i) a.in[i] = (const float*)d_in[i];
    a.out = (float*)d_out; a.ws = (unsigned char*)d_ws; a.probe = PROBE_P2MASK;
    if (MK_N_LAUNCHES == 1) {
        a.ph_lo = 0; a.ph_hi = 8;
        void* kargs[] = {&a};
        const hipError_t e = hipLaunchCooperativeKernel((const void*)mega_fwd, dim3(grid), dim3(NWAVES * 64), kargs, LDS_BYTES, stream);
        if (e != hipSuccess) fprintf(stderr, "kernel_launch: cooperative launch failed: %s (grid %d)\n", hipGetErrorString(e), grid);
    } else {
        for (int p = 0; p < 8; ++p) { a.ph_lo = p; a.ph_hi = p + 1; hipLaunchKernelGGL(mega_fwd, dim3(grid), dim3(NWAVES * 64), LDS_BYTES, stream, a); }
    }
}
```

```cpp
#include <hip/hip_runtime.h>
#include <cstdio>
#include <cstdint>
#include <hip/hip_cooperative_groups.h>
namespace cg = cooperative_groups;
namespace pg8 {
#define PG8_LAS __attribute__((address_space(3)))
typedef unsigned short bf16_t;
typedef short bf16x8 __attribute__((ext_vector_type(8)));
typedef float f32x4 __attribute__((ext_vector_type(4)));
typedef unsigned u32x4 __attribute__((ext_vector_type(4)));
constexpr int BM = 256, BK = 64, HALF = 128, HTB = HALF * BK * 2  , STAGE_BYTES = 8 * HTB, NXCD = 8, WGM = 8;

__host__ __device__ __forceinline__ int lds_byte(int r, int c) { const int st = (r >> 4) * 2 + (c >> 5), rr = r & 15, cc = c & 31, ob = rr * 64 + cc * 2; return st * 1024 + (ob ^ (((ob >> 9) & 1) << 5)); }
__host__ __device__ __forceinline__ void stage_rc(int b, int& R, int& C) { const int st = b / 1024, sb = b % 1024, swz = sb ^ (((sb >> 9) & 1) << 5); R = (st >> 1) * 16 + swz / 64; C = (st & 1) * 32 + (swz % 64) / 2; }
__host__ __device__ __forceinline__ int perm32(int rho) { const int n = rho >> 4, i = rho & 15; return 8 * (i >> 2) + 4 * n + (i & 3); }

struct Unit { int pm, pn, lin, ks, ns; };
struct Gemm { const bf16_t* A; const bf16_t* Bt; int M, N, K; float* part; unsigned* cnt; };

struct StaticOrder {
    int nM, nN, nwg, G, c, nfull, S, nitems;
    __host__ __device__ void init(int M, int N, int G_, int c_, int S_ = 1) { nM = M / BM; nN = N / BM; nwg = nM * nN; G = G_; c = c_; S = S_; nfull = S_ > 1 ? (nwg / G_) * G_ : nwg; nitems = nfull + (nwg - nfull) * S_; }
    __host__ __device__ bool next(int i, Unit& u) const {
        const long L = (long)i * G + c; if (L >= nitems) return false;
        int wgid = (int)L; u.ks = 0; u.ns = 1;
        if (wgid >= nfull) { const int e = wgid - nfull; wgid = nfull + e / S; u.ks = e % S; u.ns = S; }
        u.lin = wgid;
        { const int q = nwg / NXCD, r = nwg % NXCD, xcd = wgid % NXCD, off = wgid / NXCD; wgid = (xcd < r ? xcd * (q + 1) : r * (q + 1) + (xcd - r) * q) + off; }
        const int nig = WGM * nN, gid = wgid / nig, fm = gid * WGM, gsz = (nM - fm) < WGM ? (nM - fm) : WGM;
        u.pm = fm + ((wgid % nig) % gsz); u.pn = (wgid % nig) / gsz; return true;
    }
    __device__ __forceinline__ void a_ready(const Unit&) const {}
    __device__ __forceinline__ void done(const Unit&) const {}
};

__device__ __forceinline__ unsigned cvt_pk_bf16(float lo, float hi) { unsigned r; asm volatile("v_cvt_pk_bf16_f32 %0, %1, %2" : "=v"(r) : "v"(lo), "v"(hi)); return r; }
typedef float f32x2 __attribute__((ext_vector_type(2)));
constexpr int NCP = 6, CP_CHUNK = 512 * NCP;
constexpr int CP_C0 = 128 * 5, CP_C1 = 128 * 21, CP_C2 = 128 * 85, CP_NCHUNK = CP_C0 + CP_C1 + CP_C2;
struct CopyJob { const float *s0, *s1, *s2; float *d0, *d1, *d2; int base; };
__device__ __forceinline__ void cp_chunk(const CopyJob& cj, int chunk, const float*& sp, float*& dp, int& so, int& dof) {
    chunk = chunk >= CP_NCHUNK ? CP_NCHUNK - 1 : chunk;
    if (chunk < CP_C0) { const int b = chunk / 5, k = (chunk - b * 5) * CP_CHUNK; sp = cj.s0; dp = cj.d0; so = ((b * 128 + 8) * 128 + k) * 16; dof = (b * 128 * 128 + k) * 16; }
    else if (chunk < CP_C0 + CP_C1) { const int i = chunk - CP_C0, b = i / 21, k = (i - b * 21) * CP_CHUNK; sp = cj.s1; dp = cj.d1; so = ((b * 512 + 8) * 128 + k) * 16; dof = (b * 512 * 128 + k) * 16; }
    else { const int i = chunk - CP_C0 - CP_C1, b = i / 85, k = (i - b * 85) * CP_CHUNK; sp = cj.s2; dp = cj.d2; so = ((b * 2048 + 8) * 128 + k) * 16; dof = (b * 2048 * 128 + k) * 16; }
}
template <int MODE> struct EpiScaleBf16 {
    static constexpr bool PERM = true, AFTER_DRAIN = false;
    bf16_t* O; int ldc; const float* rs; float eps; CopyJob cj; bf16_t* QKVP; int perm_rows;
    __device__ __forceinline__ void operator()(const f32x4 (&acc)[2][2][4][2], const Unit& u, int wr, int wc, int fr, int fq) const {
        const int row0 = u.pm * BM + wr * 64 + fr; const int col0 = u.pn * BM + wc * 32 + 8 * fq;
        float sc[8];
        if (MODE == 0) {
#pragma unroll
            for (int i = 0; i < 8; ++i) sc[i] = rs[row0 + (i >> 2) * HALF + (i & 3) * 16];
        } else {
            f32x4 pv[8];
#pragma unroll
            for (int i = 0; i < 8; ++i) pv[i] = *(const f32x4*)(rs + (size_t)(row0 + (i >> 2) * HALF + (i & 3) * 16) * 16 + 4 * fq);
#pragma unroll
            for (int i = 0; i < 8; ++i) { float ss = (pv[i][0] + pv[i][1]) + (pv[i][2] + pv[i][3]); ss += __shfl_xor(ss, 16); ss += __shfl_xor(ss, 32);
                sc[i] = __builtin_amdgcn_rsqf(ss * (1.0f / 1024.0f) + eps); }
        }
        u32x4 cpa[NCP], cpb[NCP]; const float *spa, *spb; float *dpa, *dpb; int soa, sob, doa, dob;
        { const int ch = __builtin_amdgcn_readfirstlane(u.ns > 1 ? CP_NCHUNK : 2 * (cj.base + u.lin)); cp_chunk(cj, ch, spa, dpa, soa, doa); cp_chunk(cj, ch + 1, spb, dpb, sob, dob); }
        const int toff = threadIdx.x * 16;
        { const __amdgpu_buffer_rsrc_t ra = __builtin_amdgcn_make_buffer_rsrc((void*)spa, 0, 0x7fffffff, 0x00020000), rb = __builtin_amdgcn_make_buffer_rsrc((void*)spb, 0, 0x7fffffff, 0x00020000);
#pragma unroll
          for (int j = 0; j < NCP; ++j) cpa[j] = __builtin_amdgcn_raw_buffer_load_b128(ra, toff, soa + j * 8192, 0);
#pragma unroll
          for (int j = 0; j < NCP; ++j) cpb[j] = __builtin_amdgcn_raw_buffer_load_b128(rb, toff, sob + j * 8192, 0); }
        asm volatile("" ::: "memory");
#pragma unroll
        for (int ai = 0; ai < 2; ++ai)
#pragma unroll
            for (int m = 0; m < 4; ++m) { const int row = row0 + ai * HALF + m * 16; const float s1 = sc[ai * 4 + m];
                bf16_t* rowp = O + (size_t)row * ldc + col0; int bjs = HALF;
                if (MODE == 0 && QKVP != nullptr && u.pn < 9 && u.pm * BM < perm_rows) {
                    const int sel = u.pn / 3, g = u.pn - 3 * sel, sh = 2 * g, b = row >> 13, t = row & 8191, prow = (t & ((1 << sh) - 1)) * (8192 >> sh) + (t >> sh);
                    rowp = QKVP + ((size_t)((((sel * 3 + g) * 4 + (wc >> 1)) * 8 + b) * 8192 + prow)) * 64 + (wc & 1) * 32 + 8 * fq; bjs = 2 * 8 * 8192 * 64; }
#pragma unroll
                for (int bj = 0; bj < 2; ++bj) { f32x4 v0 = acc[ai][bj][m][0] * s1, v1 = acc[ai][bj][m][1] * s1;
                    if (MODE == 1) {
#pragma unroll
                        for (int e = 0; e < 4; ++e) { const float x0 = fmaxf(v0[e], 0.f), x1 = fmaxf(v1[e], 0.f); v0[e] = x0 * x0; v1[e] = x1 * x1; } }
                    u32x4 w; w.x = cvt_pk_bf16(v0[0], v0[1]); w.y = cvt_pk_bf16(v0[2], v0[3]); w.z = cvt_pk_bf16(v1[0], v1[1]); w.w = cvt_pk_bf16(v1[2], v1[3]);
                    *(u32x4*)(rowp + (size_t)bj * bjs) = w; } }
        asm volatile("" ::: "memory");
        { const __amdgpu_buffer_rsrc_t ra = __builtin_amdgcn_make_buffer_rsrc((void*)dpa, 0, 0x7fffffff, 0x00020000), rb = __builtin_amdgcn_make_buffer_rsrc((void*)dpb, 0, 0x7fffffff, 0x00020000);
#pragma unroll
          for (int j = 0; j < NCP; ++j) __builtin_amdgcn_raw_buffer_store_b128(cpa[j], ra, toff, doa + j * 8192, 0);
#pragma unroll
          for (int j = 0; j < NCP; ++j) __builtin_amdgcn_raw_buffer_store_b128(cpb[j], rb, toff, dob + j * 8192, 0); }
    }
};
template <bool WB> struct EpiRes {
    static constexpr bool PERM = false, AFTER_DRAIN = false;
    const float* base0; const float* base1; int split_row; float* out; bf16_t* xb; float* stats;
    __device__ __forceinline__ void operator()(const f32x4 (&acc)[2][2][4][2], const Unit& u, int wr, int wc, int fr, int fq) const {
        typedef unsigned u32x2v __attribute__((ext_vector_type(2)));
        const int col0 = u.pn * BM + wc * 32 + 4 * fq; const int rt0 = u.pm * BM;
        const float* base = rt0 < split_row ? base0 : base1; const int rsub = rt0 < split_row ? 0 : split_row;
#pragma unroll
        for (int ai = 0; ai < 2; ++ai)
#pragma unroll
            for (int m = 0; m < 4; ++m) { const int r = rt0 + ai * HALF + wr * 64 + m * 16 + fr; const size_t off = (size_t)r * 1024 + col0, offb = (size_t)(r - rsub) * 1024 + col0; float ss = 0.f;
#pragma unroll
                for (int bj = 0; bj < 2; ++bj)
#pragma unroll
                    for (int n = 0; n < 2; ++n) { const f32x4 bs = *(const f32x4*)(base + offb + bj * HALF + n * 16); const f32x4 o = bs + acc[ai][bj][m][n];
                        *(f32x4*)(out + off + bj * HALF + n * 16) = o;
                        if (WB) { u32x2v w; w.x = cvt_pk_bf16(o[0], o[1]); w.y = cvt_pk_bf16(o[2], o[3]); *(u32x2v*)(xb + off + bj * HALF + n * 16) = w; }
                        ss += (o[0] * o[0] + o[1] * o[1]) + (o[2] * o[2] + o[3] * o[3]); }
                ss += __shfl_xor(ss, 16); ss += __shfl_xor(ss, 32);
                if (fq == 0) stats[(size_t)r * 16 + u.pn * 4 + wc] = ss;
                if (m & 1) asm volatile("" ::: "memory"); }
    }
};

template <class Epi, class Sched, bool ALIGN_EPI = false, bool SP2 = false>
__device__ __forceinline__ void gemm_phase(PG8_LAS unsigned char* lds, const Gemm g, const Sched& S, const Epi& E) {
    const int tid = threadIdx.x, wid = __builtin_amdgcn_readfirstlane(tid >> 6), lane = tid & 63, wr = wid >> 2, wc = wid & 3, fr = lane & 15, fq = lane >> 4;
    const int K = g.K;
    unsigned voffA[2], voffB[2];
#pragma unroll
    for (int i = 0; i < 2; ++i) { int R, C; stage_rc(tid * 16 + i * 8192, R, C); const int Rb = Epi::PERM ? ((R & ~31) + perm32(R & 31)) : R;
        voffA[i] = (unsigned)(R * K + C) * 2u; voffB[i] = (unsigned)(Rb * K + C) * 2u; }
    const size_t kstep = (size_t)(BK * 2);
    const size_t hstep = (size_t)HALF * K * 2;
    const size_t tstep = 2 * hstep;
    const unsigned ldsw = (unsigned)wid * 1024u;
    const int aoff = lds_byte(wr * 64 + fr, fq * 8), boff = lds_byte(wc * 32 + fr, fq * 8);
#define PG8_SA(b, h) (((b) * 2 + (h)) * HTB)
#define PG8_SB(b, h) ((4 + (b) * 2 + (h)) * HTB)
#define PG8_STAGE(bufoff, gbase, voff) do { _Pragma("unroll") for (int _i = 0; _i < 2; ++_i) \
        __builtin_amdgcn_global_load_lds((const unsigned*)((const char*)(gbase) + (voff)[_i]), (PG8_LAS unsigned*)(lds + (bufoff) + ldsw + _i * 8192), 16, 0, 0); } while (0)
#define PG8_LDA(dst, b, h) do { _Pragma("unroll") for (int m = 0; m < 4; ++m) _Pragma("unroll") for (int k = 0; k < 2; ++k) dst[m][k] = *(const PG8_LAS bf16x8*)(lds + PG8_SA(b, h) + aoff + m * 2048 + k * 1024); } while (0)
#define PG8_LDB(dst, b, h) do { _Pragma("unroll") for (int n = 0; n < 2; ++n) _Pragma("unroll") for (int k = 0; k < 2; ++k) dst[n][k] = *(const PG8_LAS bf16x8*)(lds + PG8_SB(b, h) + boff + n * 2048 + k * 1024); } while (0)
#define PG8_MMA(ai, bj, At, Bt) do { __builtin_amdgcn_s_setprio(1); _Pragma("unroll") for (int m = 0; m < 4; ++m) _Pragma("unroll") for (int n = 0; n < 2; ++n) _Pragma("unroll") for (int k = 0; k < 2; ++k) \
        acc[ai][bj][m][n] = __builtin_amdgcn_mfma_f32_16x16x32_bf16(Bt[n][k], At[m][k], acc[ai][bj][m][n], 0, 0, 0); __builtin_amdgcn_s_setprio(0); } while (0)
#define PG8_WAIT_V(n) asm volatile("s_waitcnt vmcnt(" #n ")" ::: "memory")
#define PG8_WAIT_L(n) asm volatile("s_waitcnt lgkmcnt(" #n ")" ::: "memory")
#define PG8_BAR __builtin_amdgcn_s_barrier()
#define PG8_SCHED __builtin_amdgcn_sched_barrier(0)
    Unit cur, nxt; int ui = 0;
    if (!S.next(0, cur)) return;
    f32x4 acc[2][2][4][2];
#pragma unroll
    for (int a = 0; a < 2; ++a)
#pragma unroll
        for (int b = 0; b < 2; ++b)
#pragma unroll
            for (int m = 0; m < 4; ++m)
#pragma unroll
                for (int n = 0; n < 2; ++n) acc[a][b][m][n] = (f32x4){0.f, 0.f, 0.f, 0.f};
    bf16x8 At[4][2], B0[2][2], B1[2][2];
    int nt = K / BK / cur.ns; size_t koff = (size_t)cur.ks * nt * kstep;
    const char* cA = (const char*)g.A + (size_t)cur.pm * tstep + koff; const char* cB = (const char*)g.Bt + (size_t)cur.pn * tstep + koff;
    S.a_ready(cur);
    if constexpr (SP2) {
        PG8_STAGE(PG8_SB(0, 0), cB, voffB); PG8_STAGE(PG8_SB(0, 1), cB + hstep, voffB); PG8_STAGE(PG8_SA(0, 0), cA, voffA); PG8_STAGE(PG8_SA(0, 1), cA + hstep, voffA);
        if (wr == 1) PG8_BAR;
        PG8_WAIT_V(2); PG8_BAR;
        PG8_STAGE(PG8_SB(1, 0), cB + kstep, voffB); PG8_STAGE(PG8_SA(1, 0), cA + kstep, voffA); PG8_STAGE(PG8_SB(1, 1), cB + hstep + kstep, voffB);
        PG8_WAIT_V(6); PG8_BAR;
    } else {
        PG8_STAGE(PG8_SB(0, 0), cB, voffB); PG8_STAGE(PG8_SA(0, 0), cA, voffA); PG8_STAGE(PG8_SB(0, 1), cB + hstep, voffB); PG8_STAGE(PG8_SA(0, 1), cA + hstep, voffA);
        if (wr == 1) PG8_BAR;
        PG8_WAIT_V(4); PG8_BAR;
        PG8_STAGE(PG8_SB(1, 0), cB + kstep, voffB); PG8_STAGE(PG8_SA(1, 0), cA + kstep, voffA); PG8_STAGE(PG8_SB(1, 1), cB + hstep + kstep, voffB);
        PG8_WAIT_V(6); PG8_BAR;
    }
    for (;;) {
        const bool has_next = S.next(ui + 1, nxt);
        const int nnt = has_next ? K / BK / nxt.ns : nt; const size_t nkoff = has_next ? (size_t)nxt.ks * nnt * kstep : 0;
        const char* nA = has_next ? (const char*)g.A + (size_t)nxt.pm * tstep + nkoff : cA; const char* nB = has_next ? (const char*)g.Bt + (size_t)nxt.pn * tstep + nkoff : cB;
        for (int t = 0; t < nt; t += 2) {
            const bool last = (t == nt - 2);
            const char* a1 = cA + (size_t)(t + 1) * kstep;
            const char* a2 = last ? nA : cA + (size_t)(t + 2) * kstep; const char* b2 = last ? nB : cB + (size_t)(t + 2) * kstep;
            const char* a3 = a2 + kstep; const char* b3 = b2 + kstep;
            if (last && has_next) S.a_ready(nxt);
            if constexpr (SP2) {
            PG8_LDB(B0, 0, 0); PG8_LDB(B1, 0, 1); PG8_SCHED; PG8_LDA(At, 0, 0); PG8_STAGE(PG8_SA(1, 1), a1 + hstep, voffA);
            PG8_WAIT_V(8); PG8_WAIT_L(0); PG8_BAR; PG8_MMA(0, 0, At, B0); PG8_MMA(0, 1, At, B1); PG8_BAR; PG8_SCHED;
            PG8_LDA(At, 0, 1); PG8_STAGE(PG8_SB(0, 0), b2, voffB); PG8_STAGE(PG8_SB(0, 1), b2 + hstep, voffB); PG8_STAGE(PG8_SA(0, 0), a2, voffA);
            PG8_WAIT_V(8); PG8_WAIT_L(0); PG8_BAR; PG8_MMA(1, 0, At, B0); PG8_MMA(1, 1, At, B1); PG8_BAR; PG8_SCHED;
            PG8_LDB(B0, 1, 0); PG8_LDB(B1, 1, 1); PG8_SCHED; PG8_LDA(At, 1, 0); PG8_STAGE(PG8_SA(0, 1), a2 + hstep, voffA);
            PG8_WAIT_V(8); PG8_WAIT_L(0); PG8_BAR; PG8_MMA(0, 0, At, B0); PG8_MMA(0, 1, At, B1); PG8_BAR; PG8_SCHED;
            PG8_LDA(At, 1, 1); PG8_STAGE(PG8_SB(1, 0), b3, voffB); PG8_STAGE(PG8_SB(1, 1), b3 + hstep, voffB); PG8_STAGE(PG8_SA(1, 0), a3, voffA);
            PG8_WAIT_V(8); PG8_WAIT_L(0); PG8_BAR; PG8_MMA(1, 0, At, B0); PG8_MMA(1, 1, At, B1); PG8_BAR; PG8_SCHED;
            } else {
            PG8_LDB(B0, 0, 0); PG8_SCHED; PG8_LDA(At, 0, 0); PG8_STAGE(PG8_SA(1, 1), a1 + hstep, voffA);
            PG8_WAIT_L(8); PG8_BAR; PG8_WAIT_L(0); PG8_MMA(0, 0, At, B0); PG8_BAR; PG8_SCHED;
            PG8_LDB(B1, 0, 1); PG8_STAGE(PG8_SB(0, 0), b2, voffB);
            PG8_BAR; PG8_WAIT_L(0); PG8_MMA(0, 1, At, B1); PG8_BAR;
            PG8_LDA(At, 0, 1); PG8_STAGE(PG8_SA(0, 0), a2, voffA);
            PG8_BAR; PG8_WAIT_L(0); PG8_MMA(1, 0, At, B0); PG8_BAR; PG8_SCHED;
            PG8_STAGE(PG8_SB(0, 1), b2 + hstep, voffB);
            PG8_WAIT_V(6); PG8_BAR; PG8_MMA(1, 1, At, B1); PG8_BAR;
            PG8_LDB(B0, 1, 0); PG8_SCHED; PG8_LDA(At, 1, 0); PG8_STAGE(PG8_SA(0, 1), a2 + hstep, voffA);
            PG8_WAIT_L(8); PG8_BAR; PG8_WAIT_L(0); PG8_MMA(0, 0, At, B0); PG8_BAR; PG8_SCHED;
            PG8_LDB(B1, 1, 1); PG8_STAGE(PG8_SB(1, 0), b3, voffB);
            PG8_BAR; PG8_WAIT_L(0); PG8_MMA(0, 1, At, B1); PG8_BAR;
            PG8_LDA(At, 1, 1); PG8_STAGE(PG8_SA(1, 0), a3, voffA);
            PG8_BAR; PG8_WAIT_L(0); PG8_MMA(1, 0, At, B0); PG8_BAR; PG8_SCHED;
            PG8_STAGE(PG8_SB(1, 1), b3 + hstep, voffB);
            PG8_WAIT_V(6); PG8_BAR; PG8_MMA(1, 1, At, B1); PG8_BAR;
            }
        }
        if constexpr (ALIGN_EPI) { if (wr == 0) PG8_BAR; }
        if constexpr (!Epi::AFTER_DRAIN) {
            bool do_epi = true;
            if (cur.ns > 1) {
                const int tt = cur.lin - S.nfull;
                unsigned* part = (unsigned*)g.part + ((size_t)(tt * cur.ns + cur.ks) * 8 + wid) * 8192 + lane;
#pragma unroll
                for (int a = 0; a < 2; ++a)
#pragma unroll
                    for (int b = 0; b < 2; ++b)
#pragma unroll
                        for (int m = 0; m < 4; ++m)
#pragma unroll
                            for (int n = 0; n < 2; ++n)
#pragma unroll
                                for (int e = 0; e < 4; ++e) { const float fv = acc[a][b][m][n][e]; __hip_atomic_store(part + ((((a * 2 + b) * 4 + m) * 2 + n) * 4 + e) * 64, __float_as_uint(fv), __ATOMIC_RELAXED, __HIP_MEMORY_SCOPE_AGENT); }
                asm volatile("s_waitcnt vmcnt(0)" ::: "memory");
                unsigned old = 0u; if (lane == 0) old = __hip_atomic_fetch_add(g.cnt + tt * 8 + wid, 1u, __ATOMIC_RELAXED, __HIP_MEMORY_SCOPE_AGENT);
                old = (unsigned)__builtin_amdgcn_readfirstlane((int)old);
                do_epi = (old == (unsigned)(cur.ns - 1));
                if (do_epi) {
                    __builtin_amdgcn_fence(__ATOMIC_ACQUIRE, "agent");
#pragma unroll
                    for (int a = 0; a < 2; ++a)
#pragma unroll
                        for (int b = 0; b < 2; ++b)
#pragma unroll
                            for (int m = 0; m < 4; ++m)
#pragma unroll
                                for (int n = 0; n < 2; ++n) acc[a][b][m][n] = (f32x4){0.f, 0.f, 0.f, 0.f};
#pragma unroll 1
                    for (int k = 0; k < cur.ns; ++k) { unsigned* pk = (unsigned*)g.part + ((size_t)(tt * cur.ns + k) * 8 + wid) * 8192 + lane;
#pragma unroll
                        for (int a = 0; a < 2; ++a)
#pragma unroll
                            for (int b = 0; b < 2; ++b)
#pragma unroll
                                for (int m = 0; m < 4; ++m)
#pragma unroll
                                    for (int n = 0; n < 2; ++n)
#pragma unroll
                                        for (int e = 0; e < 4; ++e) { const unsigned uv = __hip_atomic_load(pk + ((((a * 2 + b) * 4 + m) * 2 + n) * 4 + e) * 64, __ATOMIC_RELAXED, __HIP_MEMORY_SCOPE_AGENT); acc[a][b][m][n][e] += __uint_as_float(uv); } }
                }
            }
            if (do_epi) E(acc, cur, wr, wc, fr, fq);
            S.done(cur); }
        if (!has_next) break;
#pragma unroll
        for (int a = 0; a < 2; ++a)
#pragma unroll
            for (int b = 0; b < 2; ++b)
#pragma unroll
                for (int m = 0; m < 4; ++m)
#pragma unroll
                    for (int n = 0; n < 2; ++n) acc[a][b][m][n] = (f32x4){0.f, 0.f, 0.f, 0.f};
        cur = nxt; cA = nA; cB = nB; nt = nnt; ++ui;
        if constexpr (ALIGN_EPI) { if (wr == 1) PG8_BAR; }
    }
    PG8_WAIT_V(0);
    if constexpr (!ALIGN_EPI) { if (wr == 0) PG8_BAR; }
    PG8_BAR;
    if constexpr (Epi::AFTER_DRAIN) { E.fused(acc, cur, wr, wc, fr, fq, lds, wid, lane); S.done(cur); }
#undef PG8_SA
#undef PG8_SB
#undef PG8_STAGE
#undef PG8_LDA
#undef PG8_LDB
#undef PG8_MMA
#undef PG8_WAIT_V
#undef PG8_WAIT_L
#undef PG8_BAR
#undef PG8_SCHED
}
}
#ifndef PG8_SP2
#define PG8_SP2 true
#endif
#ifndef PG8_ALIGN
#define PG8_ALIGN true
#endif
#ifndef PROBE_REP
#define PROBE_REP -1
#endif
#ifndef REP_A
#define REP_A 1
#endif
#ifndef REP_B
#define REP_B 1
#endif
#ifndef REP_C
#define REP_C 1
#endif
#ifndef PROBE_P2MASK
#define PROBE_P2MASK 0
#endif
#ifndef MK_N_LAUNCHES
#define MK_N_LAUNCHES 1
#endif

constexpr int D = 1024, FF = 4096, NIN = 3072;
constexpr int MP = 8 * 8192, MS = 128 * 8, M = MP + MS;
constexpr int TP = 8192;
constexpr float EPS = 1e-6f;
constexpr int NWAVES = 8;
#define GAS __attribute__((address_space(1)))
#define LAS __attribute__((address_space(3)))
typedef unsigned short bf16;
typedef unsigned v4u __attribute__((ext_vector_type(4)));
typedef unsigned v2u __attribute__((ext_vector_type(2)));
typedef float f32x4 __attribute__((ext_vector_type(4)));
typedef short bf16x8 __attribute__((ext_vector_type(8)));
typedef short s16x4 __attribute__((ext_vector_type(4)));
typedef float f32x16 __attribute__((ext_vector_type(16)));

constexpr size_t MiB = 1u << 20;
constexpr size_t WS_WIN = 0, WS_WOUT = 6 * MiB, WS_WUP = 8 * MiB, WS_WDN = 16 * MiB;
constexpr size_t WS_RSTD0 = 24 * MiB;
constexpr size_t WS_ST1 = 25 * MiB, WS_ST2 = 30 * MiB;
constexpr size_t WS_LSE = 35 * MiB;
constexpr size_t WS_XB = 40 * MiB;
constexpr size_t WS_PROJ = 172 * MiB;
constexpr size_t WS_MIX = 564 * MiB;
constexpr size_t WS_HB = 696 * MiB;
constexpr size_t WS_QKVP = 1220 * MiB;
constexpr size_t WS_PART = 1510 * MiB;
constexpr size_t WS_CNT = 39 * MiB;
constexpr size_t WS_END = 1574 * MiB;
static_assert(WS_XB + (size_t)M * D * 2 <= WS_PROJ && WS_PROJ + (size_t)M * NIN * 2 <= WS_MIX && WS_MIX + (size_t)M * D * 2 <= WS_HB && WS_HB + (size_t)M * FF * 2 <= WS_END, "d_ws map");
static_assert(WS_ST1 + (size_t)M * 64 <= WS_ST2 && WS_ST2 + (size_t)M * 64 <= WS_LSE && WS_LSE + (size_t)M * 48 <= WS_XB, "d_ws map 2");

constexpr size_t O_Y = 0;
constexpr size_t O_KVP0 = (size_t)M * D;
constexpr size_t O_KVP1 = O_KVP0 + 8ull * 128 * 512;
constexpr size_t O_KVP2 = O_KVP1 + 8ull * 512 * 512;
constexpr size_t O_CVP = O_KVP2 + 8ull * 2048 * 512;
constexpr size_t O_KVS0 = O_CVP + 8ull * 2 * 256;
constexpr size_t O_KVS1 = O_KVS0 + 128ull * 128 * 512;
constexpr size_t O_KVS2 = O_KVS1 + 128ull * 512 * 512;
constexpr size_t O_CVS = O_KVS2 + 128ull * 2048 * 512;
constexpr size_t O_END = O_CVS + 128ull * 2 * 256;

constexpr int LDS_BYTES = 163840;

__device__ __forceinline__ unsigned f2bf(float f) { unsigned u = __builtin_bit_cast(unsigned, f); return (u + 0x7fffu + ((u >> 16) & 1u)) >> 16; }
__device__ __forceinline__ unsigned pk2(float lo, float hi) { return f2bf(lo) | (f2bf(hi) << 16); }
__device__ __forceinline__ float bflo(unsigned w) { return __builtin_bit_cast(float, w << 16); }
__device__ __forceinline__ float bfhi(unsigned w) { return __builtin_bit_cast(float, w & 0xffff0000u); }
__device__ __forceinline__ float wave_sum(float v) {
#pragma unroll
    for (int o = 1; o < 64; o <<= 1) v += __shfl_xor(v, o);
    return v;
}

__device__ __forceinline__ unsigned att_cvtpk(float lo, float hi) { typedef float f2 __attribute__((ext_vector_type(2))); typedef __bf16 b2 __attribute__((ext_vector_type(2))); f2 v = {lo, hi}; b2 b = __builtin_convertvector(v, b2); return __builtin_bit_cast(unsigned, b); }
__device__ __forceinline__ const float* pick3(int g, const float* a, const float* b, const float* c) { return g == 0 ? a : (g == 1 ? b : c); }
struct Frame {
    LAS unsigned char* lds;
    int tid, lane, wave, vcu, G;
    const float *xp, *xs, *c0, *c1, *c2, *sconv, *g_attn, *w_in, *conv_w, *w_out, *g_mlp, *w_up, *w_down, *g_fin;
    float* out;
    bf16 *Win_t, *Wout_t, *Wup_t, *Wdn_t, *XB, *PROJ, *MIX, *HB, *QKVP;
    float *RSTD0, *ST1, *ST2, *LSE, *PART; unsigned* CNT;
};

__device__ __forceinline__ void p0_transpose_item(const float* W, const float* gk, int K, int N, bf16* WT, LAS float* scr, int item, int lane) {
    const int nblk = N / 32, kb = item / nblk, nb = item % nblk, k0 = 64 * kb, n0 = 32 * nb;
#pragma unroll 8
    for (int i = 0; i < 32; ++i) { const int kk = 2 * i + (lane >> 5); float v = W[(size_t)(k0 + kk) * N + n0 + (lane & 31)]; if (gk) v *= gk[k0 + kk]; scr[kk * 33 + (lane & 31)] = v; }
    asm volatile("s_waitcnt lgkmcnt(0)" ::: "memory");
    const int c = lane & 7;
#pragma unroll
    for (int j = 0; j < 4; ++j) { const int n = (lane >> 3) + 8 * j; const LAS float* s = scr + (8 * c) * 33 + n;
        v4u o; o.x = pk2(s[0 * 33], s[1 * 33]); o.y = pk2(s[2 * 33], s[3 * 33]); o.z = pk2(s[4 * 33], s[5 * 33]); o.w = pk2(s[6 * 33], s[7 * 33]);
        *(v4u*)(WT + (size_t)(n0 + n) * K + k0 + 8 * c) = o; }
    asm volatile("s_waitcnt lgkmcnt(0)" ::: "memory");
}
__device__ __forceinline__ void p0_prologue(Frame& F) {
    if (blockIdx.x == 0) for (int i = F.tid; i < 2048; i += NWAVES * 64) F.CNT[i] = 0u;
    LAS float* scr = (LAS float*)(F.lds + F.wave * 16384);
    const int gw = F.vcu * NWAVES + F.wave, NGW = F.G * NWAVES;
    constexpr int I_IN = (D / 64) * (NIN / 32), I_O = (D / 64) * (D / 32), I_UP = (D / 64) * (FF / 32), I_DN = (FF / 64) * (D / 32);
    constexpr int NITEMS = I_IN + I_O + I_UP + I_DN;
    for (int it = gw; it < NITEMS; it += NGW) {
        int r = it;
        if (r < I_IN) { p0_transpose_item(F.w_in, F.g_attn, D, NIN, F.Win_t, scr, r, F.lane); continue; } r -= I_IN;
        if (r < I_O) { p0_transpose_item(F.w_out, nullptr, D, D, F.Wout_t, scr, r, F.lane); continue; } r -= I_O;
        if (r < I_UP) { p0_transpose_item(F.w_up, F.g_mlp, D, FF, F.Wup_t, scr, r, F.lane); continue; } r -= I_UP;
        p0_transpose_item(F.w_down, nullptr, FF, D, F.Wdn_t, scr, r, F.lane);
    }
    for (int m0 = gw * 4; m0 < M; m0 += NGW * 4) {
        const float* xrow = m0 < MP ? F.xp + (size_t)m0 * D : F.xs + (size_t)(m0 - MP) * D;
        f32x4 v[4][4]; float s[4];
#pragma unroll
        for (int r = 0; r < 4; ++r)
#pragma unroll
            for (int j = 0; j < 4; ++j) v[r][j] = ((const f32x4*)(xrow + (size_t)r * D))[F.lane + 64 * j];
#pragma unroll
        for (int r = 0; r < 4; ++r) { float t = 0.f;
#pragma unroll
            for (int j = 0; j < 4; ++j) t += (v[r][j].x * v[r][j].x + v[r][j].y * v[r][j].y) + (v[r][j].z * v[r][j].z + v[r][j].w * v[r][j].w);
            s[r] = wave_sum(t); }
#pragma unroll
        for (int r = 0; r < 4; ++r) { v2u* o8 = (v2u*)(F.XB + (size_t)(m0 + r) * D) + F.lane;
#pragma unroll
            for (int j = 0; j < 4; ++j) { v2u w; w.x = att_cvtpk(v[r][j].x, v[r][j].y); w.y = att_cvtpk(v[r][j].z, v[r][j].w); o8[64 * j] = w; }
            if (F.lane == 0) F.RSTD0[m0 + r] = __builtin_amdgcn_rsqf(s[r] * (1.0f / D) + EPS); }
    }
}

namespace att {
constexpr int VP = 128;
constexpr int WTILE = 160 * VP;
constexpr float C2 = 0.125f * 1.4426950408889634f;
typedef __amdgpu_buffer_rsrc_t rsrc_t;
__device__ __forceinline__ rsrc_t mk_rsrc(const void* p) { return __builtin_amdgcn_make_buffer_rsrc((void*)p, 0, 0x7fffffff, 0x00020000); }
__device__ __forceinline__ v4u bld16(rsrc_t r, int voff, int soff) { return __builtin_amdgcn_raw_buffer_load_b128(r, voff, soff, 0); }
__device__ __forceinline__ v2u bld8(rsrc_t r, int voff, int soff) { return __builtin_amdgcn_raw_buffer_load_b64(r, voff, soff, 0); }
__device__ __forceinline__ int crow(int r, int hi) { return (r & 3) + 8 * (r >> 2) + 4 * hi; }
__device__ __forceinline__ s16x4 vtr(const LAS unsigned char* p) { return __builtin_bit_cast(s16x4, __builtin_amdgcn_ds_read_tr16_b64_v4i16((LAS s16x4*)p)); }
__device__ __forceinline__ unsigned cvtpk(float lo, float hi) { typedef float f2 __attribute__((ext_vector_type(2))); typedef __bf16 b2 __attribute__((ext_vector_type(2))); f2 v = {lo, hi}; b2 b = __builtin_convertvector(v, b2); return __builtin_bit_cast(unsigned, b); }

__device__ __forceinline__ void prompt_tile(const rsrc_t rp, bf16* __restrict__ mixed, float* __restrict__ lse, LAS unsigned char* wl, int b, int g, int h, int r, int j, int lane) {
    const int a = lane & 31, hi = lane >> 5, s = 2 * g, qs = 32 * j, rowb = b * TP, colq = g * 256 + h * 64, l8 = lane >> 3, c8 = lane & 7;
    const int L = TP >> s, vo = lane * 16;
    const int bq = (((g * 4 + h) * 8 + b) * TP + r * L + qs) * 128, bk = bq + 3 * 4 * 8 * TP * 128 - 128 * 128, bv = bk + 3 * 4 * 8 * TP * 128;
    v4u qraw[4], kraw[20], va[12], vb[8];
#pragma unroll
    for (int i = 0; i < 4; ++i) qraw[i] = bld16(rp, vo, bq + i * 1024);
#pragma unroll
    for (int i = 0; i < 20; ++i) kraw[i] = bld16(rp, vo, bk + i * 1024);
    const int wsw = l8 * VP + ((c8 ^ l8) * 16), rsw = a * VP;
#pragma unroll
    for (int i = 0; i < 4; ++i) *(LAS v4u*)(wl + 8 * i * VP + wsw) = qraw[i];
    bf16x8 qf[4];
#pragma unroll
    for (int d0 = 0; d0 < 4; ++d0) qf[d0] = *(const LAS bf16x8*)(wl + rsw + (((2 * d0 + hi) ^ (a & 7)) * 16));
#pragma unroll
    for (int i = 0; i < 20; ++i) *(LAS v4u*)(wl + 8 * i * VP + wsw) = kraw[i];
    asm volatile("" ::: "memory");
#pragma unroll
    for (int i = 0; i < 12; ++i) va[i] = bld16(rp, vo, bv + i * 1024);
    f32x16 S[5];
#pragma unroll
    for (int kb = 0; kb < 5; ++kb) { f32x16 acc = {};
#pragma unroll
        for (int d0 = 0; d0 < 4; ++d0) { const bf16x8 kf = *(const LAS bf16x8*)(wl + 32 * kb * VP + rsw + (((2 * d0 + hi) ^ (a & 7)) * 16)); acc = __builtin_amdgcn_mfma_f32_32x32x16_bf16(kf, qf[d0], acc, 0, 0, 0); }
        S[kb] = acc; }
    float mr = -INFINITY; float bias[5];
#pragma unroll
    for (int kb = 0; kb < 5; ++kb) { const bool bv = (qs - 128 + 32 * kb) >= 0; bias[kb] = bv ? 0.f : -INFINITY; float bm = -INFINITY;
#pragma unroll
        for (int rr = 0; rr < 16; ++rr) { const int key = crow(rr, hi); float v = S[kb][rr];
            if (kb == 0) { v = key >= a ? v : -INFINITY; S[kb][rr] = v; } if (kb == 4) { v = key <= a ? v : -INFINITY; S[kb][rr] = v; }
            bm = fmaxf(bm, v); }
        mr = bv ? fmaxf(mr, bm) : mr; }
    mr = fmaxf(mr, __shfl_xor(mr, 32));
    const float mxs = mr * C2;
    float l = 0.f; v4u pw[5][2];
#pragma unroll
    for (int kb = 0; kb < 5; ++kb) { const float nb = bias[kb] - mxs; float p[16];
#pragma unroll
        for (int rr = 0; rr < 16; ++rr) { p[rr] = __builtin_amdgcn_exp2f(__builtin_fmaf(S[kb][rr], C2, nb)); l += p[rr]; }
#pragma unroll
        for (int st = 0; st < 2; ++st) { pw[kb][st].x = cvtpk(p[8 * st + 0], p[8 * st + 1]); pw[kb][st].y = cvtpk(p[8 * st + 2], p[8 * st + 3]); pw[kb][st].z = cvtpk(p[8 * st + 4], p[8 * st + 5]); pw[kb][st].w = cvtpk(p[8 * st + 6], p[8 * st + 7]); } }
    l += __shfl_xor(l, 32);
#pragma unroll
    for (int i = 0; i < 8; ++i) vb[i] = bld16(rp, vo, bv + (12 + i) * 1024);
#pragma unroll
    for (int i = 0; i < 12; ++i) *(LAS v4u*)(wl + (8 * i + l8) * VP + c8 * 16) = va[i];
    f32x16 o[2]; o[0] = f32x16{}; o[1] = f32x16{};
    const LAS unsigned char* vbase = wl + (4 * hi + ((lane & 15) >> 2)) * VP + (16 * ((lane >> 4) & 1) + 4 * (lane & 3)) * 2;
#pragma unroll
    for (int kb = 0; kb < 5; ++kb) {
        if (kb == 3) {
#pragma unroll
            for (int i = 0; i < 8; ++i) *(LAS v4u*)(wl + (96 + 8 * i + l8) * VP + c8 * 16) = vb[i]; }
#pragma unroll
        for (int st = 0; st < 2; ++st) {
            const bf16x8 pa = __builtin_bit_cast(bf16x8, pw[kb][st]);
#pragma unroll
            for (int cc = 0; cc < 2; ++cc) {
                const s16x4 lo = vtr(vbase + (32 * kb + 16 * st) * VP + cc * 64), hh = vtr(vbase + (32 * kb + 16 * st + 8) * VP + cc * 64);
                const bf16x8 vf = (bf16x8){lo[0], lo[1], lo[2], lo[3], hh[0], hh[1], hh[2], hh[3]};
                o[cc] = __builtin_amdgcn_mfma_f32_32x32x16_bf16(pa, vf, o[cc], 0, 0, 0);
            }
        }
    }
    const float linv = 1.0f / l;
#pragma unroll
    for (int rr = 0; rr < 16; ++rr) { const int q = crow(rr, hi); const float li = __shfl(linv, q);
        const unsigned w = cvtpk(o[0][rr] * li, o[1][rr] * li); LAS bf16* op = (LAS bf16*)(wl + q * VP) + a; op[0] = (bf16)(w & 0xffffu); op[32] = (bf16)(w >> 16); }
#pragma unroll
    for (int i = 0; i < 4; ++i) { const v4u ov = *(const LAS v4u*)(wl + (8 * i + l8) * VP + c8 * 16);
        *(v4u*)(mixed + (size_t)(rowb + ((qs + 8 * i + l8) << s) + r) * D + colq + c8 * 8) = ov; }
    if (hi == 0) lse[(size_t)(rowb + ((qs + a) << s) + r) * 12 + g * 4 + h] = mxs + __builtin_amdgcn_logf(l);
}

__device__ __forceinline__ f32x4 kv_row(const rsrc_t rc, const rsrc_t rp, bool maybe_new, int W, int b, int idx, int sel, int g, int h, int c) {
    if (maybe_new) { const bool nw = idx >= W; const int idc = nw ? W - 1 : idx;
        const f32x4 cv = __builtin_bit_cast(f32x4, bld16(rc, ((b * W + idc) * 2 + sel) * 1024 + (h * 64 + 4 * c) * 4, 0));
        const v2u pw = bld8(rp, (MP + b * 8 + (nw ? idx - W : 0)) * (NIN * 2) + (768 + sel * 768 + g * 256 + h * 64 + 4 * c) * 2, 0);
        const f32x4 pv = {bflo(pw.x), bfhi(pw.x), bflo(pw.y), bfhi(pw.y)};
        return nw ? pv : cv; }
    return __builtin_bit_cast(f32x4, bld16(rc, ((b * W + idx) * 2 + sel) * 1024 + (h * 64 + 4 * c) * 4, 0));
}
__device__ __forceinline__ void sample_group(Frame& F, const rsrc_t rp, int b, int g, int h, int t, const int lane_in, f32x4& o_out, float& lse_out) {
    int lane = lane_in; asm volatile("" : "+v"(lane));
    const int rg = lane >> 4, c = lane & 15;
    const int W = 128 << (2 * g), sh = 2 * g;
    const rsrc_t rc = mk_rsrc(pick3(g, F.c0, F.c1, F.c2));
    const int qrow = MP + b * 8 + t;
    f32x4 q; { const v2u w = bld8(rp, qrow * (NIN * 2) + (g * 256 + h * 64 + 4 * c) * 2, 0); q = (f32x4){bflo(w.x), bfhi(w.x), bflo(w.y), bfhi(w.y)}; }
    f32x4 kv[33]; float sc[33];
#pragma unroll
    for (int i0 = 0; i0 < 33; i0 += 33) {
        asm volatile("" ::: "memory");
#pragma unroll
        for (int i = i0; i < i0 + 33 && i < 33; ++i) { int j = 4 * i + rg; j = j > 128 ? 128 : j; kv[i] = kv_row(rc, rp, i < 2, W, b, W + t - (j << sh), 0, g, h, c); }
#pragma unroll
        for (int i = i0; i < i0 + 33 && i < 33; ++i) { float p = (kv[i][0] * q[0] + kv[i][1] * q[1]) + (kv[i][2] * q[2] + kv[i][3] * q[3]);
            p += __shfl_xor(p, 1); p += __shfl_xor(p, 2); p += __shfl_xor(p, 4); p += __shfl_xor(p, 8);
            sc[i] = (4 * i + rg) <= 128 ? p * C2 : -INFINITY; } }
    float mx = sc[0];
#pragma unroll
    for (int i = 1; i < 33; ++i) mx = fmaxf(mx, sc[i]);
    mx = fmaxf(mx, __shfl_xor(mx, 16)); mx = fmaxf(mx, __shfl_xor(mx, 32));
    float l = 0.f;
#pragma unroll
    for (int i = 0; i < 33; ++i) { sc[i] = __builtin_amdgcn_exp2f(sc[i] - mx); l += sc[i]; }
    l += __shfl_xor(l, 16); l += __shfl_xor(l, 32);
    f32x4 o = {0.f, 0.f, 0.f, 0.f};
#pragma unroll
    for (int i0 = 0; i0 < 33; i0 += 33) {
        asm volatile("" ::: "memory");
#pragma unroll
        for (int i = i0; i < i0 + 33 && i < 33; ++i) { int j = 4 * i + rg; j = j > 128 ? 128 : j; kv[i] = kv_row(rc, rp, i < 2, W, b, W + t - (j << sh), 1, g, h, c); }
#pragma unroll
        for (int i = i0; i < i0 + 33 && i < 33; ++i) o += kv[i] * sc[i]; }
#pragma unroll
    for (int e = 0; e < 4; ++e) { float v = o[e]; v += __shfl_xor(v, 16); v += __shfl_xor(v, 32); o[e] = v; }
    const float li = 1.0f / l;
    o_out = o * li; lse_out = mx + __builtin_amdgcn_logf(l);
}
__device__ __forceinline__ void sample_task(Frame& F, const rsrc_t rp, LAS unsigned char* wl, int task, const int lane) {
    const int t = task & 7, h = (task >> 3) & 3, b = task >> 5, rg = lane >> 4, c = lane & 15;
#pragma unroll 1
    for (int g = 0; g < 3; ++g) { f32x4 o; float ls; sample_group(F, rp, b, g, h, t, lane, o, ls);
        *(LAS f32x4*)(wl + g * 1024 + lane * 16) = o; *(LAS float*)(wl + 3072 + g * 256 + lane * 4) = ls; }
    f32x4 o0 = *(const LAS f32x4*)(wl + lane * 16), o1 = *(const LAS f32x4*)(wl + 1024 + lane * 16), o2 = *(const LAS f32x4*)(wl + 2048 + lane * 16);
    const float l0 = *(const LAS float*)(wl + 3072 + lane * 4), l1 = *(const LAS float*)(wl + 3072 + 256 + lane * 4), l2 = *(const LAS float*)(wl + 3072 + 512 + lane * 4);
    const float mx = fmaxf(l0, fmaxf(l1, l2)); const float e0 = __builtin_amdgcn_exp2f(l0 - mx), e1 = __builtin_amdgcn_exp2f(l1 - mx), e2 = __builtin_amdgcn_exp2f(l2 - mx);
    const float inv = 1.0f / (e0 + e1 + e2);
    o0 = o0 * (e0 * inv); o1 = o1 * (e1 * inv); o2 = o2 * (e2 * inv);
    if (rg == 0) { bf16* op = F.MIX + (size_t)(MP + b * 8 + t) * D + h * 64 + 4 * c; v2u w;
        w.x = cvtpk(o0[0], o0[1]); w.y = cvtpk(o0[2], o0[3]); *(v2u*)(op) = w;
        w.x = cvtpk(o1[0], o1[1]); w.y = cvtpk(o1[2], o1[3]); *(v2u*)(op + 256) = w;
        w.x = cvtpk(o2[0], o2[1]); w.y = cvtpk(o2[2], o2[3]); *(v2u*)(op + 512) = w; }
}
}

__device__ __forceinline__ void unpack8(const v4u w, float (&f)[8]) { f[0] = bflo(w.x); f[1] = bfhi(w.x); f[2] = bflo(w.y); f[3] = bfhi(w.y); f[4] = bflo(w.z); f[5] = bfhi(w.z); f[6] = bflo(w.w); f[7] = bfhi(w.w); }
__device__ __forceinline__ void conv_u(const bf16* proj, size_t row, int ch, float (&u)[8]) {
    float cf[8], hf[8]; unpack8(*(const v4u*)(proj + row * NIN + 2560 + 8 * ch), cf); unpack8(*(const v4u*)(proj + row * NIN + 2816 + 8 * ch), hf);
#pragma unroll
    for (int e = 0; e < 8; ++e) u[e] = cf[e] * hf[e];
}
__device__ __forceinline__ void ld8f(const float* p, float (&u)[8]) { const f32x4 a = *(const f32x4*)p, b = *(const f32x4*)(p + 4); u[0] = a[0]; u[1] = a[1]; u[2] = a[2]; u[3] = a[3]; u[4] = b[0]; u[5] = b[1]; u[6] = b[2]; u[7] = b[3]; }

__device__ __forceinline__ void p2_mixers(Frame& F, const int mask) {
    int tid_ = F.tid; asm volatile("" : "+v"(tid_));
    const int lane_ = tid_ & 63;
    const int gt = F.vcu * (NWAVES * 64) + tid_, NGT = F.G * NWAVES * 64;
    const int gw = F.vcu * NWAVES + F.wave, NGW = F.G * NWAVES;
    const att::rsrc_t rp = att::mk_rsrc(F.PROJ), rq = att::mk_rsrc(F.QKVP);
    if (mask & 1) { LAS unsigned char* wl = F.lds + F.wave * att::WTILE;
      for (int su_ = F.vcu; su_ < 512 * REP_A; su_ += F.G) { const int su = su_ % 512, b = su >> 6, h = (su >> 4) & 3, rg = su & 15;
#pragma unroll 1
        for (int i = 0; i < 6; ++i) { const int k = F.wave + 8 * i, g = k >> 4, kk = k & 15, tpr = 16 >> (2 * g), r = kk / tpr, j = rg * tpr + kk % tpr;
            att::prompt_tile(rq, F.MIX, F.LSE, wl, b, g, h, r, j, lane_); }
        asm volatile("s_waitcnt vmcnt(0)" ::: "memory"); __syncthreads(); __builtin_amdgcn_fence(__ATOMIC_ACQUIRE, "workgroup");
        const size_t row0 = (size_t)b * TP + rg * 512;
#pragma unroll 1
        for (int i0 = 0; i0 < 8; i0 += 4) { float ls[4][3]; v4u mw[4][3];
#pragma unroll
            for (int k = 0; k < 4; ++k) { const int it = tid_ + 512 * (i0 + k), ch = it & 7; const size_t row = row0 + (it >> 3);
#pragma unroll
                for (int g = 0; g < 3; ++g) { ls[k][g] = F.LSE[row * 12 + 4 * g + h]; mw[k][g] = *(const v4u*)(F.MIX + row * D + g * 256 + h * 64 + 8 * ch); } }
#pragma unroll
            for (int k = 0; k < 4; ++k) { const int it = tid_ + 512 * (i0 + k), ch = it & 7; const size_t row = row0 + (it >> 3);
                const float mx = fmaxf(ls[k][0], fmaxf(ls[k][1], ls[k][2])); const float e0 = __builtin_amdgcn_exp2f(ls[k][0] - mx), e1 = __builtin_amdgcn_exp2f(ls[k][1] - mx), e2 = __builtin_amdgcn_exp2f(ls[k][2] - mx);
                const float inv = 1.0f / (e0 + e1 + e2); const float al[3] = {e0 * inv, e1 * inv, e2 * inv};
#pragma unroll
                for (int g = 0; g < 3; ++g) { float f[8]; unpack8(mw[k][g], f);
                    v4u o; o.x = att::cvtpk(f[0] * al[g], f[1] * al[g]); o.y = att::cvtpk(f[2] * al[g], f[3] * al[g]); o.z = att::cvtpk(f[4] * al[g], f[5] * al[g]); o.w = att::cvtpk(f[6] * al[g], f[7] * al[g]);
                    *(v4u*)(F.MIX + row * D + g * 256 + h * 64 + 8 * ch) = o; } }
        }
      } }
    if (mask & 2) for (int task = gw; task < 128 * 4 * 8 * REP_B; task += NGW) att::sample_task(F, rp, F.lds + F.wave * att::WTILE, task % (128 * 4 * 8), lane_);
    if (mask & 4) for (int it_ = gt; it_ < (M / 4) * 32 * REP_C; it_ += NGT) { const int it = it_ % ((M / 4) * 32);
        const int ch = it & 31, row0 = (it >> 5) * 4; const bool smp = row0 >= MP;
        const int t0 = smp ? ((row0 - MP) & 7) : (row0 & (TP - 1)), b = smp ? ((row0 - MP) >> 3) : (row0 >> 13);
        v4u cw[6], hw[6], bw[4];
#pragma unroll
        for (int k = 0; k < 6; ++k) { const int row = row0 - 2 + k; if (k >= 2 || t0 > 0) { cw[k] = *(const v4u*)(F.PROJ + (size_t)row * NIN + 2560 + 8 * ch); hw[k] = *(const v4u*)(F.PROJ + (size_t)row * NIN + 2816 + 8 * ch); } else { cw[k] = (v4u){0u, 0u, 0u, 0u}; hw[k] = cw[k]; } }
#pragma unroll
        for (int k = 0; k < 4; ++k) bw[k] = *(const v4u*)(F.PROJ + (size_t)(row0 + k) * NIN + 2304 + 8 * ch);
        float w0[8], w1[8], w2[8]; ld8f(F.conv_w + 8 * ch, w0); ld8f(F.conv_w + 256 + 8 * ch, w1); ld8f(F.conv_w + 512 + 8 * ch, w2);
        float u[6][8];
#pragma unroll
        for (int k = 0; k < 6; ++k) { float cf[8], hf[8]; unpack8(cw[k], cf); unpack8(hw[k], hf);
#pragma unroll
            for (int e = 0; e < 8; ++e) u[k][e] = cf[e] * hf[e]; }
        if (smp && t0 == 0) { ld8f(F.sconv + ((size_t)b * 2 + 0) * 256 + 8 * ch, u[0]); ld8f(F.sconv + ((size_t)b * 2 + 1) * 256 + 8 * ch, u[1]); }
#pragma unroll
        for (int k = 0; k < 4; ++k) { float bg[8], y[8]; unpack8(bw[k], bg);
#pragma unroll
            for (int e = 0; e < 8; ++e) y[e] = bg[e] * (w0[e] * u[k][e] + w1[e] * u[k + 1][e] + w2[e] * u[k + 2][e]);
            v4u o; o.x = att::cvtpk(y[0], y[1]); o.y = att::cvtpk(y[2], y[3]); o.z = att::cvtpk(y[4], y[5]); o.w = att::cvtpk(y[6], y[7]);
            *(v4u*)(F.MIX + (size_t)(row0 + k) * D + 768 + 8 * ch) = o; }
    }
    if (mask & 8) for (int g = 0; g < 3; ++g) {
        const int W = 128 << (2 * g); float* dst = F.out + (g == 0 ? O_KVP0 : (g == 1 ? O_KVP1 : O_KVP2));
        { const int NK = 8 * W * 64;
          for (int it0 = gt; it0 < NK; it0 += 4 * NGT) { v4u w[4];
#pragma unroll
            for (int k = 0; k < 4; ++k) { const int it = it0 + k * NGT; if (it < NK) { const int ch = it & 31, sel = (it >> 5) & 1, br = it >> 6, rr = br % W, b = br / W;
                const int t = TP - W + rr, sh = 2 * g, prow = (t & ((1 << sh) - 1)) * (TP >> sh) + (t >> sh);
                w[k] = *(const v4u*)(F.QKVP + ((size_t)(((((1 + sel) * 3 + g) * 4 + (ch >> 3)) * 8 + b) * TP + prow)) * 64 + 8 * (ch & 7)); } }
#pragma unroll
            for (int k = 0; k < 4; ++k) { const int it = it0 + k * NGT; if (it < NK) { float f[8]; unpack8(w[k], f);
                float* o = dst + (size_t)it * 8; *(f32x4*)o = (f32x4){f[0], f[1], f[2], f[3]}; *(f32x4*)(o + 4) = (f32x4){f[4], f[5], f[6], f[7]}; } } } }
        float* dsts = F.out + (g == 0 ? O_KVS0 : (g == 1 ? O_KVS1 : O_KVS2));
        for (int it = gt; it < 128 * 8 * 64; it += NGT) { const int ch = it & 31, sel = (it >> 5) & 1, bt = it >> 6, t = bt & 7, b = bt >> 3;
            float f[8]; unpack8(*(const v4u*)(F.PROJ + ((size_t)MP + b * 8 + t) * NIN + 768 + sel * 768 + g * 256 + 8 * ch), f);
            float* o = dsts + (((size_t)b * W + (W - 8 + t)) * 2 + sel) * 256 + 8 * ch; *(f32x4*)o = (f32x4){f[0], f[1], f[2], f[3]}; *(f32x4*)(o + 4) = (f32x4){f[4], f[5], f[6], f[7]}; }
    }
    for (int it = gt; it < 8 * 2 * 32; it += NGT) { const int ch = it & 31, j = (it >> 5) & 1, b = it >> 6; float u[8]; conv_u(F.PROJ, (size_t)b * TP + TP - 2 + j, ch, u);
        float* o = F.out + O_CVP + (size_t)it * 8; *(f32x4*)o = (f32x4){u[0], u[1], u[2], u[3]}; *(f32x4*)(o + 4) = (f32x4){u[4], u[5], u[6], u[7]}; }
    for (int it = gt; it < 128 * 2 * 32; it += NGT) { const int ch = it & 31, j = (it >> 5) & 1, b = it >> 6; float u[8]; conv_u(F.PROJ, (size_t)MP + b * 8 + 6 + j, ch, u);
        float* o = F.out + O_CVS + (size_t)it * 8; *(f32x4*)o = (f32x4){u[0], u[1], u[2], u[3]}; *(f32x4*)(o + 4) = (f32x4){u[4], u[5], u[6], u[7]}; }
}
__device__ __forceinline__ void p6_final(Frame& F) {
    const int gw = F.vcu * NWAVES + F.wave, NGW = F.G * NWAVES;
    f32x4 gf[4];
#pragma unroll
    for (int j = 0; j < 4; ++j) gf[j] = ((const f32x4*)F.g_fin)[F.lane + 64 * j];
    for (int m0 = gw * 4; m0 < M; m0 += NGW * 4) {
        float sp[4]; f32x4 v[4][4];
#pragma unroll
        for (int r = 0; r < 4; ++r) sp[r] = F.ST2[(size_t)(m0 + r) * 16 + (F.lane & 15)];
#pragma unroll
        for (int r = 0; r < 4; ++r)
#pragma unroll
            for (int j = 0; j < 4; ++j) v[r][j] = ((const f32x4*)(F.out + (size_t)(m0 + r) * D))[F.lane + 64 * j];
#pragma unroll
        for (int r = 0; r < 4; ++r) { float ss = sp[r]; ss += __shfl_xor(ss, 1); ss += __shfl_xor(ss, 2); ss += __shfl_xor(ss, 4); ss += __shfl_xor(ss, 8);
            const float rstd = __builtin_amdgcn_rsqf(ss * (1.0f / D) + EPS);
#pragma unroll
            for (int j = 0; j < 4; ++j) ((f32x4*)(F.out + (size_t)(m0 + r) * D))[F.lane + 64 * j] = v[r][j] * rstd * gf[j]; }
    }
}

struct Args { const float* in[14]; float* out; unsigned char* ws; int ph_lo, ph_hi, probe, pad; };
__global__ void __launch_bounds__(NWAVES * 64, 2) mega_fwd(Args args) {
    extern __shared__ __attribute__((aligned(16))) unsigned char lds[];
    cg::grid_group grid = cg::this_grid();
    Frame F;
    F.lds = (LAS unsigned char*)lds;
    F.tid = threadIdx.x; F.lane = F.tid & 63; F.wave = __builtin_amdgcn_readfirstlane(F.tid >> 6);
    F.G = gridDim.x; { const int bx = blockIdx.x; F.vcu = (F.G % 8 == 0) ? (bx % 8) * (F.G / 8) + bx / 8 : bx; }
    unsigned char* ws = args.ws;
    F.xp = args.in[0]; F.xs = args.in[1]; F.c0 = args.in[2]; F.c1 = args.in[3]; F.c2 = args.in[4]; F.sconv = args.in[5]; F.g_attn = args.in[6]; F.w_in = args.in[7];
    F.conv_w = args.in[8]; F.w_out = args.in[9]; F.g_mlp = args.in[10]; F.w_up = args.in[11]; F.w_down = args.in[12]; F.g_fin = args.in[13]; F.out = args.out;
    F.Win_t = (bf16*)(ws + WS_WIN); F.Wout_t = (bf16*)(ws + WS_WOUT); F.Wup_t = (bf16*)(ws + WS_WUP); F.Wdn_t = (bf16*)(ws + WS_WDN);
    F.XB = (bf16*)(ws + WS_XB); F.PROJ = (bf16*)(ws + WS_PROJ); F.MIX = (bf16*)(ws + WS_MIX); F.HB = (bf16*)(ws + WS_HB); F.QKVP = (bf16*)(ws + WS_QKVP);
    F.RSTD0 = (float*)(ws + WS_RSTD0); F.ST1 = (float*)(ws + WS_ST1); F.ST2 = (float*)(ws + WS_ST2); F.LSE = (float*)(ws + WS_LSE); F.PART = (float*)(ws + WS_PART); F.CNT = (unsigned*)(ws + WS_CNT);
    const int lo = args.ph_lo, hi = args.ph_hi;
#define IN(k) (lo <= (k) && (k) < hi)
#define SEAM(k) do { if (IN(k) && IN((k) + 1)) grid.sync(); } while (0)

    if (IN(0)) { p0_prologue(F); if (PROBE_REP == 0) p0_prologue(F); }
    SEAM(0);
    if (IN(1)) {
        pg8::Gemm g{F.XB, F.Win_t, M, NIN, D, F.PART, F.CNT}; pg8::StaticOrder S; S.init(M, NIN, F.G, (int)blockIdx.x, 1);
        pg8::EpiScaleBf16<0> E{F.PROJ, NIN, F.RSTD0, EPS, pg8::CopyJob{F.c0, F.c1, F.c2, F.out + O_KVS0, F.out + O_KVS1, F.out + O_KVS2, 0}, F.QKVP, MP};
        pg8::gemm_phase<pg8::EpiScaleBf16<0>, pg8::StaticOrder, PG8_ALIGN, PG8_SP2>(F.lds, g, S, E);
    }
    SEAM(1);
    if (IN(2)) p2_mixers(F, 15);
    SEAM(2);
    if (IN(4)) {
        pg8::Gemm g{F.MIX, F.Wout_t, M, D, D, F.PART, F.CNT + 512}; pg8::StaticOrder S; S.init(M, D, F.G, (int)blockIdx.x, 1);
        pg8::EpiRes<true> E{F.xp, F.xs, MP, F.out, F.XB, F.ST1};
        pg8::gemm_phase<pg8::EpiRes<true>, pg8::StaticOrder, PG8_ALIGN, PG8_SP2>(F.lds, g, S, E);
    }
    SEAM(4);
    if (IN(5)) {
        pg8::Gemm g{F.XB, F.Wup_t, M, FF, D, F.PART, F.CNT + 1024}; pg8::StaticOrder S; S.init(M, FF, F.G, (int)blockIdx.x, 1);
        pg8::EpiScaleBf16<1> E{F.HB, FF, F.ST1, EPS, pg8::CopyJob{F.c0, F.c1, F.c2, F.out + O_KVS0, F.out + O_KVS1, F.out + O_KVS2, (M / 256) * (NIN / 256)}, nullptr, 0};
        pg8::gemm_phase<pg8::EpiScaleBf16<1>, pg8::StaticOrder, PG8_ALIGN, PG8_SP2>(F.lds, g, S, E);
    }
    SEAM(5);
    if (IN(6)) {
        pg8::Gemm g{F.HB, F.Wdn_t, M, D, FF, F.PART, F.CNT + 1536}; pg8::StaticOrder S; S.init(M, D, F.G, (int)blockIdx.x, 1);
        pg8::EpiRes<false> E{F.out, F.out, 1 << 30, F.out, nullptr, F.ST2};
        pg8::gemm_phase<pg8::EpiRes<false>, pg8::StaticOrder, PG8_ALIGN, PG8_SP2>(F.lds, g, S, E);
    }
    SEAM(6);
    if (IN(7)) p6_final(F);
#undef IN
#undef SEAM
}

extern "C" void kernel_launch(void* const* d_in, const int* in_sizes, int n_in, void* d_out, int out_size, void* d_ws, size_t ws_size, hipStream_t stream) {
    static int grid = 0;
    if (grid == 0) {
        if (n_in != 14 || in_sizes[0] != MP * D || (size_t)out_size != O_END || ws_size < WS_END) { fprintf(stderr, "kernel_launch: unexpected shapes (n_in %d, in0 %d, out %d, ws %zu); nothing launched\n", n_in, n_in > 0 ? in_sizes[0] : -1, out_size, ws_size); grid = -1; return; }
        int dev = 0, cus = 0, per_cu = 0;
        if (hipGetDevice(&dev) != hipSuccess || hipDeviceGetAttribute(&cus, hipDeviceAttributeMultiprocessorCount, dev) != hipSuccess) { grid = -1; return; }
        if (hipFuncSetAttribute((const void*)mega_fwd, hipFuncAttributeMaxDynamicSharedMemorySize, LDS_BYTES) != hipSuccess) { fprintf(stderr, "kernel_launch: hipFuncSetAttribute failed\n"); grid = -1; return; }
        if (hipOccupancyMaxActiveBlocksPerMultiprocessor(&per_cu, (const void*)mega_fwd, NWAVES * 64, LDS_BYTES) != hipSuccess || per_cu < 1) { fprintf(stderr, "kernel_launch: occupancy query failed (%d)\n", per_cu); (void)hipGetLastError(); grid = -1; return; }
        grid = cus;
    }
    if (grid < 0) return;
    Args a{};
    for (int i = 0; i < 14; ++i) a.in[i] = (const float*)d_in[i];
    a.out = (float*)d_out; a.ws = (unsigned char*)d_ws; a.probe = PROBE_P2MASK;
    if (MK_N_LAUNCHES == 1) {
        a.ph_lo = 0; a.ph_hi = 8;
        void* kargs[] = {&a};
        const hipError_t e = hipLaunchCooperativeKernel((const void*)mega_fwd, dim3(grid), dim3(NWAVES * 64), kargs, LDS_BYTES, stream);
        if (e != hipSuccess) fprintf(stderr, "kernel_launch: cooperative launch failed: %s (grid %d)\n", hipGetErrorString(e), grid);
    } else {
        for (int p = 0; p < 8; ++p) { a.ph_lo = p; a.ph_hi = p + 1; hipLaunchKernelGGL(mega_fwd, dim3(grid), dim3(NWAVES * 64), LDS_BYTES, stream, a); }
    }
}
```

```cpp
#include <hip/hip_runtime.h>
#include <cstdio>
#include <cstdint>
#include <hip/hip_cooperative_groups.h>
namespace cg = cooperative_groups;
namespace pg8 {
#define PG8_LAS __attribute__((address_space(3)))
typedef unsigned short bf16_t;
typedef short bf16x8 __attribute__((ext_vector_type(8)));
typedef float f32x4 __attribute__((ext_vector_type(4)));
typedef unsigned u32x4 __attribute__((ext_vector_type(4)));
constexpr int BM = 256, BK = 64, HALF = 128, HTB = HALF * BK * 2  , STAGE_BYTES = 8 * HTB, NXCD = 8, WGM = 8;

__host__ __device__ __forceinline__ int lds_byte(int r, int c) { const int st = (r >> 4) * 2 + (c >> 5), rr = r & 15, cc = c & 31, ob = rr * 64 + cc * 2; return st * 1024 + (ob ^ (((ob >> 9) & 1) << 5)); }
__host__ __device__ __forceinline__ void stage_rc(int b, int& R, int& C) { const int st = b / 1024, sb = b % 1024, swz = sb ^ (((sb >> 9) & 1) << 5); R = (st >> 1) * 16 + swz / 64; C = (st & 1) * 32 + (swz % 64) / 2; }
__host__ __device__ __forceinline__ int perm32(int rho) { const int n = rho >> 4, i = rho & 15; return 8 * (i >> 2) + 4 * n + (i & 3); }

struct Unit { int pm, pn, lin, ks, ns; };
struct Gemm { const bf16_t* A; const bf16_t* Bt; int M, N, K; };

struct StaticOrder {
    int nM, nN, nwg, G, c, rep, lim;
    __host__ __device__ void init(int M, int N, int G_, int c_, int rep_ = 1, int lim_ = 0) { nM = M / BM; nN = N / BM; nwg = nM * nN; G = G_; c = c_; rep = rep_; lim = lim_ > 0 ? lim_ : nwg; }
    __host__ __device__ void tile(int wgid, Unit& u) const {
        { const int q = nwg / NXCD, r = nwg % NXCD, xcd = wgid % NXCD, off = wgid / NXCD; wgid = (xcd < r ? xcd * (q + 1) : r * (q + 1) + (xcd - r) * q) + off; }
        const int nig = WGM * nN, gid = wgid / nig, fm = gid * WGM, gsz = (nM - fm) < WGM ? (nM - fm) : WGM;
        u.pm = fm + ((wgid % nig) % gsz); u.pn = (wgid % nig) / gsz;
    }
    __host__ __device__ bool next(int i, Unit& u) const {
        long L = (long)i * G + c; if (L >= (long)lim * rep) return false; L %= lim;
        u.lin = (int)L; u.ks = 0; u.ns = 1; tile((int)L, u); return true;
    }
    __device__ __forceinline__ void a_ready(const Unit&) const {}
    __device__ __forceinline__ void done(const Unit&) const {}
};
struct TailOrder {
    StaticOrder so; int first, S;
    __device__ bool next(int i, Unit& u) const {
        if (i > 0) return false; const int item = so.c; if (item >= (so.nwg - first) * S) return false;
        u.lin = first + item / S; u.ks = item % S; u.ns = S; so.tile(u.lin, u); return true;
    }
    __device__ __forceinline__ void a_ready(const Unit&) const {}
    __device__ __forceinline__ void done(const Unit&) const {}
};

__device__ __forceinline__ unsigned cvt_pk_bf16(float lo, float hi) { unsigned r; asm volatile("v_cvt_pk_bf16_f32 %0, %1, %2" : "=v"(r) : "v"(lo), "v"(hi)); return r; }
typedef float f32x2 __attribute__((ext_vector_type(2)));
constexpr int CP_NBLK = 128 * 128;
struct CopyJob { const float* s2; float* d2; int on; };
template <int MODE> struct EpiScaleBf16 {
    static constexpr bool PERM = true, AFTER_DRAIN = false;
    bf16_t* O; int ldc; const float* rs; float eps; CopyJob cj; bf16_t* QKVP; int perm_rows;
    __device__ __forceinline__ void operator()(const f32x4 (&acc)[2][2][4][2], const Unit& u, int wr, int wc, int fr, int fq) const {
        const int row0 = u.pm * BM + wr * 64 + fr; const int col0 = u.pn * BM + wc * 32 + 8 * fq;
        float sc[8];
        if (MODE == 0) {
#pragma unroll
            for (int i = 0; i < 8; ++i) sc[i] = rs[row0 + (i >> 2) * HALF + (i & 3) * 16];
        } else {
            f32x4 pv[8];
#pragma unroll
            for (int i = 0; i < 8; ++i) pv[i] = *(const f32x4*)(rs + (size_t)(row0 + (i >> 2) * HALF + (i & 3) * 16) * 16 + 4 * fq);
#pragma unroll
            for (int i = 0; i < 8; ++i) { float ss = (pv[i][0] + pv[i][1]) + (pv[i][2] + pv[i][3]); ss += __shfl_xor(ss, 16); ss += __shfl_xor(ss, 32);
                sc[i] = __builtin_amdgcn_rsqf(ss * (1.0f / 1024.0f) + eps); }
        }
        u32x4 cp[8]; int so[4], dof[4]; const int toff = threadIdx.x * 16;
        if (MODE == 1 && cj.on) {
#pragma unroll
            for (int k = 0; k < 4; ++k) { int blk = __builtin_amdgcn_readfirstlane(4 * u.lin + k); blk = blk >= CP_NBLK ? CP_NBLK - 1 : blk;
                const int b = blk >> 7, q = blk & 127; dof[k] = ((b * 2048 + 16 * q) * 512) * 4; so[k] = dof[k] + 8 * 512 * 4; }
            const __amdgpu_buffer_rsrc_t rs_ = __builtin_amdgcn_make_buffer_rsrc((void*)cj.s2, 0, 0x7fffffff, 0x00020000);
#pragma unroll
            for (int k = 0; k < 4; ++k) { cp[2 * k] = __builtin_amdgcn_raw_buffer_load_b128(rs_, toff, so[k], 2); cp[2 * k + 1] = __builtin_amdgcn_raw_buffer_load_b128(rs_, toff, so[k] + 8192, 2); }
            asm volatile("" ::: "memory");
        }
#pragma unroll
        for (int ai = 0; ai < 2; ++ai)
#pragma unroll
            for (int m = 0; m < 4; ++m) { const int row = row0 + ai * HALF + m * 16; const float s1 = sc[ai * 4 + m];
                bf16_t* rowp = O + (size_t)row * ldc + col0; int bjs = HALF;
                if (MODE == 0 && QKVP != nullptr && u.pn < 9 && u.pm * BM < perm_rows) {
                    const int sel = u.pn / 3, g = u.pn - 3 * sel, sh = 2 * g, b = row >> 13, t = row & 8191, prow = (t & ((1 << sh) - 1)) * (8192 >> sh) + (t >> sh);
                    rowp = QKVP + ((size_t)((((sel * 3 + g) * 4 + (wc >> 1)) * 8 + b) * 8192 + prow)) * 64 + (wc & 1) * 32 + 8 * fq; bjs = 2 * 8 * 8192 * 64; }
#pragma unroll
                for (int bj = 0; bj < 2; ++bj) { f32x4 v0 = acc[ai][bj][m][0] * s1, v1 = acc[ai][bj][m][1] * s1;
                    if (MODE == 1) {
#pragma unroll
                        for (int e = 0; e < 4; ++e) { const float x0 = fmaxf(v0[e], 0.f), x1 = fmaxf(v1[e], 0.f); v0[e] = x0 * x0; v1[e] = x1 * x1; } }
                    u32x4 w; w.x = cvt_pk_bf16(v0[0], v0[1]); w.y = cvt_pk_bf16(v0[2], v0[3]); w.z = cvt_pk_bf16(v1[0], v1[1]); w.w = cvt_pk_bf16(v1[2], v1[3]);
                    *(u32x4*)(rowp + (size_t)bj * bjs) = w; } }
        if (MODE == 1 && cj.on) {
            asm volatile("" ::: "memory");
            const __amdgpu_buffer_rsrc_t rd_ = __builtin_amdgcn_make_buffer_rsrc((void*)cj.d2, 0, 0x7fffffff, 0x00020000);
#pragma unroll
            for (int k = 0; k < 4; ++k) { __builtin_amdgcn_raw_buffer_store_b128(cp[2 * k], rd_, toff, dof[k], 2); __builtin_amdgcn_raw_buffer_store_b128(cp[2 * k + 1], rd_, toff, dof[k] + 8192, 2); }
        }
    }
};
struct EpiResBf16 {
    static constexpr bool PERM = true, AFTER_DRAIN = false;
    const bf16_t* xin; bf16_t* xio; float* stats;
    __device__ __forceinline__ void operator()(const f32x4 (&acc)[2][2][4][2], const Unit& u, int wr, int wc, int fr, int fq) const {
        const int row0 = u.pm * BM + wr * 64 + fr; const int col0 = u.pn * BM + wc * 32 + 8 * fq;
#pragma unroll
        for (int ai = 0; ai < 2; ++ai) { u32x4 rw[4][2];
#pragma unroll
            for (int m = 0; m < 4; ++m)
#pragma unroll
                for (int bj = 0; bj < 2; ++bj) rw[m][bj] = *(const u32x4*)(xin + (size_t)(row0 + ai * HALF + m * 16) * 1024 + col0 + bj * HALF);
#pragma unroll
            for (int m = 0; m < 4; ++m) { const int row = row0 + ai * HALF + m * 16; float ss = 0.f;
#pragma unroll
                for (int bj = 0; bj < 2; ++bj) { const u32x4 r = rw[m][bj];
                    f32x4 o0 = acc[ai][bj][m][0], o1 = acc[ai][bj][m][1];
                    o0[0] += __builtin_bit_cast(float, r.x << 16); o0[1] += __builtin_bit_cast(float, r.x & 0xffff0000u); o0[2] += __builtin_bit_cast(float, r.y << 16); o0[3] += __builtin_bit_cast(float, r.y & 0xffff0000u);
                    o1[0] += __builtin_bit_cast(float, r.z << 16); o1[1] += __builtin_bit_cast(float, r.z & 0xffff0000u); o1[2] += __builtin_bit_cast(float, r.w << 16); o1[3] += __builtin_bit_cast(float, r.w & 0xffff0000u);
                    u32x4 w; w.x = cvt_pk_bf16(o0[0], o0[1]); w.y = cvt_pk_bf16(o0[2], o0[3]); w.z = cvt_pk_bf16(o1[0], o1[1]); w.w = cvt_pk_bf16(o1[2], o1[3]);
                    *(u32x4*)(xio + (size_t)row * 1024 + col0 + bj * HALF) = w;
                    ss += ((o0[0] * o0[0] + o0[1] * o0[1]) + (o0[2] * o0[2] + o0[3] * o0[3])) + ((o1[0] * o1[0] + o1[1] * o1[1]) + (o1[2] * o1[2] + o1[3] * o1[3])); }
                ss += __shfl_xor(ss, 16); ss += __shfl_xor(ss, 32);
                if (fq == 0) stats[(size_t)row * 16 + u.pn * 4 + wc] = ss; }
            asm volatile("" ::: "memory"); }
    }
};
struct EpiPartial {
    static constexpr bool PERM = true, AFTER_DRAIN = false;
    float* part; int first;
    __device__ __forceinline__ void operator()(const f32x4 (&acc)[2][2][4][2], const Unit& u, int wr, int wc, int fr, int fq) const {
        float* base = part + (size_t)((u.lin - first) * u.ns + u.ks) * 65536 + (wr * 64 + fr) * 256 + wc * 32 + 8 * fq;
#pragma unroll
        for (int ai = 0; ai < 2; ++ai)
#pragma unroll
            for (int m = 0; m < 4; ++m)
#pragma unroll
                for (int bj = 0; bj < 2; ++bj) { float* p = base + (ai * HALF + m * 16) * 256 + bj * HALF; *(f32x4*)p = acc[ai][bj][m][0]; *(f32x4*)(p + 4) = acc[ai][bj][m][1]; }
    }
};
template <class Epi, class Sched, bool ALIGN_EPI = false, bool SP2 = false>
__device__ __forceinline__ void gemm_phase(PG8_LAS unsigned char* lds, const Gemm g, const Sched& S, const Epi& E) {
    const int tid = threadIdx.x, wid = __builtin_amdgcn_readfirstlane(tid >> 6), lane = tid & 63, wr = wid >> 2, wc = wid & 3, fr = lane & 15, fq = lane >> 4;
    const int K = g.K;
    unsigned voffA[2], voffB[2];
#pragma unroll
    for (int i = 0; i < 2; ++i) { int R, C; stage_rc(tid * 16 + i * 8192, R, C); const int Rb = Epi::PERM ? ((R & ~31) + perm32(R & 31)) : R;
        voffA[i] = (unsigned)(R * K + C) * 2u; voffB[i] = (unsigned)(Rb * K + C) * 2u; }
    const size_t kstep = (size_t)(BK * 2);
    const size_t hstep = (size_t)HALF * K * 2;
    const size_t tstep = 2 * hstep;
    const unsigned ldsw = (unsigned)wid * 1024u;
    const int aoff = lds_byte(wr * 64 + fr, fq * 8), boff = lds_byte(wc * 32 + fr, fq * 8);
#define PG8_SA(b, h) (((b) * 2 + (h)) * HTB)
#define PG8_SB(b, h) ((4 + (b) * 2 + (h)) * HTB)
#define PG8_STAGE(bufoff, gbase, voff) do { _Pragma("unroll") for (int _i = 0; _i < 2; ++_i) \
        __builtin_amdgcn_global_load_lds((const unsigned*)((const char*)(gbase) + (voff)[_i]), (PG8_LAS unsigned*)(lds + (bufoff) + ldsw + _i * 8192), 16, 0, 0); } while (0)
#define PG8_LDA(dst, b, h) do { _Pragma("unroll") for (int m = 0; m < 4; ++m) _Pragma("unroll") for (int k = 0; k < 2; ++k) dst[m][k] = *(const PG8_LAS bf16x8*)(lds + PG8_SA(b, h) + aoff + m * 2048 + k * 1024); } while (0)
#define PG8_LDB(dst, b, h) do { _Pragma("unroll") for (int n = 0; n < 2; ++n) _Pragma("unroll") for (int k = 0; k < 2; ++k) dst[n][k] = *(const PG8_LAS bf16x8*)(lds + PG8_SB(b, h) + boff + n * 2048 + k * 1024); } while (0)
#define PG8_MMA(ai, bj, At, Bt) do { __builtin_amdgcn_s_setprio(1); _Pragma("unroll") for (int m = 0; m < 4; ++m) _Pragma("unroll") for (int n = 0; n < 2; ++n) _Pragma("unroll") for (int k = 0; k < 2; ++k) \
        acc[ai][bj][m][n] = __builtin_amdgcn_mfma_f32_16x16x32_bf16(Bt[n][k], At[m][k], acc[ai][bj][m][n], 0, 0, 0); __builtin_amdgcn_s_setprio(0); } while (0)
#define PG8_WAIT_V(n) asm volatile("s_waitcnt vmcnt(" #n ")" ::: "memory")
#define PG8_WAIT_L(n) asm volatile("s_waitcnt lgkmcnt(" #n ")" ::: "memory")
#define PG8_BAR __builtin_amdgcn_s_barrier()
#define PG8_SCHED __builtin_amdgcn_sched_barrier(0)
    Unit cur, nxt; int ui = 0;
    if (!S.next(0, cur)) return;
    f32x4 acc[2][2][4][2];
#pragma unroll
    for (int a = 0; a < 2; ++a)
#pragma unroll
        for (int b = 0; b < 2; ++b)
#pragma unroll
            for (int m = 0; m < 4; ++m)
#pragma unroll
                for (int n = 0; n < 2; ++n) acc[a][b][m][n] = (f32x4){0.f, 0.f, 0.f, 0.f};
    bf16x8 At[4][2], B0[2][2], B1[2][2];
    int nt = K / BK / cur.ns; const size_t koff = (size_t)cur.ks * nt * kstep;
    const char* cA = (const char*)g.A + (size_t)cur.pm * tstep + koff; const char* cB = (const char*)g.Bt + (size_t)cur.pn * tstep + koff;
    S.a_ready(cur);
    if constexpr (SP2) {
        PG8_STAGE(PG8_SB(0, 0), cB, voffB); PG8_STAGE(PG8_SB(0, 1), cB + hstep, voffB); PG8_STAGE(PG8_SA(0, 0), cA, voffA); PG8_STAGE(PG8_SA(0, 1), cA + hstep, voffA);
        if (wr == 1) PG8_BAR;
        PG8_WAIT_V(2); PG8_BAR;
        PG8_STAGE(PG8_SB(1, 0), cB + kstep, voffB); PG8_STAGE(PG8_SA(1, 0), cA + kstep, voffA); PG8_STAGE(PG8_SB(1, 1), cB + hstep + kstep, voffB);
        PG8_WAIT_V(6); PG8_BAR;
    } else {
        PG8_STAGE(PG8_SB(0, 0), cB, voffB); PG8_STAGE(PG8_SA(0, 0), cA, voffA); PG8_STAGE(PG8_SB(0, 1), cB + hstep, voffB); PG8_STAGE(PG8_SA(0, 1), cA + hstep, voffA);
        if (wr == 1) PG8_BAR;
        PG8_WAIT_V(4); PG8_BAR;
        PG8_STAGE(PG8_SB(1, 0), cB + kstep, voffB); PG8_STAGE(PG8_SA(1, 0), cA + kstep, voffA); PG8_STAGE(PG8_SB(1, 1), cB + hstep + kstep, voffB);
        PG8_WAIT_V(6); PG8_BAR;
    }
    for (;;) {
        const bool has_next = S.next(ui + 1, nxt);
        const int nnt = has_next ? K / BK / nxt.ns : nt; const size_t nkoff = has_next ? (size_t)nxt.ks * nnt * kstep : 0;
        const char* nA = has_next ? (const char*)g.A + (size_t)nxt.pm * tstep + nkoff : cA; const char* nB = has_next ? (const char*)g.Bt + (size_t)nxt.pn * tstep + nkoff : cB;
        for (int t = 0; t < nt; t += 2) {
            const bool last = (t == nt - 2);
            const char* a1 = cA + (size_t)(t + 1) * kstep;
            const char* a2 = last ? nA : cA + (size_t)(t + 2) * kstep; const char* b2 = last ? nB : cB + (size_t)(t + 2) * kstep;
            const char* a3 = a2 + kstep; const char* b3 = b2 + kstep;
            if (last && has_next) S.a_ready(nxt);
            if constexpr (SP2) {
            PG8_LDB(B0, 0, 0); PG8_LDB(B1, 0, 1); PG8_SCHED; PG8_LDA(At, 0, 0); PG8_STAGE(PG8_SA(1, 1), a1 + hstep, voffA);
            PG8_WAIT_V(8); PG8_WAIT_L(0); PG8_BAR; PG8_MMA(0, 0, At, B0); PG8_MMA(0, 1, At, B1); PG8_BAR; PG8_SCHED;
            PG8_LDA(At, 0, 1); PG8_STAGE(PG8_SB(0, 0), b2, voffB); PG8_STAGE(PG8_SB(0, 1), b2 + hstep, voffB); PG8_STAGE(PG8_SA(0, 0), a2, voffA);
            PG8_WAIT_V(8); PG8_WAIT_L(0); PG8_BAR; PG8_MMA(1, 0, At, B0); PG8_MMA(1, 1, At, B1); PG8_BAR; PG8_SCHED;
            PG8_LDB(B0, 1, 0); PG8_LDB(B1, 1, 1); PG8_SCHED; PG8_LDA(At, 1, 0); PG8_STAGE(PG8_SA(0, 1), a2 + hstep, voffA);
            PG8_WAIT_V(8); PG8_WAIT_L(0); PG8_BAR; PG8_MMA(0, 0, At, B0); PG8_MMA(0, 1, At, B1); PG8_BAR; PG8_SCHED;
            PG8_LDA(At, 1, 1); PG8_STAGE(PG8_SB(1, 0), b3, voffB); PG8_STAGE(PG8_SB(1, 1), b3 + hstep, voffB); PG8_STAGE(PG8_SA(1, 0), a3, voffA);
            PG8_WAIT_V(8); PG8_WAIT_L(0); PG8_BAR; PG8_MMA(1, 0, At, B0); PG8_MMA(1, 1, At, B1); PG8_BAR; PG8_SCHED;
            } else {
            PG8_LDB(B0, 0, 0); PG8_SCHED; PG8_LDA(At, 0, 0); PG8_STAGE(PG8_SA(1, 1), a1 + hstep, voffA);
            PG8_WAIT_L(8); PG8_BAR; PG8_WAIT_L(0); PG8_MMA(0, 0, At, B0); PG8_BAR; PG8_SCHED;
            PG8_LDB(B1, 0, 1); PG8_STAGE(PG8_SB(0, 0), b2, voffB);
            PG8_BAR; PG8_WAIT_L(0); PG8_MMA(0, 1, At, B1); PG8_BAR;
            PG8_LDA(At, 0, 1); PG8_STAGE(PG8_SA(0, 0), a2, voffA);
            PG8_BAR; PG8_WAIT_L(0); PG8_MMA(1, 0, At, B0); PG8_BAR; PG8_SCHED;
            PG8_STAGE(PG8_SB(0, 1), b2 + hstep, voffB);
            PG8_WAIT_V(6); PG8_BAR; PG8_MMA(1, 1, At, B1); PG8_BAR;
            PG8_LDB(B0, 1, 0); PG8_SCHED; PG8_LDA(At, 1, 0); PG8_STAGE(PG8_SA(0, 1), a2 + hstep, voffA);
            PG8_WAIT_L(8); PG8_BAR; PG8_WAIT_L(0); PG8_MMA(0, 0, At, B0); PG8_BAR; PG8_SCHED;
            PG8_LDB(B1, 1, 1); PG8_STAGE(PG8_SB(1, 0), b3, voffB);
            PG8_BAR; PG8_WAIT_L(0); PG8_MMA(0, 1, At, B1); PG8_BAR;
            PG8_LDA(At, 1, 1); PG8_STAGE(PG8_SA(1, 0), a3, voffA);
            PG8_BAR; PG8_WAIT_L(0); PG8_MMA(1, 0, At, B0); PG8_BAR; PG8_SCHED;
            PG8_STAGE(PG8_SB(1, 1), b3 + hstep, voffB);
            PG8_WAIT_V(6); PG8_BAR; PG8_MMA(1, 1, At, B1); PG8_BAR;
            }
        }
        if constexpr (ALIGN_EPI) { if (wr == 0) PG8_BAR; }
        if constexpr (!Epi::AFTER_DRAIN) { E(acc, cur, wr, wc, fr, fq); S.done(cur); }
        if (!has_next) break;
#pragma unroll
        for (int a = 0; a < 2; ++a)
#pragma unroll
            for (int b = 0; b < 2; ++b)
#pragma unroll
                for (int m = 0; m < 4; ++m)
#pragma unroll
                    for (int n = 0; n < 2; ++n) acc[a][b][m][n] = (f32x4){0.f, 0.f, 0.f, 0.f};
        cur = nxt; cA = nA; cB = nB; nt = nnt; ++ui;
        if constexpr (ALIGN_EPI) { if (wr == 1) PG8_BAR; }
    }
    PG8_WAIT_V(0);
    if constexpr (!ALIGN_EPI) { if (wr == 0) PG8_BAR; }
    PG8_BAR;
    if constexpr (Epi::AFTER_DRAIN) { E.fused(acc, cur, wr, wc, fr, fq, lds, wid, lane); S.done(cur); }
#undef PG8_SA
#undef PG8_SB
#undef PG8_STAGE
#undef PG8_LDA
#undef PG8_LDB
#undef PG8_MMA
#undef PG8_WAIT_V
#undef PG8_WAIT_L
#undef PG8_BAR
#undef PG8_SCHED
}
}
#ifndef PG8_SP2
#define PG8_SP2 true
#endif
#ifndef PG8_ALIGN
#define PG8_ALIGN true
#endif
#ifndef PROBE_REP
#define PROBE_REP -1
#endif
#ifndef REP_A
#define REP_A 1
#endif
#ifndef STAGGER_US1
#define STAGGER_US1 7
#define STAGGER_US5 9
#endif
#ifndef REP_G1
#define REP_G1 1
#endif
#ifndef REP_G4
#define REP_G4 1
#endif
#ifndef REP_G5
#define REP_G5 1
#endif
#ifndef REP_P0
#define REP_P0 1
#endif
#ifndef REP_B
#define REP_B 1
#endif
#ifndef REP_C
#define REP_C 1
#endif
#ifndef PROBE_P2MASK
#define PROBE_P2MASK 0
#endif
#ifndef MK_N_LAUNCHES
#define MK_N_LAUNCHES 1
#endif

constexpr int D = 1024, FF = 4096, NIN = 3072;
constexpr int MP = 8 * 8192, MS = 128 * 8, M = MP + MS;
constexpr int TP = 8192;
constexpr float EPS = 1e-6f;
constexpr int NWAVES = 8;
#define GAS __attribute__((address_space(1)))
#define LAS __attribute__((address_space(3)))
typedef unsigned short bf16;
typedef unsigned v4u __attribute__((ext_vector_type(4)));
typedef unsigned v2u __attribute__((ext_vector_type(2)));
typedef float f32x4 __attribute__((ext_vector_type(4)));
typedef short bf16x8 __attribute__((ext_vector_type(8)));
typedef short s16x4 __attribute__((ext_vector_type(4)));
typedef float f32x16 __attribute__((ext_vector_type(16)));

constexpr size_t MiB = 1u << 20;
constexpr size_t WS_WIN = 0, WS_WOUT = 6 * MiB, WS_WUP = 8 * MiB, WS_WDN = 16 * MiB;
constexpr size_t WS_RSTD0 = 24 * MiB;
constexpr size_t WS_ST1 = 25 * MiB, WS_ST2 = 30 * MiB;
constexpr size_t WS_LSE = 35 * MiB;
constexpr size_t WS_XB = 40 * MiB;
constexpr size_t WS_PROJ = 172 * MiB;
constexpr size_t WS_MIX = 564 * MiB;
constexpr size_t WS_HB = 696 * MiB;
constexpr size_t WS_QKVP = 1220 * MiB;
constexpr size_t WS_PART = 1510 * MiB;
constexpr size_t WS_BAR = 38 * MiB + 512 * 1024, WS_BAR_BYTES = 16384;
constexpr size_t WS_CNT = 39 * MiB;
constexpr size_t WS_END = 1592 * MiB;
static_assert(WS_XB + (size_t)M * D * 2 <= WS_PROJ && WS_PROJ + (size_t)M * NIN * 2 <= WS_MIX && WS_MIX + (size_t)M * D * 2 <= WS_HB && WS_HB + (size_t)M * FF * 2 <= WS_END, "d_ws map");
static_assert(WS_ST1 + (size_t)M * 64 <= WS_ST2 && WS_ST2 + (size_t)M * 64 <= WS_LSE && WS_LSE + (size_t)M * 48 <= WS_XB, "d_ws map 2");

constexpr size_t O_Y = 0;
constexpr size_t O_KVP0 = (size_t)M * D;
constexpr size_t O_KVP1 = O_KVP0 + 8ull * 128 * 512;
constexpr size_t O_KVP2 = O_KVP1 + 8ull * 512 * 512;
constexpr size_t O_CVP = O_KVP2 + 8ull * 2048 * 512;
constexpr size_t O_KVS0 = O_CVP + 8ull * 2 * 256;
constexpr size_t O_KVS1 = O_KVS0 + 128ull * 128 * 512;
constexpr size_t O_KVS2 = O_KVS1 + 128ull * 512 * 512;
constexpr size_t O_CVS = O_KVS2 + 128ull * 2048 * 512;
constexpr size_t O_END = O_CVS + 128ull * 2 * 256;

constexpr int P6_SPLIT = 16;
constexpr int LDS_BYTES = 163840;

__device__ __forceinline__ unsigned f2bf(float f) { unsigned u = __builtin_bit_cast(unsigned, f); return (u + 0x7fffu + ((u >> 16) & 1u)) >> 16; }
__device__ __forceinline__ unsigned pk2(float lo, float hi) { return f2bf(lo) | (f2bf(hi) << 16); }
__device__ __forceinline__ float bflo(unsigned w) { return __builtin_bit_cast(float, w << 16); }
__device__ __forceinline__ float bfhi(unsigned w) { return __builtin_bit_cast(float, w & 0xffff0000u); }
__device__ __forceinline__ float wave_sum(float v) {
#pragma unroll
    for (int o = 1; o < 64; o <<= 1) v += __shfl_xor(v, o);
    return v;
}

__device__ __forceinline__ unsigned att_cvtpk(float lo, float hi) { typedef float f2 __attribute__((ext_vector_type(2))); typedef __bf16 b2 __attribute__((ext_vector_type(2))); f2 v = {lo, hi}; b2 b = __builtin_convertvector(v, b2); return __builtin_bit_cast(unsigned, b); }
__device__ __forceinline__ const float* pick3(int g, const float* a, const float* b, const float* c) { return g == 0 ? a : (g == 1 ? b : c); }
struct Frame {
    LAS unsigned char* lds;
    int tid, lane, wave, vcu, G;
    const float *xp, *xs, *c0, *c1, *c2, *sconv, *g_attn, *w_in, *conv_w, *w_out, *g_mlp, *w_up, *w_down, *g_fin;
    float* out;
    bf16 *Win_t, *Wout_t, *Wup_t, *Wdn_t, *XB, *PROJ, *MIX, *HB, *QKVP;
    float *RSTD0, *ST1, *ST2, *LSE, *PART; unsigned* CNT;
};

__device__ __forceinline__ void p0_transpose_item(const float* W, const float* gk, int K, int N, bf16* WT, LAS float* scr, int item, int lane) {
    const int nblk = N / 32, kb = item / nblk, nb = item % nblk, k0 = 64 * kb, n0 = 32 * nb;
#pragma unroll 8
    for (int i = 0; i < 32; ++i) { const int kk = 2 * i + (lane >> 5); float v = W[(size_t)(k0 + kk) * N + n0 + (lane & 31)]; if (gk) v *= gk[k0 + kk]; scr[kk * 33 + (lane & 31)] = v; }
    asm volatile("s_waitcnt lgkmcnt(0)" ::: "memory");
    const int c = lane & 7;
#pragma unroll
    for (int j = 0; j < 4; ++j) { const int n = (lane >> 3) + 8 * j; const LAS float* s = scr + (8 * c) * 33 + n;
        v4u o; o.x = pk2(s[0 * 33], s[1 * 33]); o.y = pk2(s[2 * 33], s[3 * 33]); o.z = pk2(s[4 * 33], s[5 * 33]); o.w = pk2(s[6 * 33], s[7 * 33]);
        *(v4u*)(WT + (size_t)(n0 + n) * K + k0 + 8 * c) = o; }
    asm volatile("s_waitcnt lgkmcnt(0)" ::: "memory");
}
__device__ __forceinline__ void p0_prologue(Frame& F) {
    LAS float* scr = (LAS float*)(F.lds + F.wave * 16384);
    const int gw = F.vcu * NWAVES + F.wave, NGW = F.G * NWAVES;
    constexpr int I_IN = (D / 64) * (NIN / 32), I_O = (D / 64) * (D / 32), I_UP = (D / 64) * (FF / 32), I_DN = (FF / 64) * (D / 32);
    constexpr int NITEMS = I_IN + I_O + I_UP + I_DN;
    for (int it = gw; it < NITEMS; it += NGW) {
        int r = it;
        if (r < I_IN) { p0_transpose_item(F.w_in, F.g_attn, D, NIN, F.Win_t, scr, r, F.lane); continue; } r -= I_IN;
        if (r < I_O) { p0_transpose_item(F.w_out, nullptr, D, D, F.Wout_t, scr, r, F.lane); continue; } r -= I_O;
        if (r < I_UP) { p0_transpose_item(F.w_up, F.g_mlp, D, FF, F.Wup_t, scr, r, F.lane); continue; } r -= I_UP;
        p0_transpose_item(F.w_down, nullptr, FF, D, F.Wdn_t, scr, r, F.lane);
    }
    for (int m0_ = gw * 4; m0_ < M * REP_P0; m0_ += NGW * 4) { const int m0 = m0_ % M;
        const float* xrow = m0 < MP ? F.xp + (size_t)m0 * D : F.xs + (size_t)(m0 - MP) * D;
        f32x4 v[4][4]; float s[4];
#pragma unroll
        for (int r = 0; r < 4; ++r)
#pragma unroll
            for (int j = 0; j < 4; ++j) v[r][j] = ((const f32x4*)(xrow + (size_t)r * D))[F.lane + 64 * j];
#pragma unroll
        for (int r = 0; r < 4; ++r) { float t = 0.f;
#pragma unroll
            for (int j = 0; j < 4; ++j) t += (v[r][j].x * v[r][j].x + v[r][j].y * v[r][j].y) + (v[r][j].z * v[r][j].z + v[r][j].w * v[r][j].w);
            s[r] = wave_sum(t); }
#pragma unroll
        for (int r = 0; r < 4; ++r) { v2u* o8 = (v2u*)(F.XB + (size_t)(m0 + r) * D) + F.lane;
#pragma unroll
            for (int j = 0; j < 4; ++j) { v2u w; w.x = att_cvtpk(v[r][j].x, v[r][j].y); w.y = att_cvtpk(v[r][j].z, v[r][j].w); o8[64 * j] = w; }
            if (F.lane == 0) F.RSTD0[m0 + r] = __builtin_amdgcn_rsqf(s[r] * (1.0f / D) + EPS); }
    }
}

namespace att {
constexpr int VP = 128;
constexpr int WTILE = 160 * VP;
constexpr float C2 = 0.125f * 1.4426950408889634f;
typedef __amdgpu_buffer_rsrc_t rsrc_t;
__device__ __forceinline__ rsrc_t mk_rsrc(const void* p) { return __builtin_amdgcn_make_buffer_rsrc((void*)p, 0, 0x7fffffff, 0x00020000); }
__device__ __forceinline__ v4u bld16(rsrc_t r, int voff, int soff) { return __builtin_amdgcn_raw_buffer_load_b128(r, voff, soff, 0); }
__device__ __forceinline__ v2u bld8(rsrc_t r, int voff, int soff) { return __builtin_amdgcn_raw_buffer_load_b64(r, voff, soff, 0); }
__device__ __forceinline__ int crow(int r, int hi) { return (r & 3) + 8 * (r >> 2) + 4 * hi; }
__device__ __forceinline__ s16x4 vtr(const LAS unsigned char* p) { return __builtin_bit_cast(s16x4, __builtin_amdgcn_ds_read_tr16_b64_v4i16((LAS s16x4*)p)); }
__device__ __forceinline__ unsigned cvtpk(float lo, float hi) { typedef float f2 __attribute__((ext_vector_type(2))); typedef __bf16 b2 __attribute__((ext_vector_type(2))); f2 v = {lo, hi}; b2 b = __builtin_convertvector(v, b2); return __builtin_bit_cast(unsigned, b); }

__device__ __forceinline__ void prompt_tile(const rsrc_t rp, bf16* __restrict__ mixed, float* __restrict__ lse, LAS unsigned char* wl, int b, int g, int h, int r, int j, int lane) {
    const int a = lane & 31, hi = lane >> 5, s = 2 * g, qs = 32 * j, rowb = b * TP, colq = g * 256 + h * 64, l8 = lane >> 3, c8 = lane & 7;
    const int L = TP >> s, vo = lane * 16;
    const int bq = (((g * 4 + h) * 8 + b) * TP + r * L + qs) * 128, bk = bq + 3 * 4 * 8 * TP * 128 - 128 * 128, bv = bk + 3 * 4 * 8 * TP * 128;
    v4u qraw[4], kraw[20], va[12], vb[8];
#pragma unroll
    for (int i = 0; i < 4; ++i) qraw[i] = bld16(rp, vo, bq + i * 1024);
#pragma unroll
    for (int i = 0; i < 20; ++i) kraw[i] = bld16(rp, vo, bk + i * 1024);
    const int wsw = l8 * VP + ((c8 ^ l8) * 16), rsw = a * VP;
#pragma unroll
    for (int i = 0; i < 4; ++i) *(LAS v4u*)(wl + 8 * i * VP + wsw) = qraw[i];
    bf16x8 qf[4];
#pragma unroll
    for (int d0 = 0; d0 < 4; ++d0) qf[d0] = *(const LAS bf16x8*)(wl + rsw + (((2 * d0 + hi) ^ (a & 7)) * 16));
#pragma unroll
    for (int i = 0; i < 20; ++i) *(LAS v4u*)(wl + 8 * i * VP + wsw) = kraw[i];
    asm volatile("" ::: "memory");
#pragma unroll
    for (int i = 0; i < 12; ++i) va[i] = bld16(rp, vo, bv + i * 1024);
    f32x16 S[5];
#pragma unroll
    for (int kb = 0; kb < 5; ++kb) { f32x16 acc = {};
#pragma unroll
        for (int d0 = 0; d0 < 4; ++d0) { const bf16x8 kf = *(const LAS bf16x8*)(wl + 32 * kb * VP + rsw + (((2 * d0 + hi) ^ (a & 7)) * 16)); acc = __builtin_amdgcn_mfma_f32_32x32x16_bf16(kf, qf[d0], acc, 0, 0, 0); }
        S[kb] = acc; }
    asm volatile("" ::: "memory");
#pragma unroll
    for (int i = 0; i < 8; ++i) vb[i] = bld16(rp, vo, bv + (12 + i) * 1024);
    float mr = -INFINITY; float bias[5];
#pragma unroll
    for (int kb = 0; kb < 5; ++kb) { const bool bv = (qs - 128 + 32 * kb) >= 0; bias[kb] = bv ? 0.f : -INFINITY; float bm = -INFINITY;
#pragma unroll
        for (int rr = 0; rr < 16; ++rr) { const int key = crow(rr, hi); float v = S[kb][rr];
            if (kb == 0) { v = key >= a ? v : -INFINITY; S[kb][rr] = v; } if (kb == 4) { v = key <= a ? v : -INFINITY; S[kb][rr] = v; }
            bm = fmaxf(bm, v); }
        mr = bv ? fmaxf(mr, bm) : mr; }
    mr = fmaxf(mr, __shfl_xor(mr, 32));
    const float mxs = mr * C2;
    float l = 0.f; v4u pw[5][2];
#pragma unroll
    for (int kb = 0; kb < 5; ++kb) { const float nb = bias[kb] - mxs; float p[16];
#pragma unroll
        for (int rr = 0; rr < 16; ++rr) { p[rr] = __builtin_amdgcn_exp2f(__builtin_fmaf(S[kb][rr], C2, nb)); l += p[rr]; }
#pragma unroll
        for (int st = 0; st < 2; ++st) { pw[kb][st].x = cvtpk(p[8 * st + 0], p[8 * st + 1]); pw[kb][st].y = cvtpk(p[8 * st + 2], p[8 * st + 3]); pw[kb][st].z = cvtpk(p[8 * st + 4], p[8 * st + 5]); pw[kb][st].w = cvtpk(p[8 * st + 6], p[8 * st + 7]); } }
    l += __shfl_xor(l, 32);
#pragma unroll
    for (int i = 0; i < 12; ++i) *(LAS v4u*)(wl + (8 * i + l8) * VP + c8 * 16) = va[i];
    f32x16 o[2]; o[0] = f32x16{}; o[1] = f32x16{};
    const LAS unsigned char* vbase = wl + (4 * hi + ((lane & 15) >> 2)) * VP + (16 * ((lane >> 4) & 1) + 4 * (lane & 3)) * 2;
#pragma unroll
    for (int kb = 0; kb < 5; ++kb) {
        if (kb == 3) {
#pragma unroll
            for (int i = 0; i < 8; ++i) *(LAS v4u*)(wl + (96 + 8 * i + l8) * VP + c8 * 16) = vb[i]; }
#pragma unroll
        for (int st = 0; st < 2; ++st) {
            const bf16x8 pa = __builtin_bit_cast(bf16x8, pw[kb][st]);
#pragma unroll
            for (int cc = 0; cc < 2; ++cc) {
                const s16x4 lo = vtr(vbase + (32 * kb + 16 * st) * VP + cc * 64), hh = vtr(vbase + (32 * kb + 16 * st + 8) * VP + cc * 64);
                const bf16x8 vf = (bf16x8){lo[0], lo[1], lo[2], lo[3], hh[0], hh[1], hh[2], hh[3]};
                o[cc] = __builtin_amdgcn_mfma_f32_32x32x16_bf16(pa, vf, o[cc], 0, 0, 0);
            }
        }
    }
    const float linv = 1.0f / l;
#pragma unroll
    for (int rr = 0; rr < 16; ++rr) { const int q = crow(rr, hi); const float li = __shfl(linv, q);
        const unsigned w = cvtpk(o[0][rr] * li, o[1][rr] * li); LAS bf16* op = (LAS bf16*)(wl + q * VP) + a; op[0] = (bf16)(w & 0xffffu); op[32] = (bf16)(w >> 16); }
#pragma unroll
    for (int i = 0; i < 4; ++i) { const v4u ov = *(const LAS v4u*)(wl + (8 * i + l8) * VP + c8 * 16);
        *(v4u*)(mixed + (size_t)(rowb + ((qs + 8 * i + l8) << s) + r) * D + colq + c8 * 8) = ov; }
    if (hi == 0) lse[(size_t)(rowb + ((qs + a) << s) + r) * 12 + g * 4 + h] = mxs + __builtin_amdgcn_logf(l);
}

__device__ __forceinline__ f32x4 kv_row(const rsrc_t rc, const rsrc_t rp, bool maybe_new, int W, int b, int idx, int sel, int g, int h, int c) {
    if (maybe_new) { const bool nw = idx >= W; const int idc = nw ? W - 1 : idx;
        const f32x4 cv = __builtin_bit_cast(f32x4, bld16(rc, ((b * W + idc) * 2 + sel) * 1024 + (h * 64 + 4 * c) * 4, 0));
        const v2u pw = bld8(rp, (MP + b * 8 + (nw ? idx - W : 0)) * (NIN * 2) + (768 + sel * 768 + g * 256 + h * 64 + 4 * c) * 2, 0);
        const f32x4 pv = {bflo(pw.x), bfhi(pw.x), bflo(pw.y), bfhi(pw.y)};
        return nw ? pv : cv; }
    return __builtin_bit_cast(f32x4, bld16(rc, ((b * W + idx) * 2 + sel) * 1024 + (h * 64 + 4 * c) * 4, 0));
}
__device__ __forceinline__ void sample_group(Frame& F, const rsrc_t rp, int b, int g, int h, int t, const int lane_in, f32x4& o_out, float& lse_out, float* kvout) {
    int lane = lane_in; asm volatile("" : "+v"(lane));
    const int rg = lane >> 4, c = lane & 15;
    const int W = 128 << (2 * g), sh = 2 * g;
    const rsrc_t rc = mk_rsrc(pick3(g, F.c0, F.c1, F.c2));
    const int qrow = MP + b * 8 + t;
    f32x4 q; { const v2u w = bld8(rp, qrow * (NIN * 2) + (g * 256 + h * 64 + 4 * c) * 2, 0); q = (f32x4){bflo(w.x), bfhi(w.x), bflo(w.y), bfhi(w.y)}; }
    f32x4 kv[33]; float sc[33];
    const bool cpy = t < (1 << (g + (g > 0 ? 1 : 0)));
    const rsrc_t ro = mk_rsrc(kvout); const int vo0 = (((b * W + W + t - 8 - (rg << sh)) * 2) * 256 + h * 64 + 4 * c) * 4, vstr = (4 << sh) * 2048;
#pragma unroll
    for (int i0 = 0; i0 < 33; i0 += 33) {
        asm volatile("" ::: "memory");
#pragma unroll
        for (int i = i0; i < i0 + 33 && i < 33; ++i) { int j = 4 * i + rg; j = j > 128 ? 128 : j; kv[i] = kv_row(rc, rp, i < 2, W, b, W + t - (j << sh), 0, g, h, c); }
#pragma unroll
        for (int i = i0; i < i0 + 33 && i < 33; ++i) { float p = (kv[i][0] * q[0] + kv[i][1] * q[1]) + (kv[i][2] * q[2] + kv[i][3] * q[3]);
            p += __shfl_xor(p, 1); p += __shfl_xor(p, 2); p += __shfl_xor(p, 4); p += __shfl_xor(p, 8);
            sc[i] = (4 * i + rg) <= 128 ? p * C2 : -INFINITY;
            { const int j = 4 * i + rg, idx = W + t - (j << sh); if (cpy && j <= 128 && idx >= 8 && idx < W) __builtin_amdgcn_raw_buffer_store_b128(__builtin_bit_cast(v4u, kv[i]), ro, vo0 - i * vstr, 0, 0); } } }
    float mx = sc[0];
#pragma unroll
    for (int i = 1; i < 33; ++i) mx = fmaxf(mx, sc[i]);
    mx = fmaxf(mx, __shfl_xor(mx, 16)); mx = fmaxf(mx, __shfl_xor(mx, 32));
    float l = 0.f;
#pragma unroll
    for (int i = 0; i < 33; ++i) { sc[i] = __builtin_amdgcn_exp2f(sc[i] - mx); l += sc[i]; }
    l += __shfl_xor(l, 16); l += __shfl_xor(l, 32);
    f32x4 o = {0.f, 0.f, 0.f, 0.f};
#pragma unroll
    for (int i0 = 0; i0 < 33; i0 += 33) {
        asm volatile("" ::: "memory");
#pragma unroll
        for (int i = i0; i < i0 + 33 && i < 33; ++i) { int j = 4 * i + rg; j = j > 128 ? 128 : j; kv[i] = kv_row(rc, rp, i < 2, W, b, W + t - (j << sh), 1, g, h, c); }
#pragma unroll
        for (int i = i0; i < i0 + 33 && i < 33; ++i) { o += kv[i] * sc[i];
            const int j = 4 * i + rg, idx = W + t - (j << sh); if (cpy && j <= 128 && idx >= 8 && idx < W) __builtin_amdgcn_raw_buffer_store_b128(__builtin_bit_cast(v4u, kv[i]), ro, vo0 - i * vstr + 1024, 0, 0); } }
#pragma unroll
    for (int e = 0; e < 4; ++e) { float v = o[e]; v += __shfl_xor(v, 16); v += __shfl_xor(v, 32); o[e] = v; }
    const float li = 1.0f / l;
    o_out = o * li; lse_out = mx + __builtin_amdgcn_logf(l);
}
__device__ __forceinline__ void sample_task(Frame& F, const rsrc_t rp, LAS unsigned char* wl, int task, const int lane) {
    const int t = task & 7, h = (task >> 3) & 3, b = task >> 5, rg = lane >> 4, c = lane & 15;
#pragma unroll 1
    for (int g = 0; g < 3; ++g) { f32x4 o; float ls; sample_group(F, rp, b, g, h, t, lane, o, ls, F.out + (g == 0 ? O_KVS0 : (g == 1 ? O_KVS1 : O_KVS2)));
        *(LAS f32x4*)(wl + g * 1024 + lane * 16) = o; *(LAS float*)(wl + 3072 + g * 256 + lane * 4) = ls; }
    f32x4 o0 = *(const LAS f32x4*)(wl + lane * 16), o1 = *(const LAS f32x4*)(wl + 1024 + lane * 16), o2 = *(const LAS f32x4*)(wl + 2048 + lane * 16);
    const float l0 = *(const LAS float*)(wl + 3072 + lane * 4), l1 = *(const LAS float*)(wl + 3072 + 256 + lane * 4), l2 = *(const LAS float*)(wl + 3072 + 512 + lane * 4);
    const float mx = fmaxf(l0, fmaxf(l1, l2)); const float e0 = __builtin_amdgcn_exp2f(l0 - mx), e1 = __builtin_amdgcn_exp2f(l1 - mx), e2 = __builtin_amdgcn_exp2f(l2 - mx);
    const float inv = 1.0f / (e0 + e1 + e2);
    o0 = o0 * (e0 * inv); o1 = o1 * (e1 * inv); o2 = o2 * (e2 * inv);
    if (rg == 0) { bf16* op = F.MIX + (size_t)(MP + b * 8 + t) * D + h * 64 + 4 * c; v2u w;
        w.x = cvtpk(o0[0], o0[1]); w.y = cvtpk(o0[2], o0[3]); *(v2u*)(op) = w;
        w.x = cvtpk(o1[0], o1[1]); w.y = cvtpk(o1[2], o1[3]); *(v2u*)(op + 256) = w;
        w.x = cvtpk(o2[0], o2[1]); w.y = cvtpk(o2[2], o2[3]); *(v2u*)(op + 512) = w; }
}
}

__device__ __forceinline__ void unpack8(const v4u w, float (&f)[8]) { f[0] = bflo(w.x); f[1] = bfhi(w.x); f[2] = bflo(w.y); f[3] = bfhi(w.y); f[4] = bflo(w.z); f[5] = bfhi(w.z); f[6] = bflo(w.w); f[7] = bfhi(w.w); }
__device__ __forceinline__ void conv_u(const bf16* proj, size_t row, int ch, float (&u)[8]) {
    float cf[8], hf[8]; unpack8(*(const v4u*)(proj + row * NIN + 2560 + 8 * ch), cf); unpack8(*(const v4u*)(proj + row * NIN + 2816 + 8 * ch), hf);
#pragma unroll
    for (int e = 0; e < 8; ++e) u[e] = cf[e] * hf[e];
}
__device__ __forceinline__ void ld8f(const float* p, float (&u)[8]) { const f32x4 a = *(const f32x4*)p, b = *(const f32x4*)(p + 4); u[0] = a[0]; u[1] = a[1]; u[2] = a[2]; u[3] = a[3]; u[4] = b[0]; u[5] = b[1]; u[6] = b[2]; u[7] = b[3]; }

__device__ __forceinline__ void p2_mixers(Frame& F, const int mask) {
    int tid_ = F.tid; asm volatile("" : "+v"(tid_));
    const int lane_ = tid_ & 63;
    const int gt = F.vcu * (NWAVES * 64) + tid_, NGT = F.G * NWAVES * 64;
    const int gw = F.vcu * NWAVES + F.wave, NGW = F.G * NWAVES;
    const att::rsrc_t rp = att::mk_rsrc(F.PROJ), rq = att::mk_rsrc(F.QKVP);
    if (mask & 1) { LAS unsigned char* wl = F.lds + F.wave * att::WTILE;
      for (int su_ = F.vcu; su_ < 512 * REP_A; su_ += F.G) { const int su = su_ % 512, b = su >> 6, h = (su >> 4) & 3, rg = su & 15;
#pragma unroll 1
        for (int i = 0; i < 6; ++i) { const int k = F.wave + 8 * i, g = k >> 4, kk = k & 15, tpr = 16 >> (2 * g), r = kk / tpr, j = rg * tpr + kk % tpr;
            att::prompt_tile(rq, F.MIX, F.LSE, wl, b, g, h, r, j, lane_); }
        asm volatile("s_waitcnt vmcnt(0)" ::: "memory"); __syncthreads(); __builtin_amdgcn_fence(__ATOMIC_ACQUIRE, "workgroup");
        const size_t row0 = (size_t)b * TP + rg * 512;
#pragma unroll 1
        for (int i0 = 0; i0 < 8; i0 += 4) { float ls[4][3]; v4u mw[4][3];
#pragma unroll
            for (int k = 0; k < 4; ++k) { const int it = tid_ + 512 * (i0 + k), ch = it & 7; const size_t row = row0 + (it >> 3);
#pragma unroll
                for (int g = 0; g < 3; ++g) { ls[k][g] = F.LSE[row * 12 + 4 * g + h]; mw[k][g] = *(const v4u*)(F.MIX + row * D + g * 256 + h * 64 + 8 * ch); } }
#pragma unroll
            for (int k = 0; k < 4; ++k) { const int it = tid_ + 512 * (i0 + k), ch = it & 7; const size_t row = row0 + (it >> 3);
                const float mx = fmaxf(ls[k][0], fmaxf(ls[k][1], ls[k][2])); const float e0 = __builtin_amdgcn_exp2f(ls[k][0] - mx), e1 = __builtin_amdgcn_exp2f(ls[k][1] - mx), e2 = __builtin_amdgcn_exp2f(ls[k][2] - mx);
                const float inv = 1.0f / (e0 + e1 + e2); const float al[3] = {e0 * inv, e1 * inv, e2 * inv};
#pragma unroll
                for (int g = 0; g < 3; ++g) { float f[8]; unpack8(mw[k][g], f);
                    v4u o; o.x = att::cvtpk(f[0] * al[g], f[1] * al[g]); o.y = att::cvtpk(f[2] * al[g], f[3] * al[g]); o.z = att::cvtpk(f[4] * al[g], f[5] * al[g]); o.w = att::cvtpk(f[6] * al[g], f[7] * al[g]);
                    *(v4u*)(F.MIX + row * D + g * 256 + h * 64 + 8 * ch) = o; } }
        }
      } }
    if (mask & 2) for (int task = gw; task < 128 * 4 * 8 * REP_B; task += NGW) att::sample_task(F, rp, F.lds + F.wave * att::WTILE, task % (128 * 4 * 8), lane_);
    if (mask & 4) for (int it_ = gt; it_ < (M / 4) * 32 * REP_C; it_ += NGT) { const int it = it_ % ((M / 4) * 32);
        const int ch = it & 31, row0 = (it >> 5) * 4; const bool smp = row0 >= MP;
        const int t0 = smp ? ((row0 - MP) & 7) : (row0 & (TP - 1)), b = smp ? ((row0 - MP) >> 3) : (row0 >> 13);
        v4u cw[6], hw[6], bw[4];
#pragma unroll
        for (int k = 0; k < 6; ++k) { const int row = row0 - 2 + k; if (k >= 2 || t0 > 0) { cw[k] = *(const v4u*)(F.PROJ + (size_t)row * NIN + 2560 + 8 * ch); hw[k] = *(const v4u*)(F.PROJ + (size_t)row * NIN + 2816 + 8 * ch); } else { cw[k] = (v4u){0u, 0u, 0u, 0u}; hw[k] = cw[k]; } }
#pragma unroll
        for (int k = 0; k < 4; ++k) bw[k] = *(const v4u*)(F.PROJ + (size_t)(row0 + k) * NIN + 2304 + 8 * ch);
        float w0[8], w1[8], w2[8]; ld8f(F.conv_w + 8 * ch, w0); ld8f(F.conv_w + 256 + 8 * ch, w1); ld8f(F.conv_w + 512 + 8 * ch, w2);
        float u[6][8];
#pragma unroll
        for (int k = 0; k < 6; ++k) { float cf[8], hf[8]; unpack8(cw[k], cf); unpack8(hw[k], hf);
#pragma unroll
            for (int e = 0; e < 8; ++e) u[k][e] = cf[e] * hf[e]; }
        if (smp && t0 == 0) { ld8f(F.sconv + ((size_t)b * 2 + 0) * 256 + 8 * ch, u[0]); ld8f(F.sconv + ((size_t)b * 2 + 1) * 256 + 8 * ch, u[1]); }
#pragma unroll
        for (int k = 0; k < 4; ++k) { float bg[8], y[8]; unpack8(bw[k], bg);
#pragma unroll
            for (int e = 0; e < 8; ++e) y[e] = bg[e] * (w0[e] * u[k][e] + w1[e] * u[k + 1][e] + w2[e] * u[k + 2][e]);
            v4u o; o.x = att::cvtpk(y[0], y[1]); o.y = att::cvtpk(y[2], y[3]); o.z = att::cvtpk(y[4], y[5]); o.w = att::cvtpk(y[6], y[7]);
            *(v4u*)(F.MIX + (size_t)(row0 + k) * D + 768 + 8 * ch) = o; }
    }
}
__device__ __forceinline__ void p2_outputs(Frame& F, const int wg_rank, const int wg_count) {
    const int gt = wg_rank * (NWAVES * 64) + F.tid, NGT = wg_count * NWAVES * 64; const int mask = 8;
    if (mask & 8) for (int g = 0; g < 3; ++g) {
        const int W = 128 << (2 * g); float* dst = F.out + (g == 0 ? O_KVP0 : (g == 1 ? O_KVP1 : O_KVP2));
        { const int NK = 8 * W * 64;
          for (int it0 = gt; it0 < NK; it0 += 4 * NGT) { v4u w[4];
#pragma unroll
            for (int k = 0; k < 4; ++k) { const int it = it0 + k * NGT; if (it < NK) { const int ch = it & 31, sel = (it >> 5) & 1, br = it >> 6, rr = br % W, b = br / W;
                const int t = TP - W + rr, sh = 2 * g, prow = (t & ((1 << sh) - 1)) * (TP >> sh) + (t >> sh);
                w[k] = *(const v4u*)(F.QKVP + ((size_t)(((((1 + sel) * 3 + g) * 4 + (ch >> 3)) * 8 + b) * TP + prow)) * 64 + 8 * (ch & 7)); } }
#pragma unroll
            for (int k = 0; k < 4; ++k) { const int it = it0 + k * NGT; if (it < NK) { float f[8]; unpack8(w[k], f);
                float* o = dst + (size_t)it * 8; *(f32x4*)o = (f32x4){f[0], f[1], f[2], f[3]}; *(f32x4*)(o + 4) = (f32x4){f[4], f[5], f[6], f[7]}; } } } }
        float* dsts = F.out + (g == 0 ? O_KVS0 : (g == 1 ? O_KVS1 : O_KVS2));
        for (int it = gt; it < 128 * 8 * 64; it += NGT) { const int ch = it & 31, sel = (it >> 5) & 1, bt = it >> 6, t = bt & 7, b = bt >> 3;
            float f[8]; unpack8(*(const v4u*)(F.PROJ + ((size_t)MP + b * 8 + t) * NIN + 768 + sel * 768 + g * 256 + 8 * ch), f);
            float* o = dsts + (((size_t)b * W + (W - 8 + t)) * 2 + sel) * 256 + 8 * ch; *(f32x4*)o = (f32x4){f[0], f[1], f[2], f[3]}; *(f32x4*)(o + 4) = (f32x4){f[4], f[5], f[6], f[7]}; }
    }
    for (int it = gt; it < 8 * 2 * 32; it += NGT) { const int ch = it & 31, j = (it >> 5) & 1, b = it >> 6; float u[8]; conv_u(F.PROJ, (size_t)b * TP + TP - 2 + j, ch, u);
        float* o = F.out + O_CVP + (size_t)it * 8; *(f32x4*)o = (f32x4){u[0], u[1], u[2], u[3]}; *(f32x4*)(o + 4) = (f32x4){u[4], u[5], u[6], u[7]}; }
    for (int it = gt; it < 128 * 2 * 32; it += NGT) { const int ch = it & 31, j = (it >> 5) & 1, b = it >> 6; float u[8]; conv_u(F.PROJ, (size_t)MP + b * 8 + 6 + j, ch, u);
        float* o = F.out + O_CVS + (size_t)it * 8; *(f32x4*)o = (f32x4){u[0], u[1], u[2], u[3]}; *(f32x4*)(o + 4) = (f32x4){u[4], u[5], u[6], u[7]}; }
}
__device__ __forceinline__ void p6_final(Frame& F) {
    const int gw = F.vcu * NWAVES + F.wave, NGW = F.G * NWAVES;
    f32x4 gf[4];
#pragma unroll
    for (int j = 0; j < 4; ++j) gf[j] = ((const f32x4*)F.g_fin)[2 * (F.lane + 64 * (j >> 1)) + (j & 1)];
    for (int m0 = gw * 4; m0 < M; m0 += NGW * 4) {
        float sp[4]; v4u v[4][2];
#pragma unroll
        for (int r = 0; r < 4; ++r) sp[r] = F.ST2[(size_t)(m0 + r) * 16 + (F.lane & 15)];
#pragma unroll
        for (int r = 0; r < 4; ++r)
#pragma unroll
            for (int j = 0; j < 2; ++j) v[r][j] = ((const v4u*)(F.MIX + (size_t)(m0 + r) * D))[F.lane + 64 * j];
#pragma unroll
        for (int r = 0; r < 4; ++r) { float ss = sp[r]; ss += __shfl_xor(ss, 1); ss += __shfl_xor(ss, 2); ss += __shfl_xor(ss, 4); ss += __shfl_xor(ss, 8);
            const float rstd = __builtin_amdgcn_rsqf(ss * (1.0f / D) + EPS);
#pragma unroll
            for (int j = 0; j < 2; ++j) { float f[8]; unpack8(v[r][j], f); f32x4* o = (f32x4*)(F.out + (size_t)(m0 + r) * D) + 2 * (F.lane + 64 * j);
                o[0] = (f32x4){f[0], f[1], f[2], f[3]} * rstd * gf[2 * j]; o[1] = (f32x4){f[4], f[5], f[6], f[7]} * rstd * gf[2 * j + 1]; } }
    }
}

__device__ __forceinline__ void p6_tail_reduce(Frame& F, const pg8::StaticOrder& S0, const int nfull, const int split) {
    const int gt = F.vcu * (NWAVES * 64) + F.tid, NGT = F.G * NWAVES * 64; const int ntail = S0.nwg - nfull;
    for (int it = gt; it < ntail * 256 * 32; it += NGT) {
        const int ch = it & 31, rw = (it >> 5) & 255, ti = it >> 13; pg8::Unit u; S0.tile(nfull + ti, u);
        const float* p = F.PART + (size_t)ti * split * 65536 + rw * 256 + ch * 8;
        f32x4 s0 = {0.f, 0.f, 0.f, 0.f}, s1 = s0;
#pragma unroll 1
        for (int k0 = 0; k0 < split; k0 += 8) { f32x4 a[8], b[8];
#pragma unroll
            for (int k = 0; k < 8; ++k) { const int kk = k0 + k < split ? k0 + k : 0; a[k] = *(const f32x4*)(p + (size_t)kk * 65536); b[k] = *(const f32x4*)(p + (size_t)kk * 65536 + 4); }
#pragma unroll
            for (int k = 0; k < 8; ++k) if (k0 + k < split) { s0 += a[k]; s1 += b[k]; } }
        const size_t row = (size_t)u.pm * 256 + rw; const size_t off = row * D + u.pn * 256 + ch * 8;
        float xr[8]; unpack8(*(const v4u*)(F.XB + off), xr);
        float o[8] = {s0[0] + xr[0], s0[1] + xr[1], s0[2] + xr[2], s0[3] + xr[3], s1[0] + xr[4], s1[1] + xr[5], s1[2] + xr[6], s1[3] + xr[7]};
        v4u w; w.x = att::cvtpk(o[0], o[1]); w.y = att::cvtpk(o[2], o[3]); w.z = att::cvtpk(o[4], o[5]); w.w = att::cvtpk(o[6], o[7]);
        *(v4u*)(F.MIX + off) = w;
        float ss = ((o[0] * o[0] + o[1] * o[1]) + (o[2] * o[2] + o[3] * o[3])) + ((o[4] * o[4] + o[5] * o[5]) + (o[6] * o[6] + o[7] * o[7]));
        ss += __shfl_xor(ss, 1); ss += __shfl_xor(ss, 2); ss += __shfl_xor(ss, 4); ss += __shfl_xor(ss, 8); ss += __shfl_xor(ss, 16);
        if (ch < 4) F.ST2[row * 16 + u.pn * 4 + ch] = ch == 0 ? ss : 0.f;
    }
}
__device__ __forceinline__ void tail_copy(Frame& F, int first, int count, int n_busy) {
    const int bid = (int)blockIdx.x; if (bid < n_busy) return;
    const int rank = bid - n_busy, nidle = F.G - n_busy, toff = F.tid * 16;
    const __amdgpu_buffer_rsrc_t rs_ = __builtin_amdgcn_make_buffer_rsrc((void*)F.c2, 0, 0x7fffffff, 0x00020000), rd_ = __builtin_amdgcn_make_buffer_rsrc((void*)(F.out + O_KVS2), 0, 0x7fffffff, 0x00020000);
    for (int k0 = rank * 4; k0 < count; k0 += nidle * 4) {
        v4u cp[8]; int dof[4];
#pragma unroll
        for (int k = 0; k < 4; ++k) { int blk = first + (k0 + k < count ? k0 + k : count - 1); blk = blk >= pg8::CP_NBLK ? pg8::CP_NBLK - 1 : blk; const int b = blk >> 7, q = blk & 127; dof[k] = ((b * 2048 + 16 * q) * 512) * 4;
            cp[2 * k] = __builtin_amdgcn_raw_buffer_load_b128(rs_, toff, dof[k] + 16384, 2); cp[2 * k + 1] = __builtin_amdgcn_raw_buffer_load_b128(rs_, toff, dof[k] + 16384 + 8192, 2); }
#pragma unroll
        for (int k = 0; k < 4; ++k) { __builtin_amdgcn_raw_buffer_store_b128(cp[2 * k], rd_, toff, dof[k], 2); __builtin_amdgcn_raw_buffer_store_b128(cp[2 * k + 1], rd_, toff, dof[k] + 8192, 2); }
    }
}
__device__ __forceinline__ void stagger_start(int us) {
    const unsigned long long t0 = __builtin_amdgcn_s_memrealtime(), dt = (unsigned long long)(((blockIdx.x >> 3) & 3) * us * 100);
    while (__builtin_amdgcn_s_memrealtime() - t0 < dt) __builtin_amdgcn_s_sleep(16);
}
#define XB_TMO      128
#define XB_XCNT(j)  (256  + 64 * (j))
#define XB_XSUB(j)  (1280 + 64 * (j))
#define XB_XGEN(j)  (2304 + 64 * (j))
#define XB_TOP      3328
#define XB_TOPGEN   3392
#define XCD_BAR_WORDS 3456
#define XB_SPIN_CAP (1u << 18)
__device__ __forceinline__ unsigned xb_ld(unsigned* p)              { return __hip_atomic_load(p, __ATOMIC_RELAXED, __HIP_MEMORY_SCOPE_AGENT); }
__device__ __forceinline__ unsigned xb_add(unsigned* p, unsigned v) { return __hip_atomic_fetch_add(p, v, __ATOMIC_RELAXED, __HIP_MEMORY_SCOPE_AGENT); }
__device__ __forceinline__ unsigned xb_xcc_id() { return (unsigned)__builtin_amdgcn_s_getreg((3 << 11) | 20) & 0xFu; }
#define XB_SPIN(cond, bar) do { unsigned _sp = 0; while (cond) { __builtin_amdgcn_s_sleep(1); \
    if ((++_sp & 255u) == 0u) { if (xb_ld(&(bar)[XB_TMO])) break; if (_sp > XB_SPIN_CAP) { atomicAdd(&(bar)[XB_TMO], 1u); break; } } } } while (0)
struct XcdBarrier { unsigned* bar; unsigned x, nloc, nx; };
__device__ __forceinline__ void xcd_barrier_complete(unsigned* bar, unsigned x, unsigned& nloc, unsigned& nx) {
    const unsigned G = gridDim.x * gridDim.y * gridDim.z;
    unsigned sum, cnt, mine, sp = 0u;
    for (;;) {
        sum = 0u; cnt = 0u; mine = 0u;
#pragma unroll
        for (unsigned j = 0; j < 16; ++j) { const unsigned c = xb_ld(&bar[XB_XCNT(j)]); sum += c; cnt += (c > 0u) ? 1u : 0u; mine = (j == x) ? c : mine; }
        if (sum == G) break;
        __builtin_amdgcn_s_sleep(1);
        if ((++sp & 255u) == 0u) { if (xb_ld(&bar[XB_TMO])) break; if (sp > XB_SPIN_CAP) { atomicAdd(&bar[XB_TMO], 1u); break; } }
    }
    nloc = mine > 0u ? mine : 1u; nx = cnt > 0u ? cnt : 1u;
}
__device__ __forceinline__ void xcd_barrier(XcdBarrier& b) {
    asm volatile("s_waitcnt vmcnt(0)" ::: "memory");
    __syncthreads();
    if (threadIdx.x == 0) {
        unsigned* bar = b.bar;
        __builtin_amdgcn_s_waitcnt(0);
        if (b.nloc == 0u) xcd_barrier_complete(bar, b.x, b.nloc, b.nx);
        const unsigned nloc = b.nloc, nx = b.nx;
        const unsigned old = xb_add(&bar[XB_XSUB(b.x)], 1u);
        const unsigned gen = old / nloc;
        if (old + 1u == (gen + 1u) * nloc) {
            __builtin_amdgcn_fence(__ATOMIC_RELEASE, "agent");
            asm volatile("s_waitcnt vmcnt(0)" ::: "memory");
            const unsigned og = xb_add(&bar[XB_TOP], 1u);
            const unsigned tg = og / nx;
            if (og + 1u == (tg + 1u) * nx) xb_add(&bar[XB_TOPGEN], 1u);
            else XB_SPIN(xb_ld(&bar[XB_TOPGEN]) == tg, bar);
            __builtin_amdgcn_fence(__ATOMIC_ACQUIRE, "agent");
            xb_add(&bar[XB_XGEN(b.x)], 1u);
            asm volatile("s_waitcnt vmcnt(0)" ::: "memory");
        } else {
            XB_SPIN(xb_ld(&bar[XB_XGEN(b.x)]) == gen, bar);
            __builtin_amdgcn_fence(__ATOMIC_ACQUIRE, "agent");
            asm volatile("s_waitcnt vmcnt(0)" ::: "memory");
        }
    }
    __syncthreads();
}
struct Args { const float* in[14]; float* out; unsigned char* ws; int ph_lo, ph_hi, probe, pad; };
__global__ void __launch_bounds__(NWAVES * 64, 2) mega_fwd(Args args) {
    extern __shared__ __attribute__((aligned(16))) unsigned char lds[];
    cg::grid_group grid = cg::this_grid();
    Frame F;
    F.lds = (LAS unsigned char*)lds;
    F.tid = threadIdx.x; F.lane = F.tid & 63; F.wave = __builtin_amdgcn_readfirstlane(F.tid >> 6);
    F.G = gridDim.x; { const int bx = blockIdx.x; F.vcu = (F.G % 8 == 0) ? (bx % 8) * (F.G / 8) + bx / 8 : bx; }
    unsigned char* ws = args.ws;
    F.xp = args.in[0]; F.xs = args.in[1]; F.c0 = args.in[2]; F.c1 = args.in[3]; F.c2 = args.in[4]; F.sconv = args.in[5]; F.g_attn = args.in[6]; F.w_in = args.in[7];
    F.conv_w = args.in[8]; F.w_out = args.in[9]; F.g_mlp = args.in[10]; F.w_up = args.in[11]; F.w_down = args.in[12]; F.g_fin = args.in[13]; F.out = args.out;
    F.Win_t = (bf16*)(ws + WS_WIN); F.Wout_t = (bf16*)(ws + WS_WOUT); F.Wup_t = (bf16*)(ws + WS_WUP); F.Wdn_t = (bf16*)(ws + WS_WDN);
    F.XB = (bf16*)(ws + WS_XB); F.PROJ = (bf16*)(ws + WS_PROJ); F.MIX = (bf16*)(ws + WS_MIX); F.HB = (bf16*)(ws + WS_HB); F.QKVP = (bf16*)(ws + WS_QKVP);
    F.RSTD0 = (float*)(ws + WS_RSTD0); F.ST1 = (float*)(ws + WS_ST1); F.ST2 = (float*)(ws + WS_ST2); F.LSE = (float*)(ws + WS_LSE); F.PART = (float*)(ws + WS_PART); F.PART = (float*)(ws + WS_PART); F.CNT = (unsigned*)(ws + WS_CNT);
    const int lo = args.ph_lo, hi = args.ph_hi;
    XcdBarrier xbar; xbar.bar = (unsigned*)(ws + WS_BAR); xbar.x = xb_xcc_id(); xbar.nloc = 0u; xbar.nx = 0u;
    if (hi - lo > 1 && threadIdx.x == 0) (void)xb_add(&xbar.bar[XB_XCNT(xbar.x)], 1u);
#define IN(k) (lo <= (k) && (k) < hi)
#define SEAM(k) do { if (IN(k) && IN((k) + 1)) xcd_barrier(xbar); } while (0)
    if (args.probe == 0x7fffffff) grid.sync();

    if (IN(0)) { p0_prologue(F); if (PROBE_REP == 0) p0_prologue(F); }
    SEAM(0);
    if (IN(1)) {
        pg8::Gemm g{F.XB, F.Win_t, M, NIN, D}; pg8::StaticOrder S; S.init(M, NIN, F.G, (int)blockIdx.x, REP_G1);
        pg8::EpiScaleBf16<0> E{F.PROJ, NIN, F.RSTD0, EPS, pg8::CopyJob{nullptr, nullptr, 0}, F.QKVP, MP};
        pg8::gemm_phase<pg8::EpiScaleBf16<0>, pg8::StaticOrder, PG8_ALIGN, PG8_SP2>(F.lds, g, S, E);
        tail_copy(F, 0, 5400, S.nwg % F.G);
    }
    SEAM(1);
    if (IN(2)) p2_mixers(F, 7);
    SEAM(2);
    if (IN(4)) {
        pg8::Gemm g{F.MIX, F.Wout_t, M, D, D}; pg8::StaticOrder S; S.init(M, D, F.G, (int)blockIdx.x, REP_G4);
        pg8::EpiResBf16 E{F.XB, F.XB, F.ST1};
        pg8::gemm_phase<pg8::EpiResBf16, pg8::StaticOrder, PG8_ALIGN, PG8_SP2>(F.lds, g, S, E);
        { const int nb = S.nwg % F.G; tail_copy(F, 5400, 5200, nb); if ((int)blockIdx.x >= nb) p2_outputs(F, (int)blockIdx.x - nb, F.G - nb); }
    }
    SEAM(4);
    if (IN(5)) {
        pg8::Gemm g{F.XB, F.Wup_t, M, FF, D}; pg8::StaticOrder S; S.init(M, FF, F.G, (int)blockIdx.x, REP_G5);
        pg8::EpiScaleBf16<1> E{F.HB, FF, F.ST1, EPS, pg8::CopyJob{F.c2, F.out + O_KVS2, 0}, nullptr, 0};
        pg8::gemm_phase<pg8::EpiScaleBf16<1>, pg8::StaticOrder, PG8_ALIGN, PG8_SP2>(F.lds, g, S, E);
        tail_copy(F, 10600, pg8::CP_NBLK - 10600, S.nwg % F.G);
    }
    SEAM(5);
    if (IN(6)) {
        constexpr int NWG6 = (M / 256) * (D / 256);
        int nfull = (NWG6 / F.G) * F.G, ntail = NWG6 - nfull, split = P6_SPLIT; const int cap = F.G < 256 ? F.G : 256;
        while (split > 1 && ntail * split > cap) split >>= 1;
        if (ntail * split > cap || hi - lo == 1) { nfull = NWG6; ntail = 0; }
        pg8::Gemm g{F.HB, F.Wdn_t, M, D, FF}; pg8::StaticOrder S; S.init(M, D, F.G, (int)blockIdx.x, 1, nfull);
        pg8::EpiResBf16 E{F.XB, F.MIX, F.ST2};
        pg8::gemm_phase<pg8::EpiResBf16, pg8::StaticOrder, PG8_ALIGN, PG8_SP2>(F.lds, g, S, E);
        if (ntail > 0) {
            pg8::StaticOrder S0; S0.init(M, D, F.G, (int)blockIdx.x); const pg8::TailOrder T{S0, nfull, split};
            pg8::EpiPartial EP{F.PART, nfull};
            pg8::gemm_phase<pg8::EpiPartial, pg8::TailOrder, PG8_ALIGN, PG8_SP2>(F.lds, g, T, EP);
            xcd_barrier(xbar);
            p6_tail_reduce(F, S0, nfull, split);
        }
    }
    SEAM(6);
    if (IN(7)) p6_final(F);
#undef IN
#undef SEAM
}

extern "C" void kernel_launch(void* const* d_in, const int* in_sizes, int n_in, void* d_out, int out_size, void* d_ws, size_t ws_size, hipStream_t stream) {
    static int grid = 0;
    if (grid == 0) {
        if (n_in != 14 || in_sizes[0] != MP * D || (size_t)out_size != O_END || ws_size < WS_END) { fprintf(stderr, "kernel_launch: unexpected shapes (n_in %d, in0 %d, out %d, ws %zu); nothing launched\n", n_in, n_in > 0 ? in_sizes[0] : -1, out_size, ws_size); grid = -1; return; }
        int dev = 0, cus = 0, per_cu = 0;
        if (hipGetDevice(&dev) != hipSuccess || hipDeviceGetAttribute(&cus, hipDeviceAttributeMultiprocessorCount, dev) != hipSuccess) { grid = -1; return; }
        if (hipFuncSetAttribute((const void*)mega_fwd, hipFuncAttributeMaxDynamicSharedMemorySize, LDS_BYTES) != hipSuccess) { fprintf(stderr, "kernel_launch: hipFuncSetAttribute failed\n"); grid = -1; return; }
        if (hipOccupancyMaxActiveBlocksPerMultiprocessor(&per_cu, (const void*)mega_fwd, NWAVES * 64, LDS_BYTES) != hipSuccess || per_cu < 1) { fprintf(stderr, "kernel_launch: occupancy query failed (%d)\n", per_cu); (void)hipGetLastError(); grid = -1; return; }
        grid = cus;
    }
    if (grid < 0) return;
    Args a{};
    for (int i = 0; i < 14; ++i) a.in[i] = (const float*)d_in[i];
    a.out = (float*)d_out; a.ws = (unsigned char*)d_ws; a.probe = PROBE_P2MASK;
    if (MK_N_LAUNCHES == 1) {
        if (hipMemsetAsync((char*)d_ws + WS_BAR, 0, WS_BAR_BYTES, stream) != hipSuccess) { fprintf(stderr, "kernel_launch: hipMemsetAsync of the barrier words failed\n"); return; }
        a.ph_lo = 0; a.ph_hi = 8;
        void* kargs[] = {&a};
        const hipError_t e = hipLaunchCooperativeKernel((const void*)mega_fwd, dim3(grid), dim3(NWAVES * 64), kargs, LDS_BYTES, stream);
        if (e != hipSuccess) fprintf(stderr, "kernel_launch: cooperative launch failed: %s (grid %d)\n", hipGetErrorString(e), grid);
    } else {
        for (int p = 0; p < 8; ++p) { a.ph_lo = p; a.ph_hi = p + 1; hipLaunchKernelGGL(mega_fwd, dim3(grid), dim3(NWAVES * 64), LDS_BYTES, stream, a); }
    }
}
```

```cpp
#include <hip/hip_runtime.h>
#include <cstdio>
#include <cstdint>
#include <hip/hip_cooperative_groups.h>
namespace cg = cooperative_groups;
namespace pg8 {
#define PG8_LAS __attribute__((address_space(3)))
typedef unsigned short bf16_t;
typedef short bf16x8 __attribute__((ext_vector_type(8)));
typedef float f32x4 __attribute__((ext_vector_type(4)));
typedef unsigned u32x4 __attribute__((ext_vector_type(4)));
constexpr int BM = 256, BK = 64, HALF = 128, HTB = HALF * BK * 2  , STAGE_BYTES = 8 * HTB, NXCD = 8, WGM = 8;

__host__ __device__ __forceinline__ int lds_byte(int r, int c) { const int st = (r >> 4) * 2 + (c >> 5), rr = r & 15, cc = c & 31, ob = rr * 64 + cc * 2; return st * 1024 + (ob ^ (((ob >> 9) & 1) << 5)); }
__host__ __device__ __forceinline__ void stage_rc(int b, int& R, int& C) { const int st = b / 1024, sb = b % 1024, swz = sb ^ (((sb >> 9) & 1) << 5); R = (st >> 1) * 16 + swz / 64; C = (st & 1) * 32 + (swz % 64) / 2; }
__host__ __device__ __forceinline__ int perm32(int rho) { const int n = rho >> 4, i = rho & 15; return 8 * (i >> 2) + 4 * n + (i & 3); }

struct Unit { int pm, pn, lin, ks, ns; };
struct Gemm { const bf16_t* A; const bf16_t* Bt; int M, N, K; };

struct StaticOrder {
    int nM, nN, nwg, G, c, rep, lim;
    __host__ __device__ void init(int M, int N, int G_, int c_, int rep_ = 1, int lim_ = 0) { nM = M / BM; nN = N / BM; nwg = nM * nN; G = G_; c = c_; rep = rep_; lim = lim_ > 0 ? lim_ : nwg; }
    __host__ __device__ void tile(int wgid, Unit& u) const {
        { const int q = nwg / NXCD, r = nwg % NXCD, xcd = wgid % NXCD, off = wgid / NXCD; wgid = (xcd < r ? xcd * (q + 1) : r * (q + 1) + (xcd - r) * q) + off; }
        const int nig = WGM * nN, gid = wgid / nig, fm = gid * WGM, gsz = (nM - fm) < WGM ? (nM - fm) : WGM;
        u.pm = fm + ((wgid % nig) % gsz); u.pn = (wgid % nig) / gsz;
    }
    __host__ __device__ bool next(int i, Unit& u) const {
        long L = (long)i * G + c; if (L >= (long)lim * rep) return false; L %= lim;
        u.lin = (int)L; u.ks = 0; u.ns = 1; tile((int)L, u); return true;
    }
    __device__ __forceinline__ void a_ready(const Unit&) const {}
    __device__ __forceinline__ void done(const Unit&) const {}
};
struct TailOrder {
    StaticOrder so; int first, S;
    __device__ bool next(int i, Unit& u) const {
        if (i > 0) return false; const int item = so.c; if (item >= (so.nwg - first) * S) return false;
        u.lin = first + item / S; u.ks = item % S; u.ns = S; so.tile(u.lin, u); return true;
    }
    __device__ __forceinline__ void a_ready(const Unit&) const {}
    __device__ __forceinline__ void done(const Unit&) const {}
};

__device__ __forceinline__ unsigned cvt_pk_bf16(float lo, float hi) { unsigned r; asm volatile("v_cvt_pk_bf16_f32 %0, %1, %2" : "=v"(r) : "v"(lo), "v"(hi)); return r; }
typedef float f32x2 __attribute__((ext_vector_type(2)));
constexpr int CP_NBLK = 128 * 128;
struct CopyJob { const float* s2; float* d2; int on; };
template <int MODE> struct EpiScaleBf16 {
    static constexpr bool PERM = true, AFTER_DRAIN = false;
    bf16_t* O; int ldc; const float* rs; float eps; CopyJob cj; bf16_t* QKVP; int perm_rows;
    __device__ __forceinline__ void operator()(const f32x4 (&acc)[2][2][4][2], const Unit& u, int wr, int wc, int fr, int fq) const {
        const int row0 = u.pm * BM + wr * 64 + fr; const int col0 = u.pn * BM + wc * 32 + 8 * fq;
        float sc[8];
        if (MODE == 0) {
#pragma unroll
            for (int i = 0; i < 8; ++i) sc[i] = rs[row0 + (i >> 2) * HALF + (i & 3) * 16];
        } else {
            f32x4 pv[8];
#pragma unroll
            for (int i = 0; i < 8; ++i) pv[i] = *(const f32x4*)(rs + (size_t)(row0 + (i >> 2) * HALF + (i & 3) * 16) * 16 + 4 * fq);
#pragma unroll
            for (int i = 0; i < 8; ++i) { float ss = (pv[i][0] + pv[i][1]) + (pv[i][2] + pv[i][3]); ss += __shfl_xor(ss, 16); ss += __shfl_xor(ss, 32);
                sc[i] = __builtin_amdgcn_rsqf(ss * (1.0f / 1024.0f) + eps); }
        }
        u32x4 cp[8]; int so[4], dof[4]; const int toff = threadIdx.x * 16;
        if (MODE == 1 && cj.on) {
#pragma unroll
            for (int k = 0; k < 4; ++k) { int blk = __builtin_amdgcn_readfirstlane(4 * u.lin + k); blk = blk >= CP_NBLK ? CP_NBLK - 1 : blk;
                const int b = blk >> 7, q = blk & 127; dof[k] = ((b * 2048 + 16 * q) * 512) * 4; so[k] = dof[k] + 8 * 512 * 4; }
            const __amdgpu_buffer_rsrc_t rs_ = __builtin_amdgcn_make_buffer_rsrc((void*)cj.s2, 0, 0x7fffffff, 0x00020000);
#pragma unroll
            for (int k = 0; k < 4; ++k) { cp[2 * k] = __builtin_amdgcn_raw_buffer_load_b128(rs_, toff, so[k], 2); cp[2 * k + 1] = __builtin_amdgcn_raw_buffer_load_b128(rs_, toff, so[k] + 8192, 2); }
            asm volatile("" ::: "memory");
        }
#pragma unroll
        for (int ai = 0; ai < 2; ++ai)
#pragma unroll
            for (int m = 0; m < 4; ++m) { const int row = row0 + ai * HALF + m * 16; const float s1 = sc[ai * 4 + m];
                bf16_t* rowp = O + (size_t)row * ldc + col0; int bjs = HALF;
                if (MODE == 0 && QKVP != nullptr && u.pn < 9 && u.pm * BM < perm_rows) {
                    const int sel = u.pn / 3, g = u.pn - 3 * sel, sh = 2 * g, b = row >> 13, t = row & 8191, prow = (t & ((1 << sh) - 1)) * (8192 >> sh) + (t >> sh);
                    rowp = QKVP + ((size_t)((((sel * 3 + g) * 4 + (wc >> 1)) * 8 + b) * 8192 + prow)) * 64 + (wc & 1) * 32 + 8 * fq; bjs = 2 * 8 * 8192 * 64; }
#pragma unroll
                for (int bj = 0; bj < 2; ++bj) { f32x4 v0 = acc[ai][bj][m][0] * s1, v1 = acc[ai][bj][m][1] * s1;
                    if (MODE == 1) {
#pragma unroll
                        for (int e = 0; e < 4; ++e) { const float x0 = fmaxf(v0[e], 0.f), x1 = fmaxf(v1[e], 0.f); v0[e] = x0 * x0; v1[e] = x1 * x1; } }
                    u32x4 w; w.x = cvt_pk_bf16(v0[0], v0[1]); w.y = cvt_pk_bf16(v0[2], v0[3]); w.z = cvt_pk_bf16(v1[0], v1[1]); w.w = cvt_pk_bf16(v1[2], v1[3]);
                    *(u32x4*)(rowp + (size_t)bj * bjs) = w; } }
        if (MODE == 1 && cj.on) {
            asm volatile("" ::: "memory");
            const __amdgpu_buffer_rsrc_t rd_ = __builtin_amdgcn_make_buffer_rsrc((void*)cj.d2, 0, 0x7fffffff, 0x00020000);
#pragma unroll
            for (int k = 0; k < 4; ++k) { __builtin_amdgcn_raw_buffer_store_b128(cp[2 * k], rd_, toff, dof[k], 2); __builtin_amdgcn_raw_buffer_store_b128(cp[2 * k + 1], rd_, toff, dof[k] + 8192, 2); }
        }
    }
};
struct EpiResBf16 {
    static constexpr bool PERM = true, AFTER_DRAIN = false;
    const bf16_t* xin; bf16_t* xio; float* stats;
    __device__ __forceinline__ void operator()(const f32x4 (&acc)[2][2][4][2], const Unit& u, int wr, int wc, int fr, int fq) const {
        const int row0 = u.pm * BM + wr * 64 + fr; const int col0 = u.pn * BM + wc * 32 + 8 * fq;
#pragma unroll
        for (int ai = 0; ai < 2; ++ai) { u32x4 rw[4][2];
#pragma unroll
            for (int m = 0; m < 4; ++m)
#pragma unroll
                for (int bj = 0; bj < 2; ++bj) rw[m][bj] = *(const u32x4*)(xin + (size_t)(row0 + ai * HALF + m * 16) * 1024 + col0 + bj * HALF);
#pragma unroll
            for (int m = 0; m < 4; ++m) { const int row = row0 + ai * HALF + m * 16; float ss = 0.f;
#pragma unroll
                for (int bj = 0; bj < 2; ++bj) { const u32x4 r = rw[m][bj];
                    f32x4 o0 = acc[ai][bj][m][0], o1 = acc[ai][bj][m][1];
                    o0[0] += __builtin_bit_cast(float, r.x << 16); o0[1] += __builtin_bit_cast(float, r.x & 0xffff0000u); o0[2] += __builtin_bit_cast(float, r.y << 16); o0[3] += __builtin_bit_cast(float, r.y & 0xffff0000u);
                    o1[0] += __builtin_bit_cast(float, r.z << 16); o1[1] += __builtin_bit_cast(float, r.z & 0xffff0000u); o1[2] += __builtin_bit_cast(float, r.w << 16); o1[3] += __builtin_bit_cast(float, r.w & 0xffff0000u);
                    u32x4 w; w.x = cvt_pk_bf16(o0[0], o0[1]); w.y = cvt_pk_bf16(o0[2], o0[3]); w.z = cvt_pk_bf16(o1[0], o1[1]); w.w = cvt_pk_bf16(o1[2], o1[3]);
                    *(u32x4*)(xio + (size_t)row * 1024 + col0 + bj * HALF) = w;
                    ss += ((o0[0] * o0[0] + o0[1] * o0[1]) + (o0[2] * o0[2] + o0[3] * o0[3])) + ((o1[0] * o1[0] + o1[1] * o1[1]) + (o1[2] * o1[2] + o1[3] * o1[3])); }
                ss += __shfl_xor(ss, 16); ss += __shfl_xor(ss, 32);
                if (fq == 0) stats[(size_t)row * 16 + u.pn * 4 + wc] = ss; }
            asm volatile("" ::: "memory"); }
    }
};
struct EpiPartial {
    static constexpr bool PERM = true, AFTER_DRAIN = false;
    float* part; int first;
    __device__ __forceinline__ void operator()(const f32x4 (&acc)[2][2][4][2], const Unit& u, int wr, int wc, int fr, int fq) const {
        float* base = part + (size_t)((u.lin - first) * u.ns + u.ks) * 65536 + (wr * 64 + fr) * 256 + wc * 32 + 8 * fq;
#pragma unroll
        for (int ai = 0; ai < 2; ++ai)
#pragma unroll
            for (int m = 0; m < 4; ++m)
#pragma unroll
                for (int bj = 0; bj < 2; ++bj) { float* p = base + (ai * HALF + m * 16) * 256 + bj * HALF; *(f32x4*)p = acc[ai][bj][m][0]; *(f32x4*)(p + 4) = acc[ai][bj][m][1]; }
    }
};
template <class Epi, class Sched, bool ALIGN_EPI = false, bool SP2 = false>
__device__ __forceinline__ void gemm_phase(PG8_LAS unsigned char* lds, const Gemm g, const Sched& S, const Epi& E) {
    const int tid = threadIdx.x, wid = __builtin_amdgcn_readfirstlane(tid >> 6), lane = tid & 63, wr = wid >> 2, wc = wid & 3, fr = lane & 15, fq = lane >> 4;
    const int K = g.K;
    unsigned voffA[2], voffB[2];
#pragma unroll
    for (int i = 0; i < 2; ++i) { int R, C; stage_rc(tid * 16 + i * 8192, R, C); const int Rb = Epi::PERM ? ((R & ~31) + perm32(R & 31)) : R;
        voffA[i] = (unsigned)(R * K + C) * 2u; voffB[i] = (unsigned)(Rb * K + C) * 2u; }
    const size_t kstep = (size_t)(BK * 2);
    const size_t hstep = (size_t)HALF * K * 2;
    const size_t tstep = 2 * hstep;
    const unsigned ldsw = (unsigned)wid * 1024u;
    const int aoff = lds_byte(wr * 64 + fr, fq * 8), boff = lds_byte(wc * 32 + fr, fq * 8);
#define PG8_SA(b, h) (((b) * 2 + (h)) * HTB)
#define PG8_SB(b, h) ((4 + (b) * 2 + (h)) * HTB)
#define PG8_STAGE(bufoff, gbase, voff) do { _Pragma("unroll") for (int _i = 0; _i < 2; ++_i) \
        __builtin_amdgcn_global_load_lds((const unsigned*)((const char*)(gbase) + (voff)[_i]), (PG8_LAS unsigned*)(lds + (bufoff) + ldsw + _i * 8192), 16, 0, 0); } while (0)
#define PG8_LDA(dst, b, h) do { _Pragma("unroll") for (int m = 0; m < 4; ++m) _Pragma("unroll") for (int k = 0; k < 2; ++k) dst[m][k] = *(const PG8_LAS bf16x8*)(lds + PG8_SA(b, h) + aoff + m * 2048 + k * 1024); } while (0)
#define PG8_LDB(dst, b, h) do { _Pragma("unroll") for (int n = 0; n < 2; ++n) _Pragma("unroll") for (int k = 0; k < 2; ++k) dst[n][k] = *(const PG8_LAS bf16x8*)(lds + PG8_SB(b, h) + boff + n * 2048 + k * 1024); } while (0)
#define PG8_MMA(ai, bj, At, Bt) do { __builtin_amdgcn_s_setprio(1); _Pragma("unroll") for (int m = 0; m < 4; ++m) _Pragma("unroll") for (int n = 0; n < 2; ++n) _Pragma("unroll") for (int k = 0; k < 2; ++k) \
        acc[ai][bj][m][n] = __builtin_amdgcn_mfma_f32_16x16x32_bf16(Bt[n][k], At[m][k], acc[ai][bj][m][n], 0, 0, 0); __builtin_amdgcn_s_setprio(0); } while (0)
#define PG8_WAIT_V(n) asm volatile("s_waitcnt vmcnt(" #n ")" ::: "memory")
#define PG8_WAIT_L(n) asm volatile("s_waitcnt lgkmcnt(" #n ")" ::: "memory")
#define PG8_BAR __builtin_amdgcn_s_barrier()
#define PG8_SCHED __builtin_amdgcn_sched_barrier(0)
    Unit cur, nxt; int ui = 0;
    if (!S.next(0, cur)) return;
    f32x4 acc[2][2][4][2];
#pragma unroll
    for (int a = 0; a < 2; ++a)
#pragma unroll
        for (int b = 0; b < 2; ++b)
#pragma unroll
            for (int m = 0; m < 4; ++m)
#pragma unroll
                for (int n = 0; n < 2; ++n) acc[a][b][m][n] = (f32x4){0.f, 0.f, 0.f, 0.f};
    bf16x8 At[4][2], B0[2][2], B1[2][2];
    int nt = K / BK / cur.ns; const size_t koff = (size_t)cur.ks * nt * kstep;
    const char* cA = (const char*)g.A + (size_t)cur.pm * tstep + koff; const char* cB = (const char*)g.Bt + (size_t)cur.pn * tstep + koff;
    S.a_ready(cur);
    if constexpr (SP2) {
        PG8_STAGE(PG8_SB(0, 0), cB, voffB); PG8_STAGE(PG8_SB(0, 1), cB + hstep, voffB); PG8_STAGE(PG8_SA(0, 0), cA, voffA); PG8_STAGE(PG8_SA(0, 1), cA + hstep, voffA);
        if (wr == 1) PG8_BAR;
        PG8_WAIT_V(2); PG8_BAR;
        PG8_STAGE(PG8_SB(1, 0), cB + kstep, voffB); PG8_STAGE(PG8_SA(1, 0), cA + kstep, voffA); PG8_STAGE(PG8_SB(1, 1), cB + hstep + kstep, voffB);
        PG8_WAIT_V(6); PG8_BAR;
    } else {
        PG8_STAGE(PG8_SB(0, 0), cB, voffB); PG8_STAGE(PG8_SA(0, 0), cA, voffA); PG8_STAGE(PG8_SB(0, 1), cB + hstep, voffB); PG8_STAGE(PG8_SA(0, 1), cA + hstep, voffA);
        if (wr == 1) PG8_BAR;
        PG8_WAIT_V(4); PG8_BAR;
        PG8_STAGE(PG8_SB(1, 0), cB + kstep, voffB); PG8_STAGE(PG8_SA(1, 0), cA + kstep, voffA); PG8_STAGE(PG8_SB(1, 1), cB + hstep + kstep, voffB);
        PG8_WAIT_V(6); PG8_BAR;
    }
    for (;;) {
        const bool has_next = S.next(ui + 1, nxt);
        const int nnt = has_next ? K / BK / nxt.ns : nt; const size_t nkoff = has_next ? (size_t)nxt.ks * nnt * kstep : 0;
        const char* nA = has_next ? (const char*)g.A + (size_t)nxt.pm * tstep + nkoff : cA; const char* nB = has_next ? (const char*)g.Bt + (size_t)nxt.pn * tstep + nkoff : cB;
        for (int t = 0; t < nt; t += 2) {
            const bool last = (t == nt - 2);
            const char* a1 = cA + (size_t)(t + 1) * kstep;
            const char* a2 = last ? nA : cA + (size_t)(t + 2) * kstep; const char* b2 = last ? nB : cB + (size_t)(t + 2) * kstep;
            const char* a3 = a2 + kstep; const char* b3 = b2 + kstep;
            if (last && has_next) S.a_ready(nxt);
            if constexpr (SP2) {
            PG8_LDB(B0, 0, 0); PG8_LDB(B1, 0, 1); PG8_SCHED; PG8_LDA(At, 0, 0); PG8_STAGE(PG8_SA(1, 1), a1 + hstep, voffA);
            PG8_WAIT_V(8); PG8_WAIT_L(0); PG8_BAR; PG8_MMA(0, 0, At, B0); PG8_MMA(0, 1, At, B1); PG8_BAR; PG8_SCHED;
            PG8_LDA(At, 0, 1); PG8_STAGE(PG8_SB(0, 0), b2, voffB); PG8_STAGE(PG8_SB(0, 1), b2 + hstep, voffB); PG8_STAGE(PG8_SA(0, 0), a2, voffA);
            PG8_WAIT_V(8); PG8_WAIT_L(0); PG8_BAR; PG8_MMA(1, 0, At, B0); PG8_MMA(1, 1, At, B1); PG8_BAR; PG8_SCHED;
            PG8_LDB(B0, 1, 0); PG8_LDB(B1, 1, 1); PG8_SCHED; PG8_LDA(At, 1, 0); PG8_STAGE(PG8_SA(0, 1), a2 + hstep, voffA);
            PG8_WAIT_V(8); PG8_WAIT_L(0); PG8_BAR; PG8_MMA(0, 0, At, B0); PG8_MMA(0, 1, At, B1); PG8_BAR; PG8_SCHED;
            PG8_LDA(At, 1, 1); PG8_STAGE(PG8_SB(1, 0), b3, voffB); PG8_STAGE(PG8_SB(1, 1), b3 + hstep, voffB); PG8_STAGE(PG8_SA(1, 0), a3, voffA);
            PG8_WAIT_V(8); PG8_WAIT_L(0); PG8_BAR; PG8_MMA(1, 0, At, B0); PG8_MMA(1, 1, At, B1); PG8_BAR; PG8_SCHED;
            } else {
            PG8_LDB(B0, 0, 0); PG8_SCHED; PG8_LDA(At, 0, 0); PG8_STAGE(PG8_SA(1, 1), a1 + hstep, voffA);
            PG8_WAIT_L(8); PG8_BAR; PG8_WAIT_L(0); PG8_MMA(0, 0, At, B0); PG8_BAR; PG8_SCHED;
            PG8_LDB(B1, 0, 1); PG8_STAGE(PG8_SB(0, 0), b2, voffB);
            PG8_BAR; PG8_WAIT_L(0); PG8_MMA(0, 1, At, B1); PG8_BAR;
            PG8_LDA(At, 0, 1); PG8_STAGE(PG8_SA(0, 0), a2, voffA);
            PG8_BAR; PG8_WAIT_L(0); PG8_MMA(1, 0, At, B0); PG8_BAR; PG8_SCHED;
            PG8_STAGE(PG8_SB(0, 1), b2 + hstep, voffB);
            PG8_WAIT_V(6); PG8_BAR; PG8_MMA(1, 1, At, B1); PG8_BAR;
            PG8_LDB(B0, 1, 0); PG8_SCHED; PG8_LDA(At, 1, 0); PG8_STAGE(PG8_SA(0, 1), a2 + hstep, voffA);
            PG8_WAIT_L(8); PG8_BAR; PG8_WAIT_L(0); PG8_MMA(0, 0, At, B0); PG8_BAR; PG8_SCHED;
            PG8_LDB(B1, 1, 1); PG8_STAGE(PG8_SB(1, 0), b3, voffB);
            PG8_BAR; PG8_WAIT_L(0); PG8_MMA(0, 1, At, B1); PG8_BAR;
            PG8_LDA(At, 1, 1); PG8_STAGE(PG8_SA(1, 0), a3, voffA);
            PG8_BAR; PG8_WAIT_L(0); PG8_MMA(1, 0, At, B0); PG8_BAR; PG8_SCHED;
            PG8_STAGE(PG8_SB(1, 1), b3 + hstep, voffB);
            PG8_WAIT_V(6); PG8_BAR; PG8_MMA(1, 1, At, B1); PG8_BAR;
            }
        }
        if constexpr (ALIGN_EPI) { if (wr == 0) PG8_BAR; }
        if constexpr (!Epi::AFTER_DRAIN) { E(acc, cur, wr, wc, fr, fq); S.done(cur); }
        if (!has_next) break;
#pragma unroll
        for (int a = 0; a < 2; ++a)
#pragma unroll
            for (int b = 0; b < 2; ++b)
#pragma unroll
                for (int m = 0; m < 4; ++m)
#pragma unroll
                    for (int n = 0; n < 2; ++n) acc[a][b][m][n] = (f32x4){0.f, 0.f, 0.f, 0.f};
        cur = nxt; cA = nA; cB = nB; nt = nnt; ++ui;
        if constexpr (ALIGN_EPI) { if (wr == 1) PG8_BAR; }
    }
    PG8_WAIT_V(0);
    if constexpr (!ALIGN_EPI) { if (wr == 0) PG8_BAR; }
    PG8_BAR;
    if constexpr (Epi::AFTER_DRAIN) { E.fused(acc, cur, wr, wc, fr, fq, lds, wid, lane); S.done(cur); }
#undef PG8_SA
#undef PG8_SB
#undef PG8_STAGE
#undef PG8_LDA
#undef PG8_LDB
#undef PG8_MMA
#undef PG8_WAIT_V
#undef PG8_WAIT_L
#undef PG8_BAR
#undef PG8_SCHED
}
}
#ifndef PG8_SP2
#define PG8_SP2 true
#endif
#ifndef PG8_ALIGN
#define PG8_ALIGN true
#endif
#ifndef PROBE_REP
#define PROBE_REP -1
#endif
#ifndef REP_A
#define REP_A 1
#endif
#ifndef STAGGER_US1
#define STAGGER_US1 7
#define STAGGER_US5 9
#endif
#ifndef REP_G1
#define REP_G1 1
#endif
#ifndef REP_G4
#define REP_G4 1
#endif
#ifndef REP_G5
#define REP_G5 1
#endif
#ifndef REP_P0
#define REP_P0 1
#endif
#ifndef REP_B
#define REP_B 1
#endif
#ifndef REP_C
#define REP_C 1
#endif
#ifndef PROBE_P2MASK
#define PROBE_P2MASK 0
#endif
#ifndef MK_N_LAUNCHES
#define MK_N_LAUNCHES 1
#endif

constexpr int D = 1024, FF = 4096, NIN = 3072;
constexpr int MP = 8 * 8192, MS = 128 * 8, M = MP + MS;
constexpr int TP = 8192;
constexpr float EPS = 1e-6f;
constexpr int NWAVES = 8;
#define GAS __attribute__((address_space(1)))
#define LAS __attribute__((address_space(3)))
typedef unsigned short bf16;
typedef unsigned v4u __attribute__((ext_vector_type(4)));
typedef unsigned v2u __attribute__((ext_vector_type(2)));
typedef float f32x4 __attribute__((ext_vector_type(4)));
typedef short bf16x8 __attribute__((ext_vector_type(8)));
typedef short s16x4 __attribute__((ext_vector_type(4)));
typedef float f32x16 __attribute__((ext_vector_type(16)));

constexpr size_t MiB = 1u << 20;
constexpr size_t WS_WIN = 0, WS_WOUT = 6 * MiB, WS_WUP = 8 * MiB, WS_WDN = 16 * MiB;
constexpr size_t WS_RSTD0 = 24 * MiB;
constexpr size_t WS_ST1 = 25 * MiB, WS_ST2 = 30 * MiB;
constexpr size_t WS_LSE = 35 * MiB;
constexpr size_t WS_XB = 40 * MiB;
constexpr size_t WS_PROJ = 172 * MiB;
constexpr size_t WS_MIX = 564 * MiB;
constexpr size_t WS_HB = 696 * MiB;
constexpr size_t WS_QKVP = 1220 * MiB;
constexpr size_t WS_PART = 1510 * MiB;
constexpr size_t WS_BAR = 38 * MiB + 512 * 1024, WS_BAR_BYTES = 16384;
constexpr size_t WS_CNT = 39 * MiB;
constexpr size_t WS_END = 1592 * MiB;
static_assert(WS_XB + (size_t)M * D * 2 <= WS_PROJ && WS_PROJ + (size_t)M * NIN * 2 <= WS_MIX && WS_MIX + (size_t)M * D * 2 <= WS_HB && WS_HB + (size_t)M * FF * 2 <= WS_END, "d_ws map");
static_assert(WS_ST1 + (size_t)M * 64 <= WS_ST2 && WS_ST2 + (size_t)M * 64 <= WS_LSE && WS_LSE + (size_t)M * 48 <= WS_XB, "d_ws map 2");

constexpr size_t O_Y = 0;
constexpr size_t O_KVP0 = (size_t)M * D;
constexpr size_t O_KVP1 = O_KVP0 + 8ull * 128 * 512;
constexpr size_t O_KVP2 = O_KVP1 + 8ull * 512 * 512;
constexpr size_t O_CVP = O_KVP2 + 8ull * 2048 * 512;
constexpr size_t O_KVS0 = O_CVP + 8ull * 2 * 256;
constexpr size_t O_KVS1 = O_KVS0 + 128ull * 128 * 512;
constexpr size_t O_KVS2 = O_KVS1 + 128ull * 512 * 512;
constexpr size_t O_CVS = O_KVS2 + 128ull * 2048 * 512;
constexpr size_t O_END = O_CVS + 128ull * 2 * 256;

constexpr int P6_SPLIT = 16;
constexpr int LDS_BYTES = 163840;

__device__ __forceinline__ unsigned f2bf(float f) { unsigned u = __builtin_bit_cast(unsigned, f); return (u + 0x7fffu + ((u >> 16) & 1u)) >> 16; }
__device__ __forceinline__ unsigned pk2(float lo, float hi) { return f2bf(lo) | (f2bf(hi) << 16); }
__device__ __forceinline__ float bflo(unsigned w) { return __builtin_bit_cast(float, w << 16); }
__device__ __forceinline__ float bfhi(unsigned w) { return __builtin_bit_cast(float, w & 0xffff0000u); }
__device__ __forceinline__ float wave_sum(float v) {
#pragma unroll
    for (int o = 1; o < 64; o <<= 1) v += __shfl_xor(v, o);
    return v;
}

__device__ __forceinline__ unsigned att_cvtpk(float lo, float hi) { typedef float f2 __attribute__((ext_vector_type(2))); typedef __bf16 b2 __attribute__((ext_vector_type(2))); f2 v = {lo, hi}; b2 b = __builtin_convertvector(v, b2); return __builtin_bit_cast(unsigned, b); }
__device__ __forceinline__ const float* pick3(int g, const float* a, const float* b, const float* c) { return g == 0 ? a : (g == 1 ? b : c); }
struct Frame {
    LAS unsigned char* lds;
    int tid, lane, wave, vcu, G;
    const float *xp, *xs, *c0, *c1, *c2, *sconv, *g_attn, *w_in, *conv_w, *w_out, *g_mlp, *w_up, *w_down, *g_fin;
    float* out;
    bf16 *Win_t, *Wout_t, *Wup_t, *Wdn_t, *XB, *PROJ, *MIX, *HB, *QKVP;
    float *RSTD0, *ST1, *ST2, *LSE, *PART; unsigned* CNT;
};

__device__ __forceinline__ void p0_transpose_item(const float* W, const float* gk, int K, int N, bf16* WT, LAS float* scr, int item, int lane) {
    const int nblk = N / 32, kb = item / nblk, nb = item % nblk, k0 = 64 * kb, n0 = 32 * nb;
#pragma unroll 8
    for (int i = 0; i < 32; ++i) { const int kk = 2 * i + (lane >> 5); float v = W[(size_t)(k0 + kk) * N + n0 + (lane & 31)]; if (gk) v *= gk[k0 + kk]; scr[kk * 33 + (lane & 31)] = v; }
    asm volatile("s_waitcnt lgkmcnt(0)" ::: "memory");
    const int c = lane & 7;
#pragma unroll
    for (int j = 0; j < 4; ++j) { const int n = (lane >> 3) + 8 * j; const LAS float* s = scr + (8 * c) * 33 + n;
        v4u o; o.x = pk2(s[0 * 33], s[1 * 33]); o.y = pk2(s[2 * 33], s[3 * 33]); o.z = pk2(s[4 * 33], s[5 * 33]); o.w = pk2(s[6 * 33], s[7 * 33]);
        *(v4u*)(WT + (size_t)(n0 + n) * K + k0 + 8 * c) = o; }
    asm volatile("s_waitcnt lgkmcnt(0)" ::: "memory");
}
__device__ __forceinline__ void p0_prologue(Frame& F) {
    LAS float* scr = (LAS float*)(F.lds + F.wave * 16384);
    const int gw = F.vcu * NWAVES + F.wave, NGW = F.G * NWAVES;
    constexpr int I_IN = (D / 64) * (NIN / 32), I_O = (D / 64) * (D / 32), I_UP = (D / 64) * (FF / 32), I_DN = (FF / 64) * (D / 32);
    constexpr int NITEMS = I_IN + I_O + I_UP + I_DN;
    for (int it = gw; it < NITEMS; it += NGW) {
        int r = it;
        if (r < I_IN) { p0_transpose_item(F.w_in, F.g_attn, D, NIN, F.Win_t, scr, r, F.lane); continue; } r -= I_IN;
        if (r < I_O) { p0_transpose_item(F.w_out, nullptr, D, D, F.Wout_t, scr, r, F.lane); continue; } r -= I_O;
        if (r < I_UP) { p0_transpose_item(F.w_up, F.g_mlp, D, FF, F.Wup_t, scr, r, F.lane); continue; } r -= I_UP;
        p0_transpose_item(F.w_down, nullptr, FF, D, F.Wdn_t, scr, r, F.lane);
    }
    for (int m0_ = gw * 4; m0_ < M * REP_P0; m0_ += NGW * 4) { const int m0 = m0_ % M;
        const float* xrow = m0 < MP ? F.xp + (size_t)m0 * D : F.xs + (size_t)(m0 - MP) * D;
        f32x4 v[4][4]; float s[4];
#pragma unroll
        for (int r = 0; r < 4; ++r)
#pragma unroll
            for (int j = 0; j < 4; ++j) v[r][j] = ((const f32x4*)(xrow + (size_t)r * D))[F.lane + 64 * j];
#pragma unroll
        for (int r = 0; r < 4; ++r) { float t = 0.f;
#pragma unroll
            for (int j = 0; j < 4; ++j) t += (v[r][j].x * v[r][j].x + v[r][j].y * v[r][j].y) + (v[r][j].z * v[r][j].z + v[r][j].w * v[r][j].w);
            s[r] = wave_sum(t); }
#pragma unroll
        for (int r = 0; r < 4; ++r) { v2u* o8 = (v2u*)(F.XB + (size_t)(m0 + r) * D) + F.lane;
#pragma unroll
            for (int j = 0; j < 4; ++j) { v2u w; w.x = att_cvtpk(v[r][j].x, v[r][j].y); w.y = att_cvtpk(v[r][j].z, v[r][j].w); o8[64 * j] = w; }
            if (F.lane == 0) F.RSTD0[m0 + r] = __builtin_amdgcn_rsqf(s[r] * (1.0f / D) + EPS); }
    }
}

namespace att {
constexpr int VP = 128;
constexpr int WTILE = 160 * VP;
constexpr float C2 = 0.125f * 1.4426950408889634f;
typedef __amdgpu_buffer_rsrc_t rsrc_t;
__device__ __forceinline__ rsrc_t mk_rsrc(const void* p) { return __builtin_amdgcn_make_buffer_rsrc((void*)p, 0, 0x7fffffff, 0x00020000); }
__device__ __forceinline__ v4u bld16(rsrc_t r, int voff, int soff) { return __builtin_amdgcn_raw_buffer_load_b128(r, voff, soff, 0); }
__device__ __forceinline__ v2u bld8(rsrc_t r, int voff, int soff) { return __builtin_amdgcn_raw_buffer_load_b64(r, voff, soff, 0); }
__device__ __forceinline__ int crow(int r, int hi) { return (r & 3) + 8 * (r >> 2) + 4 * hi; }
__device__ __forceinline__ s16x4 vtr(const LAS unsigned char* p) { return __builtin_bit_cast(s16x4, __builtin_amdgcn_ds_read_tr16_b64_v4i16((LAS s16x4*)p)); }
__device__ __forceinline__ unsigned cvtpk(float lo, float hi) { typedef float f2 __attribute__((ext_vector_type(2))); typedef __bf16 b2 __attribute__((ext_vector_type(2))); f2 v = {lo, hi}; b2 b = __builtin_convertvector(v, b2); return __builtin_bit_cast(unsigned, b); }

__device__ __forceinline__ void prompt_tile(const rsrc_t rp, bf16* __restrict__ mixed, float* __restrict__ lse, LAS unsigned char* wl, int b, int g, int h, int r, int j, int lane_in) {
    int lane = lane_in; asm volatile("" : "+v"(lane));
    const int a = lane & 31, hi = lane >> 5, s = 2 * g, qs = 32 * j, rowb = b * TP, colq = g * 256 + h * 64, l8 = lane >> 3, c8 = lane & 7;
    const int L = TP >> s, vo = lane * 16;
    const int bq = (((g * 4 + h) * 8 + b) * TP + r * L + qs) * 128, bk = bq + 3 * 4 * 8 * TP * 128 - 128 * 128, bv = bk + 3 * 4 * 8 * TP * 128;
    v4u qraw[4], kraw[20], va[12], vb[8];
#pragma unroll
    for (int i = 0; i < 4; ++i) qraw[i] = bld16(rp, vo, bq + i * 1024);
#pragma unroll
    for (int i = 0; i < 20; ++i) kraw[i] = bld16(rp, vo, bk + i * 1024);
    const int wsw = l8 * VP + ((c8 ^ l8) * 16), rsw = a * VP;
#pragma unroll
    for (int i = 0; i < 4; ++i) *(LAS v4u*)(wl + 8 * i * VP + wsw) = qraw[i];
    bf16x8 qf[4];
#pragma unroll
    for (int d0 = 0; d0 < 4; ++d0) qf[d0] = *(const LAS bf16x8*)(wl + rsw + (((2 * d0 + hi) ^ (a & 7)) * 16));
#pragma unroll
    for (int i = 0; i < 20; ++i) *(LAS v4u*)(wl + 8 * i * VP + wsw) = kraw[i];
    asm volatile("" ::: "memory");
#pragma unroll
    for (int i = 0; i < 12; ++i) va[i] = bld16(rp, vo, bv + i * 1024);
    f32x16 S[5];
#pragma unroll
    for (int kb = 0; kb < 5; ++kb) { f32x16 acc = {};
#pragma unroll
        for (int d0 = 0; d0 < 4; ++d0) { const bf16x8 kf = *(const LAS bf16x8*)(wl + 32 * kb * VP + rsw + (((2 * d0 + hi) ^ (a & 7)) * 16)); acc = __builtin_amdgcn_mfma_f32_32x32x16_bf16(kf, qf[d0], acc, 0, 0, 0); }
        S[kb] = acc; }
    asm volatile("" ::: "memory");
#pragma unroll
    for (int i = 0; i < 8; ++i) vb[i] = bld16(rp, vo, bv + (12 + i) * 1024);
    float mr = -INFINITY; float bias[5];
#pragma unroll
    for (int kb = 0; kb < 5; ++kb) { const bool bv = (qs - 128 + 32 * kb) >= 0; bias[kb] = bv ? 0.f : -INFINITY; float bm = -INFINITY;
#pragma unroll
        for (int rr = 0; rr < 16; ++rr) { const int key = crow(rr, hi); float v = S[kb][rr];
            if (kb == 0) { v = key >= a ? v : -INFINITY; S[kb][rr] = v; } if (kb == 4) { v = key <= a ? v : -INFINITY; S[kb][rr] = v; }
            bm = fmaxf(bm, v); }
        mr = bv ? fmaxf(mr, bm) : mr; }
    mr = fmaxf(mr, __shfl_xor(mr, 32));
    const float mxs = mr * C2;
    float l = 0.f; v4u pw[5][2];
#pragma unroll
    for (int kb = 0; kb < 5; ++kb) { const float nb = bias[kb] - mxs; float p[16];
#pragma unroll
        for (int rr = 0; rr < 16; ++rr) { p[rr] = __builtin_amdgcn_exp2f(__builtin_fmaf(S[kb][rr], C2, nb)); l += p[rr]; }
#pragma unroll
        for (int st = 0; st < 2; ++st) { pw[kb][st].x = cvtpk(p[8 * st + 0], p[8 * st + 1]); pw[kb][st].y = cvtpk(p[8 * st + 2], p[8 * st + 3]); pw[kb][st].z = cvtpk(p[8 * st + 4], p[8 * st + 5]); pw[kb][st].w = cvtpk(p[8 * st + 6], p[8 * st + 7]); } }
    l += __shfl_xor(l, 32);
#pragma unroll
    for (int i = 0; i < 12; ++i) *(LAS v4u*)(wl + (8 * i + l8) * VP + c8 * 16) = va[i];
    f32x16 o[2]; o[0] = f32x16{}; o[1] = f32x16{};
    const LAS unsigned char* vbase = wl + (4 * hi + ((lane & 15) >> 2)) * VP + (16 * ((lane >> 4) & 1) + 4 * (lane & 3)) * 2;
#pragma unroll
    for (int kb = 0; kb < 5; ++kb) {
        if (kb == 3) {
#pragma unroll
            for (int i = 0; i < 8; ++i) *(LAS v4u*)(wl + (96 + 8 * i + l8) * VP + c8 * 16) = vb[i]; }
#pragma unroll
        for (int st = 0; st < 2; ++st) {
            const bf16x8 pa = __builtin_bit_cast(bf16x8, pw[kb][st]);
#pragma unroll
            for (int cc = 0; cc < 2; ++cc) {
                const s16x4 lo = vtr(vbase + (32 * kb + 16 * st) * VP + cc * 64), hh = vtr(vbase + (32 * kb + 16 * st + 8) * VP + cc * 64);
                const bf16x8 vf = (bf16x8){lo[0], lo[1], lo[2], lo[3], hh[0], hh[1], hh[2], hh[3]};
                o[cc] = __builtin_amdgcn_mfma_f32_32x32x16_bf16(pa, vf, o[cc], 0, 0, 0);
            }
        }
    }
    const float linv = 1.0f / l;
#pragma unroll
    for (int rr = 0; rr < 16; ++rr) { const int q = crow(rr, hi); const float li = __shfl(linv, q);
        const unsigned w = cvtpk(o[0][rr] * li, o[1][rr] * li); LAS bf16* op = (LAS bf16*)(wl + q * VP) + a; op[0] = (bf16)(w & 0xffffu); op[32] = (bf16)(w >> 16); }
#pragma unroll
    for (int i = 0; i < 4; ++i) { const v4u ov = *(const LAS v4u*)(wl + (8 * i + l8) * VP + c8 * 16);
        *(v4u*)(mixed + (size_t)(rowb + ((qs + 8 * i + l8) << s) + r) * D + colq + c8 * 8) = ov; }
    if (hi == 0) lse[(size_t)(rowb + ((qs + a) << s) + r) * 12 + g * 4 + h] = mxs + __builtin_amdgcn_logf(l);
}

__device__ __forceinline__ f32x4 kv_row(const rsrc_t rc, const rsrc_t rp, bool maybe_new, int W, int b, int idx, int sel, int g, int h, int c) {
    if (maybe_new) { const bool nw = idx >= W; const int idc = nw ? W - 1 : idx;
        const f32x4 cv = __builtin_bit_cast(f32x4, bld16(rc, ((b * W + idc) * 2 + sel) * 1024 + (h * 64 + 4 * c) * 4, 0));
        const v2u pw = bld8(rp, (MP + b * 8 + (nw ? idx - W : 0)) * (NIN * 2) + (768 + sel * 768 + g * 256 + h * 64 + 4 * c) * 2, 0);
        const f32x4 pv = {bflo(pw.x), bfhi(pw.x), bflo(pw.y), bfhi(pw.y)};
        return nw ? pv : cv; }
    return __builtin_bit_cast(f32x4, bld16(rc, ((b * W + idx) * 2 + sel) * 1024 + (h * 64 + 4 * c) * 4, 0));
}
__device__ __forceinline__ void sample_group(Frame& F, const rsrc_t rp, int b, int g, int h, int t, const int lane_in, f32x4& o_out, float& lse_out, float* kvout) {
    int lane = lane_in; asm volatile("" : "+v"(lane));
    const int rg = lane >> 4, c = lane & 15;
    const int W = 128 << (2 * g), sh = 2 * g;
    const rsrc_t rc = mk_rsrc(pick3(g, F.c0, F.c1, F.c2));
    const int qrow = MP + b * 8 + t;
    f32x4 q; { const v2u w = bld8(rp, qrow * (NIN * 2) + (g * 256 + h * 64 + 4 * c) * 2, 0); q = (f32x4){bflo(w.x), bfhi(w.x), bflo(w.y), bfhi(w.y)}; }
    f32x4 kv[33]; float sc[33];
    const bool cpy = t < (1 << (g + (g > 0 ? 1 : 0)));
    const rsrc_t ro = mk_rsrc(kvout); const int vo0 = (((b * W + W + t - 8 - (rg << sh)) * 2) * 256 + h * 64 + 4 * c) * 4, vstr = (4 << sh) * 2048;
#pragma unroll
    for (int i0 = 0; i0 < 33; i0 += 33) {
        asm volatile("" ::: "memory");
#pragma unroll
        for (int i = i0; i < i0 + 33 && i < 33; ++i) { int j = 4 * i + rg; j = j > 128 ? 128 : j; kv[i] = kv_row(rc, rp, i < 2, W, b, W + t - (j << sh), 0, g, h, c); }
#pragma unroll
        for (int i = i0; i < i0 + 33 && i < 33; ++i) { float p = (kv[i][0] * q[0] + kv[i][1] * q[1]) + (kv[i][2] * q[2] + kv[i][3] * q[3]);
            p += __shfl_xor(p, 1); p += __shfl_xor(p, 2); p += __shfl_xor(p, 4); p += __shfl_xor(p, 8);
            sc[i] = (4 * i + rg) <= 128 ? p * C2 : -INFINITY;
            { const int j = 4 * i + rg, idx = W + t - (j << sh); if (cpy && j <= 128 && idx >= 8 && idx < W) __builtin_amdgcn_raw_buffer_store_b128(__builtin_bit_cast(v4u, kv[i]), ro, vo0 - i * vstr, 0, 0); } } }
    float mx = sc[0];
#pragma unroll
    for (int i = 1; i < 33; ++i) mx = fmaxf(mx, sc[i]);
    mx = fmaxf(mx, __shfl_xor(mx, 16)); mx = fmaxf(mx, __shfl_xor(mx, 32));
    float l = 0.f;
#pragma unroll
    for (int i = 0; i < 33; ++i) { sc[i] = __builtin_amdgcn_exp2f(sc[i] - mx); l += sc[i]; }
    l += __shfl_xor(l, 16); l += __shfl_xor(l, 32);
    f32x4 o = {0.f, 0.f, 0.f, 0.f};
#pragma unroll
    for (int i0 = 0; i0 < 33; i0 += 33) {
        asm volatile("" ::: "memory");
#pragma unroll
        for (int i = i0; i < i0 + 33 && i < 33; ++i) { int j = 4 * i + rg; j = j > 128 ? 128 : j; kv[i] = kv_row(rc, rp, i < 2, W, b, W + t - (j << sh), 1, g, h, c); }
#pragma unroll
        for (int i = i0; i < i0 + 33 && i < 33; ++i) { o += kv[i] * sc[i];
            const int j = 4 * i + rg, idx = W + t - (j << sh); if (cpy && j <= 128 && idx >= 8 && idx < W) __builtin_amdgcn_raw_buffer_store_b128(__builtin_bit_cast(v4u, kv[i]), ro, vo0 - i * vstr + 1024, 0, 0); } }
#pragma unroll
    for (int e = 0; e < 4; ++e) { float v = o[e]; v += __shfl_xor(v, 16); v += __shfl_xor(v, 32); o[e] = v; }
    const float li = 1.0f / l;
    o_out = o * li; lse_out = mx + __builtin_amdgcn_logf(l);
}
__device__ __forceinline__ void sample_step(Frame& F, const rsrc_t rp, int task, int g, const int lane) {
    const int t = task & 7, h = (task >> 3) & 3, b = task >> 5, rg = lane >> 4, c = lane & 15;
    float* scr = F.PART + (size_t)task * 1024;
    f32x4 o; float ls; sample_group(F, rp, b, g, h, t, lane, o, ls, F.out + (g == 0 ? O_KVS0 : (g == 1 ? O_KVS1 : O_KVS2)));
    if (g < 2) { ((f32x4*)scr)[g * 64 + lane] = o; scr[768 + g * 64 + lane] = ls; return; }
    f32x4 o0 = ((const f32x4*)scr)[lane], o1 = ((const f32x4*)scr)[64 + lane], o2 = o;
    const float l0 = scr[768 + lane], l1 = scr[768 + 64 + lane], l2 = ls;
    const float mx = fmaxf(l0, fmaxf(l1, l2)); const float e0 = __builtin_amdgcn_exp2f(l0 - mx), e1 = __builtin_amdgcn_exp2f(l1 - mx), e2 = __builtin_amdgcn_exp2f(l2 - mx);
    const float inv = 1.0f / (e0 + e1 + e2);
    o0 = o0 * (e0 * inv); o1 = o1 * (e1 * inv); o2 = o2 * (e2 * inv);
    if (rg == 0) { bf16* op = F.MIX + (size_t)(MP + b * 8 + t) * D + h * 64 + 4 * c; v2u w;
        w.x = cvtpk(o0[0], o0[1]); w.y = cvtpk(o0[2], o0[3]); *(v2u*)(op) = w;
        w.x = cvtpk(o1[0], o1[1]); w.y = cvtpk(o1[2], o1[3]); *(v2u*)(op + 256) = w;
        w.x = cvtpk(o2[0], o2[1]); w.y = cvtpk(o2[2], o2[3]); *(v2u*)(op + 512) = w; }
}
}

__device__ __forceinline__ void unpack8(const v4u w, float (&f)[8]) { f[0] = bflo(w.x); f[1] = bfhi(w.x); f[2] = bflo(w.y); f[3] = bfhi(w.y); f[4] = bflo(w.z); f[5] = bfhi(w.z); f[6] = bflo(w.w); f[7] = bfhi(w.w); }
__device__ __forceinline__ void conv_u(const bf16* proj, size_t row, int ch, float (&u)[8]) {
    float cf[8], hf[8]; unpack8(*(const v4u*)(proj + row * NIN + 2560 + 8 * ch), cf); unpack8(*(const v4u*)(proj + row * NIN + 2816 + 8 * ch), hf);
#pragma unroll
    for (int e = 0; e < 8; ++e) u[e] = cf[e] * hf[e];
}
__device__ __forceinline__ void ld8f(const float* p, float (&u)[8]) { const f32x4 a = *(const f32x4*)p, b = *(const f32x4*)(p + 4); u[0] = a[0]; u[1] = a[1]; u[2] = a[2]; u[3] = a[3]; u[4] = b[0]; u[5] = b[1]; u[6] = b[2]; u[7] = b[3]; }

__device__ __forceinline__ void p2_mixers(Frame& F, const int mask) {
    int tid_ = F.tid; asm volatile("" : "+v"(tid_));
    const int lane_ = tid_ & 63;
    const int gt = F.vcu * (NWAVES * 64) + tid_, NGT = F.G * NWAVES * 64;
    const int gw = F.vcu * NWAVES + F.wave, NGW = F.G * NWAVES;
    const att::rsrc_t rp = att::mk_rsrc(F.PROJ), rq = att::mk_rsrc(F.QKVP);
    constexpr int NSTASK = 128 * 4 * 8; int sstep = 0; const int nsteps = gw < NSTASK ? 3 * ((NSTASK - gw + NGW - 1) / NGW) : 0;
    { LAS unsigned char* wl = F.lds + F.wave * att::WTILE;
      for (int su = F.vcu; su < 512 || sstep < nsteps; su += F.G) { const bool has_su = su < 512; const int b = su >> 6, h = (su >> 4) & 3, rg = su & 15;
#pragma unroll 1
        for (int i = 0; i < 6; ++i) { const int k = F.wave + 8 * i, g = k >> 4, kk = k & 15, tpr = 16 >> (2 * g), r = kk / tpr, j = rg * tpr + kk % tpr;
            if (has_su) att::prompt_tile(rq, F.MIX, F.LSE, wl, b, g, h, r, j, lane_);
            if ((i & 1) && sstep < nsteps) { att::sample_step(F, rp, gw + (sstep / 3) * NGW, sstep % 3, lane_); ++sstep; } }
        if (!has_su) continue;
        asm volatile("s_waitcnt vmcnt(0)" ::: "memory"); __syncthreads(); __builtin_amdgcn_fence(__ATOMIC_ACQUIRE, "workgroup");
        const size_t row0 = (size_t)b * TP + rg * 512;
#pragma unroll 1
        for (int i0 = 0; i0 < 8; i0 += 4) { float ls[4][3]; v4u mw[4][3];
#pragma unroll
            for (int k = 0; k < 4; ++k) { const int it = tid_ + 512 * (i0 + k), ch = it & 7; const size_t row = row0 + (it >> 3);
#pragma unroll
                for (int g = 0; g < 3; ++g) { ls[k][g] = F.LSE[row * 12 + 4 * g + h]; mw[k][g] = *(const v4u*)(F.MIX + row * D + g * 256 + h * 64 + 8 * ch); } }
#pragma unroll
            for (int k = 0; k < 4; ++k) { const int it = tid_ + 512 * (i0 + k), ch = it & 7; const size_t row = row0 + (it >> 3);
                const float mx = fmaxf(ls[k][0], fmaxf(ls[k][1], ls[k][2])); const float e0 = __builtin_amdgcn_exp2f(ls[k][0] - mx), e1 = __builtin_amdgcn_exp2f(ls[k][1] - mx), e2 = __builtin_amdgcn_exp2f(ls[k][2] - mx);
                const float inv = 1.0f / (e0 + e1 + e2); const float al[3] = {e0 * inv, e1 * inv, e2 * inv};
#pragma unroll
                for (int g = 0; g < 3; ++g) { float f[8]; unpack8(mw[k][g], f);
                    v4u o; o.x = att::cvtpk(f[0] * al[g], f[1] * al[g]); o.y = att::cvtpk(f[2] * al[g], f[3] * al[g]); o.z = att::cvtpk(f[4] * al[g], f[5] * al[g]); o.w = att::cvtpk(f[6] * al[g], f[7] * al[g]);
                    *(v4u*)(F.MIX + row * D + g * 256 + h * 64 + 8 * ch) = o; } }
        }
      } }
    if (mask & 4) for (int it_ = gt; it_ < (M / 4) * 32 * REP_C; it_ += NGT) { const int it = it_ % ((M / 4) * 32);
        const int ch = it & 31, row0 = (it >> 5) * 4; const bool smp = row0 >= MP;
        const int t0 = smp ? ((row0 - MP) & 7) : (row0 & (TP - 1)), b = smp ? ((row0 - MP) >> 3) : (row0 >> 13);
        v4u cw[6], hw[6], bw[4];
#pragma unroll
        for (int k = 0; k < 6; ++k) { const int row = row0 - 2 + k; if (k >= 2 || t0 > 0) { cw[k] = *(const v4u*)(F.PROJ + (size_t)row * NIN + 2560 + 8 * ch); hw[k] = *(const v4u*)(F.PROJ + (size_t)row * NIN + 2816 + 8 * ch); } else { cw[k] = (v4u){0u, 0u, 0u, 0u}; hw[k] = cw[k]; } }
#pragma unroll
        for (int k = 0; k < 4; ++k) bw[k] = *(const v4u*)(F.PROJ + (size_t)(row0 + k) * NIN + 2304 + 8 * ch);
        float w0[8], w1[8], w2[8]; ld8f(F.conv_w + 8 * ch, w0); ld8f(F.conv_w + 256 + 8 * ch, w1); ld8f(F.conv_w + 512 + 8 * ch, w2);
        float u[6][8];
#pragma unroll
        for (int k = 0; k < 6; ++k) { float cf[8], hf[8]; unpack8(cw[k], cf); unpack8(hw[k], hf);
#pragma unroll
            for (int e = 0; e < 8; ++e) u[k][e] = cf[e] * hf[e]; }
        if (smp && t0 == 0) { ld8f(F.sconv + ((size_t)b * 2 + 0) * 256 + 8 * ch, u[0]); ld8f(F.sconv + ((size_t)b * 2 + 1) * 256 + 8 * ch, u[1]); }
#pragma unroll
        for (int k = 0; k < 4; ++k) { float bg[8], y[8]; unpack8(bw[k], bg);
#pragma unroll
            for (int e = 0; e < 8; ++e) y[e] = bg[e] * (w0[e] * u[k][e] + w1[e] * u[k + 1][e] + w2[e] * u[k + 2][e]);
            v4u o; o.x = att::cvtpk(y[0], y[1]); o.y = att::cvtpk(y[2], y[3]); o.z = att::cvtpk(y[4], y[5]); o.w = att::cvtpk(y[6], y[7]);
            *(v4u*)(F.MIX + (size_t)(row0 + k) * D + 768 + 8 * ch) = o; }
    }
    if (mask & 8) for (int g = 0; g < 3; ++g) {
        const int W = 128 << (2 * g); float* dst = F.out + (g == 0 ? O_KVP0 : (g == 1 ? O_KVP1 : O_KVP2));
        { const int NK = 8 * W * 64;
          for (int it0 = gt; it0 < NK; it0 += 4 * NGT) { v4u w[4];
#pragma unroll
            for (int k = 0; k < 4; ++k) { const int it = it0 + k * NGT; if (it < NK) { const int ch = it & 31, sel = (it >> 5) & 1, br = it >> 6, rr = br % W, b = br / W;
                const int t = TP - W + rr, sh = 2 * g, prow = (t & ((1 << sh) - 1)) * (TP >> sh) + (t >> sh);
                w[k] = *(const v4u*)(F.QKVP + ((size_t)(((((1 + sel) * 3 + g) * 4 + (ch >> 3)) * 8 + b) * TP + prow)) * 64 + 8 * (ch & 7)); } }
#pragma unroll
            for (int k = 0; k < 4; ++k) { const int it = it0 + k * NGT; if (it < NK) { float f[8]; unpack8(w[k], f);
                float* o = dst + (size_t)it * 8; *(f32x4*)o = (f32x4){f[0], f[1], f[2], f[3]}; *(f32x4*)(o + 4) = (f32x4){f[4], f[5], f[6], f[7]}; } } } }
        float* dsts = F.out + (g == 0 ? O_KVS0 : (g == 1 ? O_KVS1 : O_KVS2));
        for (int it = gt; it < 128 * 8 * 64; it += NGT) { const int ch = it & 31, sel = (it >> 5) & 1, bt = it >> 6, t = bt & 7, b = bt >> 3;
            float f[8]; unpack8(*(const v4u*)(F.PROJ + ((size_t)MP + b * 8 + t) * NIN + 768 + sel * 768 + g * 256 + 8 * ch), f);
            float* o = dsts + (((size_t)b * W + (W - 8 + t)) * 2 + sel) * 256 + 8 * ch; *(f32x4*)o = (f32x4){f[0], f[1], f[2], f[3]}; *(f32x4*)(o + 4) = (f32x4){f[4], f[5], f[6], f[7]}; }
    }
    for (int it = gt; it < 8 * 2 * 32; it += NGT) { const int ch = it & 31, j = (it >> 5) & 1, b = it >> 6; float u[8]; conv_u(F.PROJ, (size_t)b * TP + TP - 2 + j, ch, u);
        float* o = F.out + O_CVP + (size_t)it * 8; *(f32x4*)o = (f32x4){u[0], u[1], u[2], u[3]}; *(f32x4*)(o + 4) = (f32x4){u[4], u[5], u[6], u[7]}; }
    for (int it = gt; it < 128 * 2 * 32; it += NGT) { const int ch = it & 31, j = (it >> 5) & 1, b = it >> 6; float u[8]; conv_u(F.PROJ, (size_t)MP + b * 8 + 6 + j, ch, u);
        float* o = F.out + O_CVS + (size_t)it * 8; *(f32x4*)o = (f32x4){u[0], u[1], u[2], u[3]}; *(f32x4*)(o + 4) = (f32x4){u[4], u[5], u[6], u[7]}; }
}
__device__ __forceinline__ void p6_final(Frame& F) {
    const int gw = F.vcu * NWAVES + F.wave, NGW = F.G * NWAVES;
    f32x4 gf[4];
#pragma unroll
    for (int j = 0; j < 4; ++j) gf[j] = ((const f32x4*)F.g_fin)[2 * (F.lane + 64 * (j >> 1)) + (j & 1)];
    for (int m0 = gw * 4; m0 < M; m0 += NGW * 4) {
        float sp[4]; v4u v[4][2];
#pragma unroll
        for (int r = 0; r < 4; ++r) sp[r] = F.ST2[(size_t)(m0 + r) * 16 + (F.lane & 15)];
#pragma unroll
        for (int r = 0; r < 4; ++r)
#pragma unroll
            for (int j = 0; j < 2; ++j) v[r][j] = ((const v4u*)(F.MIX + (size_t)(m0 + r) * D))[F.lane + 64 * j];
#pragma unroll
        for (int r = 0; r < 4; ++r) { float ss = sp[r]; ss += __shfl_xor(ss, 1); ss += __shfl_xor(ss, 2); ss += __shfl_xor(ss, 4); ss += __shfl_xor(ss, 8);
            const float rstd = __builtin_amdgcn_rsqf(ss * (1.0f / D) + EPS);
#pragma unroll
            for (int j = 0; j < 2; ++j) { float f[8]; unpack8(v[r][j], f); f32x4* o = (f32x4*)(F.out + (size_t)(m0 + r) * D) + 2 * (F.lane + 64 * j);
                o[0] = (f32x4){f[0], f[1], f[2], f[3]} * rstd * gf[2 * j]; o[1] = (f32x4){f[4], f[5], f[6], f[7]} * rstd * gf[2 * j + 1]; } }
    }
}

__device__ __forceinline__ void p6_tail_reduce(Frame& F, const pg8::StaticOrder& S0, const int nfull, const int split) {
    const int gt = F.vcu * (NWAVES * 64) + F.tid, NGT = F.G * NWAVES * 64; const int ntail = S0.nwg - nfull;
    for (int it = gt; it < ntail * 256 * 32; it += NGT) {
        const int ch = it & 31, rw = (it >> 5) & 255, ti = it >> 13; pg8::Unit u; S0.tile(nfull + ti, u);
        const float* p = F.PART + (size_t)ti * split * 65536 + rw * 256 + ch * 8;
        f32x4 s0 = {0.f, 0.f, 0.f, 0.f}, s1 = s0;
#pragma unroll 1
        for (int k0 = 0; k0 < split; k0 += 8) { f32x4 a[8], b[8];
#pragma unroll
            for (int k = 0; k < 8; ++k) { const int kk = k0 + k < split ? k0 + k : 0; a[k] = *(const f32x4*)(p + (size_t)kk * 65536); b[k] = *(const f32x4*)(p + (size_t)kk * 65536 + 4); }
#pragma unroll
            for (int k = 0; k < 8; ++k) if (k0 + k < split) { s0 += a[k]; s1 += b[k]; } }
        const size_t row = (size_t)u.pm * 256 + rw; const size_t off = row * D + u.pn * 256 + ch * 8;
        float xr[8]; unpack8(*(const v4u*)(F.XB + off), xr);
        float o[8] = {s0[0] + xr[0], s0[1] + xr[1], s0[2] + xr[2], s0[3] + xr[3], s1[0] + xr[4], s1[1] + xr[5], s1[2] + xr[6], s1[3] + xr[7]};
        v4u w; w.x = att::cvtpk(o[0], o[1]); w.y = att::cvtpk(o[2], o[3]); w.z = att::cvtpk(o[4], o[5]); w.w = att::cvtpk(o[6], o[7]);
        *(v4u*)(F.MIX + off) = w;
        float ss = ((o[0] * o[0] + o[1] * o[1]) + (o[2] * o[2] + o[3] * o[3])) + ((o[4] * o[4] + o[5] * o[5]) + (o[6] * o[6] + o[7] * o[7]));
        ss += __shfl_xor(ss, 1); ss += __shfl_xor(ss, 2); ss += __shfl_xor(ss, 4); ss += __shfl_xor(ss, 8); ss += __shfl_xor(ss, 16);
        if (ch < 4) F.ST2[row * 16 + u.pn * 4 + ch] = ch == 0 ? ss : 0.f;
    }
}
__device__ __forceinline__ void tail_copy(Frame& F, int first, int count, int n_busy) {
    const int bid = (int)blockIdx.x; if (bid < n_busy) return;
    const int rank = bid - n_busy, nidle = F.G - n_busy, toff = F.tid * 16;
    const __amdgpu_buffer_rsrc_t rs_ = __builtin_amdgcn_make_buffer_rsrc((void*)F.c2, 0, 0x7fffffff, 0x00020000), rd_ = __builtin_amdgcn_make_buffer_rsrc((void*)(F.out + O_KVS2), 0, 0x7fffffff, 0x00020000);
    for (int k0 = rank * 4; k0 < count; k0 += nidle * 4) {
        v4u cp[8]; int dof[4];
#pragma unroll
        for (int k = 0; k < 4; ++k) { int blk = first + (k0 + k < count ? k0 + k : count - 1); blk = blk >= pg8::CP_NBLK ? pg8::CP_NBLK - 1 : blk; const int b = blk >> 7, q = blk & 127; dof[k] = ((b * 2048 + 16 * q) * 512) * 4;
            cp[2 * k] = __builtin_amdgcn_raw_buffer_load_b128(rs_, toff, dof[k] + 16384, 2); cp[2 * k + 1] = __builtin_amdgcn_raw_buffer_load_b128(rs_, toff, dof[k] + 16384 + 8192, 2); }
#pragma unroll
        for (int k = 0; k < 4; ++k) { __builtin_amdgcn_raw_buffer_store_b128(cp[2 * k], rd_, toff, dof[k], 2); __builtin_amdgcn_raw_buffer_store_b128(cp[2 * k + 1], rd_, toff, dof[k] + 8192, 2); }
    }
}
__device__ __forceinline__ void stagger_start(int us) {
    const unsigned long long t0 = __builtin_amdgcn_s_memrealtime(), dt = (unsigned long long)(((blockIdx.x >> 3) & 3) * us * 100);
    while (__builtin_amdgcn_s_memrealtime() - t0 < dt) __builtin_amdgcn_s_sleep(16);
}
#define XB_TMO      128
#define XB_XCNT(j)  (256  + 64 * (j))
#define XB_XSUB(j)  (1280 + 64 * (j))
#define XB_XGEN(j)  (2304 + 64 * (j))
#define XB_TOP      3328
#define XB_TOPGEN   3392
#define XCD_BAR_WORDS 3456
#define XB_SPIN_CAP (1u << 18)
__device__ __forceinline__ unsigned xb_ld(unsigned* p)              { return __hip_atomic_load(p, __ATOMIC_RELAXED, __HIP_MEMORY_SCOPE_AGENT); }
__device__ __forceinline__ unsigned xb_add(unsigned* p, unsigned v) { return __hip_atomic_fetch_add(p, v, __ATOMIC_RELAXED, __HIP_MEMORY_SCOPE_AGENT); }
__device__ __forceinline__ unsigned xb_xcc_id() { return (unsigned)__builtin_amdgcn_s_getreg((3 << 11) | 20) & 0xFu; }
#define XB_SPIN(cond, bar) do { unsigned _sp = 0; while (cond) { __builtin_amdgcn_s_sleep(1); \
    if ((++_sp & 255u) == 0u) { if (xb_ld(&(bar)[XB_TMO])) break; if (_sp > XB_SPIN_CAP) { atomicAdd(&(bar)[XB_TMO], 1u); break; } } } } while (0)
struct XcdBarrier { unsigned* bar; unsigned x, nloc, nx; };
__device__ __forceinline__ void xcd_barrier_complete(unsigned* bar, unsigned x, unsigned& nloc, unsigned& nx) {
    const unsigned G = gridDim.x * gridDim.y * gridDim.z;
    unsigned sum, cnt, mine, sp = 0u;
    for (;;) {
        sum = 0u; cnt = 0u; mine = 0u;
#pragma unroll
        for (unsigned j = 0; j < 16; ++j) { const unsigned c = xb_ld(&bar[XB_XCNT(j)]); sum += c; cnt += (c > 0u) ? 1u : 0u; mine = (j == x) ? c : mine; }
        if (sum == G) break;
        __builtin_amdgcn_s_sleep(1);
        if ((++sp & 255u) == 0u) { if (xb_ld(&bar[XB_TMO])) break; if (sp > XB_SPIN_CAP) { atomicAdd(&bar[XB_TMO], 1u); break; } }
    }
    nloc = mine > 0u ? mine : 1u; nx = cnt > 0u ? cnt : 1u;
}
__device__ __forceinline__ void xcd_barrier(XcdBarrier& b) {
    asm volatile("s_waitcnt vmcnt(0)" ::: "memory");
    __syncthreads();
    if (threadIdx.x == 0) {
        unsigned* bar = b.bar;
        __builtin_amdgcn_s_waitcnt(0);
        if (b.nloc == 0u) xcd_barrier_complete(bar, b.x, b.nloc, b.nx);
        const unsigned nloc = b.nloc, nx = b.nx;
        const unsigned old = xb_add(&bar[XB_XSUB(b.x)], 1u);
        const unsigned gen = old / nloc;
        if (old + 1u == (gen + 1u) * nloc) {
            __builtin_amdgcn_fence(__ATOMIC_RELEASE, "agent");
            asm volatile("s_waitcnt vmcnt(0)" ::: "memory");
            const unsigned og = xb_add(&bar[XB_TOP], 1u);
            const unsigned tg = og / nx;
            if (og + 1u == (tg + 1u) * nx) xb_add(&bar[XB_TOPGEN], 1u);
            else XB_SPIN(xb_ld(&bar[XB_TOPGEN]) == tg, bar);
            __builtin_amdgcn_fence(__ATOMIC_ACQUIRE, "agent");
            xb_add(&bar[XB_XGEN(b.x)], 1u);
            asm volatile("s_waitcnt vmcnt(0)" ::: "memory");
        } else {
            XB_SPIN(xb_ld(&bar[XB_XGEN(b.x)]) == gen, bar);
            __builtin_amdgcn_fence(__ATOMIC_ACQUIRE, "agent");
            asm volatile("s_waitcnt vmcnt(0)" ::: "memory");
        }
    }
    __syncthreads();
}
struct Args { const float* in[14]; float* out; unsigned char* ws; int ph_lo, ph_hi, probe, pad; };
__global__ void __launch_bounds__(NWAVES * 64, 2) mega_fwd(Args args) {
    extern __shared__ __attribute__((aligned(16))) unsigned char lds[];
    cg::grid_group grid = cg::this_grid();
    Frame F;
    F.lds = (LAS unsigned char*)lds;
    F.tid = threadIdx.x; F.lane = F.tid & 63; F.wave = __builtin_amdgcn_readfirstlane(F.tid >> 6);
    F.G = gridDim.x; { const int bx = blockIdx.x; F.vcu = (F.G % 8 == 0) ? (bx % 8) * (F.G / 8) + bx / 8 : bx; }
    unsigned char* ws = args.ws;
    F.xp = args.in[0]; F.xs = args.in[1]; F.c0 = args.in[2]; F.c1 = args.in[3]; F.c2 = args.in[4]; F.sconv = args.in[5]; F.g_attn = args.in[6]; F.w_in = args.in[7];
    F.conv_w = args.in[8]; F.w_out = args.in[9]; F.g_mlp = args.in[10]; F.w_up = args.in[11]; F.w_down = args.in[12]; F.g_fin = args.in[13]; F.out = args.out;
    F.Win_t = (bf16*)(ws + WS_WIN); F.Wout_t = (bf16*)(ws + WS_WOUT); F.Wup_t = (bf16*)(ws + WS_WUP); F.Wdn_t = (bf16*)(ws + WS_WDN);
    F.XB = (bf16*)(ws + WS_XB); F.PROJ = (bf16*)(ws + WS_PROJ); F.MIX = (bf16*)(ws + WS_MIX); F.HB = (bf16*)(ws + WS_HB); F.QKVP = (bf16*)(ws + WS_QKVP);
    F.RSTD0 = (float*)(ws + WS_RSTD0); F.ST1 = (float*)(ws + WS_ST1); F.ST2 = (float*)(ws + WS_ST2); F.LSE = (float*)(ws + WS_LSE); F.PART = (float*)(ws + WS_PART); F.PART = (float*)(ws + WS_PART); F.CNT = (unsigned*)(ws + WS_CNT);
    const int lo = args.ph_lo, hi = args.ph_hi;
    XcdBarrier xbar; xbar.bar = (unsigned*)(ws + WS_BAR); xbar.x = xb_xcc_id(); xbar.nloc = 0u; xbar.nx = 0u;
    if (hi - lo > 1 && threadIdx.x == 0) (void)xb_add(&xbar.bar[XB_XCNT(xbar.x)], 1u);
#define IN(k) (lo <= (k) && (k) < hi)
#define SEAM(k) do { if (IN(k) && IN((k) + 1)) xcd_barrier(xbar); } while (0)
    if (args.probe == 0x7fffffff) grid.sync();

    if (IN(0)) { p0_prologue(F); if (PROBE_REP == 0) p0_prologue(F); }
    SEAM(0);
    if (IN(1)) {
        pg8::Gemm g{F.XB, F.Win_t, M, NIN, D}; pg8::StaticOrder S; S.init(M, NIN, F.G, (int)blockIdx.x, REP_G1);
        pg8::EpiScaleBf16<0> E{F.PROJ, NIN, F.RSTD0, EPS, pg8::CopyJob{nullptr, nullptr, 0}, F.QKVP, MP};
        pg8::gemm_phase<pg8::EpiScaleBf16<0>, pg8::StaticOrder, PG8_ALIGN, PG8_SP2>(F.lds, g, S, E);
        tail_copy(F, 0, 4608, S.nwg % F.G);
    }
    SEAM(1);
    if (IN(2)) p2_mixers(F, 15);
    SEAM(2);
    if (IN(4)) {
        pg8::Gemm g{F.MIX, F.Wout_t, M, D, D}; pg8::StaticOrder S; S.init(M, D, F.G, (int)blockIdx.x, REP_G4);
        pg8::EpiResBf16 E{F.XB, F.XB, F.ST1};
        pg8::gemm_phase<pg8::EpiResBf16, pg8::StaticOrder, PG8_ALIGN, PG8_SP2>(F.lds, g, S, E);
        tail_copy(F, 4608, 6720, S.nwg % F.G);
    }
    SEAM(4);
    if (IN(5)) {
        pg8::Gemm g{F.XB, F.Wup_t, M, FF, D}; pg8::StaticOrder S; S.init(M, FF, F.G, (int)blockIdx.x, REP_G5);
        pg8::EpiScaleBf16<1> E{F.HB, FF, F.ST1, EPS, pg8::CopyJob{F.c2, F.out + O_KVS2, 0}, nullptr, 0};
        pg8::gemm_phase<pg8::EpiScaleBf16<1>, pg8::StaticOrder, PG8_ALIGN, PG8_SP2>(F.lds, g, S, E);
        tail_copy(F, 4608 + 6720, pg8::CP_NBLK - 4608 - 6720, S.nwg % F.G);
    }
    SEAM(5);
    if (IN(6)) {
        constexpr int NWG6 = (M / 256) * (D / 256);
        int nfull = (NWG6 / F.G) * F.G, ntail = NWG6 - nfull, split = P6_SPLIT; const int cap = F.G < 256 ? F.G : 256;
        while (split > 1 && ntail * split > cap) split >>= 1;
        if (ntail * split > cap || hi - lo == 1) { nfull = NWG6; ntail = 0; }
        pg8::Gemm g{F.HB, F.Wdn_t, M, D, FF}; pg8::StaticOrder S; S.init(M, D, F.G, (int)blockIdx.x, 1, nfull);
        pg8::EpiResBf16 E{F.XB, F.MIX, F.ST2};
        pg8::gemm_phase<pg8::EpiResBf16, pg8::StaticOrder, PG8_ALIGN, PG8_SP2>(F.lds, g, S, E);
        if (ntail > 0) {
            pg8::StaticOrder S0; S0.init(M, D, F.G, (int)blockIdx.x); const pg8::TailOrder T{S0, nfull, split};
            pg8::EpiPartial EP{F.PART, nfull};
            pg8::gemm_phase<pg8::EpiPartial, pg8::TailOrder, PG8_ALIGN, PG8_SP2>(F.lds, g, T, EP);
            xcd_barrier(xbar);
            p6_tail_reduce(F, S0, nfull, split);
        }
    }
    SEAM(6);
    if (IN(7)) p6_final(F);
#undef IN
#undef SEAM
}

extern "C" void kernel_launch(void* const* d_in, const int* in_sizes, int n_in, void* d_out, int out_size, void* d_ws, size_t ws_size, hipStream_t stream) {
    static int grid = 0;
    if (grid == 0) {
        if (n_in != 14 || in_sizes[0] != MP * D || (size_t)out_size != O_END || ws_size < WS_END) { fprintf(stderr, "kernel_launch: unexpected shapes (n_in %d, in0 %d, out %d, ws %zu); nothing launched\n", n_in, n_in > 0 ? in_sizes[0] : -1, out_size, ws_size); grid = -1; return; }
        int dev = 0, cus = 0, per_cu = 0;
        if (hipGetDevice(&dev) != hipSuccess || hipDeviceGetAttribute(&cus, hipDeviceAttributeMultiprocessorCount, dev) != hipSuccess) { grid = -1; return; }
        if (hipFuncSetAttribute((const void*)mega_fwd, hipFuncAttributeMaxDynamicSharedMemorySize, LDS_BYTES) != hipSuccess) { fprintf(stderr, "kernel_launch: hipFuncSetAttribute failed\n"); grid = -1; return; }
        if (hipOccupancyMaxActiveBlocksPerMultiprocessor(&per_cu, (const void*)mega_fwd, NWAVES * 64, LDS_BYTES) != hipSuccess || per_cu < 1) { fprintf(stderr, "kernel_launch: occupancy query failed (%d)\n", per_cu); (void)hipGetLastError(); grid = -1; return; }
        grid = cus;
    }
    if (grid < 0) return;
    Args a{};
    for (int i = 0; i < 14; ++i) a.in[i] = (const float*)d_in[i];
    a.out = (float*)d_out; a.ws = (unsigned char*)d_ws; a.probe = PROBE_P2MASK;
    if (MK_N_LAUNCHES == 1) {
        if (hipMemsetAsync((char*)d_ws + WS_BAR, 0, WS_BAR_BYTES, stream) != hipSuccess) { fprintf(stderr, "kernel_launch: hipMemsetAsync of the barrier words failed\n"); return; }
        a.ph_lo = 0; a.ph_hi = 8;
        void* kargs[] = {&a};
        const hipError_t e = hipLaunchCooperativeKernel((const void*)mega_fwd, dim3(grid), dim3(NWAVES * 64), kargs, LDS_BYTES, stream);
        if (e != hipSuccess) fprintf(stderr, "kernel_launch: cooperative launch failed: %s (grid %d)\n", hipGetErrorString(e), grid);
    } else {
        for (int p = 0; p < 8; ++p) { a.ph_lo = p; a.ph_hi = p + 1; hipLaunchKernelGGL(mega_fwd, dim3(grid), dim3(NWAVES * 64), LDS_BYTES, stream, a); }
    }
}
```

```cpp
#include <hip/hip_runtime.h>
#include <cstdio>
#include <cstdint>
#include <hip/hip_cooperative_groups.h>
namespace cg = cooperative_groups;
namespace pg8 {
#define PG8_LAS __attribute__((address_space(3)))
typedef unsigned short bf16_t;
typedef short bf16x8 __attribute__((ext_vector_type(8)));
typedef float f32x4 __attribute__((ext_vector_type(4)));
typedef unsigned u32x4 __attribute__((ext_vector_type(4)));
constexpr int BM = 256, BK = 64, HALF = 128, HTB = HALF * BK * 2  , STAGE_BYTES = 8 * HTB, NXCD = 8, WGM = 8;

__host__ __device__ __forceinline__ int lds_byte(int r, int c) { const int st = (r >> 4) * 2 + (c >> 5), rr = r & 15, cc = c & 31, ob = rr * 64 + cc * 2; return st * 1024 + (ob ^ (((ob >> 9) & 1) << 5)); }
__host__ __device__ __forceinline__ void stage_rc(int b, int& R, int& C) { const int st = b / 1024, sb = b % 1024, swz = sb ^ (((sb >> 9) & 1) << 5); R = (st >> 1) * 16 + swz / 64; C = (st & 1) * 32 + (swz % 64) / 2; }
__host__ __device__ __forceinline__ int perm32(int rho) { const int n = rho >> 4, i = rho & 15; return 8 * (i >> 2) + 4 * n + (i & 3); }

struct Unit { int pm, pn, lin, ks, ns; };
struct Gemm { const bf16_t* A; const bf16_t* Bt; int M, N, K; };

struct StaticOrder {
    int nM, nN, nwg, G, c, rep, lim;
    __host__ __device__ void init(int M, int N, int G_, int c_, int rep_ = 1, int lim_ = 0) { nM = M / BM; nN = N / BM; nwg = nM * nN; G = G_; c = c_; rep = rep_; lim = lim_ > 0 ? lim_ : nwg; }
    __host__ __device__ void tile(int wgid, Unit& u) const {
        { const int q = nwg / NXCD, r = nwg % NXCD, xcd = wgid % NXCD, off = wgid / NXCD; wgid = (xcd < r ? xcd * (q + 1) : r * (q + 1) + (xcd - r) * q) + off; }
        const int nig = WGM * nN, gid = wgid / nig, fm = gid * WGM, gsz = (nM - fm) < WGM ? (nM - fm) : WGM;
        u.pm = fm + ((wgid % nig) % gsz); u.pn = (wgid % nig) / gsz;
    }
    __host__ __device__ bool next(int i, Unit& u) const {
        long L = (long)i * G + c; if (L >= (long)lim * rep) return false; L %= lim;
        u.lin = (int)L; u.ks = 0; u.ns = 1; tile((int)L, u); return true;
    }
    __device__ __forceinline__ void a_ready(const Unit&) const {}
    __device__ __forceinline__ void done(const Unit&) const {}
};
struct TailOrder {
    StaticOrder so; int first, S;
    __device__ bool next(int i, Unit& u) const {
        if (i > 0) return false; const int item = so.c; if (item >= (so.nwg - first) * S) return false;
        u.lin = first + item / S; u.ks = item % S; u.ns = S; so.tile(u.lin, u); return true;
    }
    __device__ __forceinline__ void a_ready(const Unit&) const {}
    __device__ __forceinline__ void done(const Unit&) const {}
};

__device__ __forceinline__ unsigned cvt_pk_bf16(float lo, float hi) { unsigned r; asm volatile("v_cvt_pk_bf16_f32 %0, %1, %2" : "=v"(r) : "v"(lo), "v"(hi)); return r; }
typedef float f32x2 __attribute__((ext_vector_type(2)));
constexpr int CP_NBLK = 128 * 128;
struct CopyJob { const float* s2; float* d2; int on; };
template <int MODE> struct EpiScaleBf16 {
    static constexpr bool PERM = true, AFTER_DRAIN = false;
    bf16_t* O; int ldc; const float* rs; float eps; CopyJob cj; bf16_t* QKVP; int perm_rows;
    __device__ __forceinline__ void operator()(const f32x4 (&acc)[2][2][4][2], const Unit& u, int wr, int wc, int fr, int fq) const {
        const int row0 = u.pm * BM + wr * 64 + fr; const int col0 = u.pn * BM + wc * 32 + 8 * fq;
        float sc[8];
        if (MODE == 0) {
#pragma unroll
            for (int i = 0; i < 8; ++i) sc[i] = rs[row0 + (i >> 2) * HALF + (i & 3) * 16];
        } else {
            f32x4 pv[8];
#pragma unroll
            for (int i = 0; i < 8; ++i) pv[i] = *(const f32x4*)(rs + (size_t)(row0 + (i >> 2) * HALF + (i & 3) * 16) * 16 + 4 * fq);
#pragma unroll
            for (int i = 0; i < 8; ++i) { float ss = (pv[i][0] + pv[i][1]) + (pv[i][2] + pv[i][3]); ss += __shfl_xor(ss, 16); ss += __shfl_xor(ss, 32);
                sc[i] = __builtin_amdgcn_rsqf(ss * (1.0f / 1024.0f) + eps); }
        }
        u32x4 cp[8]; int so[4], dof[4]; const int toff = threadIdx.x * 16;
        if (MODE == 1 && cj.on) {
#pragma unroll
            for (int k = 0; k < 4; ++k) { int blk = __builtin_amdgcn_readfirstlane(4 * u.lin + k); blk = blk >= CP_NBLK ? CP_NBLK - 1 : blk;
                const int b = blk >> 7, q = blk & 127; dof[k] = ((b * 2048 + 16 * q) * 512) * 4; so[k] = dof[k] + 8 * 512 * 4; }
            const __amdgpu_buffer_rsrc_t rs_ = __builtin_amdgcn_make_buffer_rsrc((void*)cj.s2, 0, 0x7fffffff, 0x00020000);
#pragma unroll
            for (int k = 0; k < 4; ++k) { cp[2 * k] = __builtin_amdgcn_raw_buffer_load_b128(rs_, toff, so[k], 2); cp[2 * k + 1] = __builtin_amdgcn_raw_buffer_load_b128(rs_, toff, so[k] + 8192, 2); }
            asm volatile("" ::: "memory");
        }
#pragma unroll
        for (int ai = 0; ai < 2; ++ai)
#pragma unroll
            for (int m = 0; m < 4; ++m) { const int row = row0 + ai * HALF + m * 16; const float s1 = sc[ai * 4 + m];
                bf16_t* rowp = O + (size_t)row * ldc + col0; int bjs = HALF;
                if (MODE == 0 && QKVP != nullptr && u.pn < 9 && u.pm * BM < perm_rows) {
                    const int sel = u.pn / 3, g = u.pn - 3 * sel, sh = 2 * g, b = row >> 13, t = row & 8191, prow = (t & ((1 << sh) - 1)) * (8192 >> sh) + (t >> sh);
                    rowp = QKVP + ((size_t)((((sel * 3 + g) * 4 + (wc >> 1)) * 8 + b) * 8192 + prow)) * 64 + (wc & 1) * 32 + 8 * fq; bjs = 2 * 8 * 8192 * 64; }
#pragma unroll
                for (int bj = 0; bj < 2; ++bj) { f32x4 v0 = acc[ai][bj][m][0] * s1, v1 = acc[ai][bj][m][1] * s1;
                    if (MODE == 1) {
#pragma unroll
                        for (int e = 0; e < 4; ++e) { const float x0 = fmaxf(v0[e], 0.f), x1 = fmaxf(v1[e], 0.f); v0[e] = x0 * x0; v1[e] = x1 * x1; } }
                    u32x4 w; w.x = cvt_pk_bf16(v0[0], v0[1]); w.y = cvt_pk_bf16(v0[2], v0[3]); w.z = cvt_pk_bf16(v1[0], v1[1]); w.w = cvt_pk_bf16(v1[2], v1[3]);
                    *(u32x4*)(rowp + (size_t)bj * bjs) = w; } }
        if (MODE == 1 && cj.on) {
            asm volatile("" ::: "memory");
            const __amdgpu_buffer_rsrc_t rd_ = __builtin_amdgcn_make_buffer_rsrc((void*)cj.d2, 0, 0x7fffffff, 0x00020000);
#pragma unroll
            for (int k = 0; k < 4; ++k) { __builtin_amdgcn_raw_buffer_store_b128(cp[2 * k], rd_, toff, dof[k], 2); __builtin_amdgcn_raw_buffer_store_b128(cp[2 * k + 1], rd_, toff, dof[k] + 8192, 2); }
        }
    }
};
struct EpiResBf16 {
    static constexpr bool PERM = true, AFTER_DRAIN = false;
    const bf16_t* xin; bf16_t* xio; float* stats;
    __device__ __forceinline__ void operator()(const f32x4 (&acc)[2][2][4][2], const Unit& u, int wr, int wc, int fr, int fq) const {
        const int row0 = u.pm * BM + wr * 64 + fr; const int col0 = u.pn * BM + wc * 32 + 8 * fq;
#pragma unroll
        for (int ai = 0; ai < 2; ++ai) { u32x4 rw[4][2];
#pragma unroll
            for (int m = 0; m < 4; ++m)
#pragma unroll
                for (int bj = 0; bj < 2; ++bj) rw[m][bj] = *(const u32x4*)(xin + (size_t)(row0 + ai * HALF + m * 16) * 1024 + col0 + bj * HALF);
#pragma unroll
            for (int m = 0; m < 4; ++m) { const int row = row0 + ai * HALF + m * 16; float ss = 0.f;
#pragma unroll
                for (int bj = 0; bj < 2; ++bj) { const u32x4 r = rw[m][bj];
                    f32x4 o0 = acc[ai][bj][m][0], o1 = acc[ai][bj][m][1];
                    o0[0] += __builtin_bit_cast(float, r.x << 16); o0[1] += __builtin_bit_cast(float, r.x & 0xffff0000u); o0[2] += __builtin_bit_cast(float, r.y << 16); o0[3] += __builtin_bit_cast(float, r.y & 0xffff0000u);
                    o1[0] += __builtin_bit_cast(float, r.z << 16); o1[1] += __builtin_bit_cast(float, r.z & 0xffff0000u); o1[2] += __builtin_bit_cast(float, r.w << 16); o1[3] += __builtin_bit_cast(float, r.w & 0xffff0000u);
                    u32x4 w; w.x = cvt_pk_bf16(o0[0], o0[1]); w.y = cvt_pk_bf16(o0[2], o0[3]); w.z = cvt_pk_bf16(o1[0], o1[1]); w.w = cvt_pk_bf16(o1[2], o1[3]);
                    *(u32x4*)(xio + (size_t)row * 1024 + col0 + bj * HALF) = w;
                    ss += ((o0[0] * o0[0] + o0[1] * o0[1]) + (o0[2] * o0[2] + o0[3] * o0[3])) + ((o1[0] * o1[0] + o1[1] * o1[1]) + (o1[2] * o1[2] + o1[3] * o1[3])); }
                ss += __shfl_xor(ss, 16); ss += __shfl_xor(ss, 32);
                if (fq == 0) stats[(size_t)row * 16 + u.pn * 4 + wc] = ss; }
            asm volatile("" ::: "memory"); }
    }
};
struct EpiPartial {
    static constexpr bool PERM = true, AFTER_DRAIN = false;
    float* part; int first;
    __device__ __forceinline__ void operator()(const f32x4 (&acc)[2][2][4][2], const Unit& u, int wr, int wc, int fr, int fq) const {
        float* base = part + (size_t)((u.lin - first) * u.ns + u.ks) * 65536 + (wr * 64 + fr) * 256 + wc * 32 + 8 * fq;
#pragma unroll
        for (int ai = 0; ai < 2; ++ai)
#pragma unroll
            for (int m = 0; m < 4; ++m)
#pragma unroll
                for (int bj = 0; bj < 2; ++bj) { float* p = base + (ai * HALF + m * 16) * 256 + bj * HALF; *(f32x4*)p = acc[ai][bj][m][0]; *(f32x4*)(p + 4) = acc[ai][bj][m][1]; }
    }
};
template <class Epi, class Sched, bool ALIGN_EPI = false, bool SP2 = false>
__device__ __forceinline__ void gemm_phase(PG8_LAS unsigned char* lds, const Gemm g, const Sched& S, const Epi& E) {
    const int tid = threadIdx.x, wid = __builtin_amdgcn_readfirstlane(tid >> 6), lane = tid & 63, wr = wid >> 2, wc = wid & 3, fr = lane & 15, fq = lane >> 4;
    const int K = g.K;
    unsigned voffA[2], voffB[2];
#pragma unroll
    for (int i = 0; i < 2; ++i) { int R, C; stage_rc(tid * 16 + i * 8192, R, C); const int Rb = Epi::PERM ? ((R & ~31) + perm32(R & 31)) : R;
        voffA[i] = (unsigned)(R * K + C) * 2u; voffB[i] = (unsigned)(Rb * K + C) * 2u; }
    const size_t kstep = (size_t)(BK * 2);
    const size_t hstep = (size_t)HALF * K * 2;
    const size_t tstep = 2 * hstep;
    const unsigned ldsw = (unsigned)wid * 1024u;
    const int aoff = lds_byte(wr * 64 + fr, fq * 8), boff = lds_byte(wc * 32 + fr, fq * 8);
#define PG8_SA(b, h) (((b) * 2 + (h)) * HTB)
#define PG8_SB(b, h) ((4 + (b) * 2 + (h)) * HTB)
#define PG8_STAGE(bufoff, gbase, voff) do { _Pragma("unroll") for (int _i = 0; _i < 2; ++_i) \
        __builtin_amdgcn_global_load_lds((const unsigned*)((const char*)(gbase) + (voff)[_i]), (PG8_LAS unsigned*)(lds + (bufoff) + ldsw + _i * 8192), 16, 0, 0); } while (0)
#define PG8_LDA(dst, b, h) do { _Pragma("unroll") for (int m = 0; m < 4; ++m) _Pragma("unroll") for (int k = 0; k < 2; ++k) dst[m][k] = *(const PG8_LAS bf16x8*)(lds + PG8_SA(b, h) + aoff + m * 2048 + k * 1024); } while (0)
#define PG8_LDB(dst, b, h) do { _Pragma("unroll") for (int n = 0; n < 2; ++n) _Pragma("unroll") for (int k = 0; k < 2; ++k) dst[n][k] = *(const PG8_LAS bf16x8*)(lds + PG8_SB(b, h) + boff + n * 2048 + k * 1024); } while (0)
#define PG8_MMA(ai, bj, At, Bt) do { __builtin_amdgcn_s_setprio(1); _Pragma("unroll") for (int m = 0; m < 4; ++m) _Pragma("unroll") for (int n = 0; n < 2; ++n) _Pragma("unroll") for (int k = 0; k < 2; ++k) \
        acc[ai][bj][m][n] = __builtin_amdgcn_mfma_f32_16x16x32_bf16(Bt[n][k], At[m][k], acc[ai][bj][m][n], 0, 0, 0); __builtin_amdgcn_s_setprio(0); } while (0)
#define PG8_WAIT_V(n) asm volatile("s_waitcnt vmcnt(" #n ")" ::: "memory")
#define PG8_WAIT_L(n) asm volatile("s_waitcnt lgkmcnt(" #n ")" ::: "memory")
#define PG8_BAR __builtin_amdgcn_s_barrier()
#define PG8_SCHED __builtin_amdgcn_sched_barrier(0)
    Unit cur, nxt; int ui = 0;
    if (!S.next(0, cur)) return;
    f32x4 acc[2][2][4][2];
#pragma unroll
    for (int a = 0; a < 2; ++a)
#pragma unroll
        for (int b = 0; b < 2; ++b)
#pragma unroll
            for (int m = 0; m < 4; ++m)
#pragma unroll
                for (int n = 0; n < 2; ++n) acc[a][b][m][n] = (f32x4){0.f, 0.f, 0.f, 0.f};
    bf16x8 At[4][2], B0[2][2], B1[2][2];
    int nt = K / BK / cur.ns; const size_t koff = (size_t)cur.ks * nt * kstep;
    const char* cA = (const char*)g.A + (size_t)cur.pm * tstep + koff; const char* cB = (const char*)g.Bt + (size_t)cur.pn * tstep + koff;
    S.a_ready(cur);
    if constexpr (SP2) {
        PG8_STAGE(PG8_SB(0, 0), cB, voffB); PG8_STAGE(PG8_SB(0, 1), cB + hstep, voffB); PG8_STAGE(PG8_SA(0, 0), cA, voffA); PG8_STAGE(PG8_SA(0, 1), cA + hstep, voffA);
        if (wr == 1) PG8_BAR;
        PG8_WAIT_V(2); PG8_BAR;
        PG8_STAGE(PG8_SB(1, 0), cB + kstep, voffB); PG8_STAGE(PG8_SA(1, 0), cA + kstep, voffA); PG8_STAGE(PG8_SB(1, 1), cB + hstep + kstep, voffB);
        PG8_WAIT_V(6); PG8_BAR;
    } else {
        PG8_STAGE(PG8_SB(0, 0), cB, voffB); PG8_STAGE(PG8_SA(0, 0), cA, voffA); PG8_STAGE(PG8_SB(0, 1), cB + hstep, voffB); PG8_STAGE(PG8_SA(0, 1), cA + hstep, voffA);
        if (wr == 1) PG8_BAR;
        PG8_WAIT_V(4); PG8_BAR;
        PG8_STAGE(PG8_SB(1, 0), cB + kstep, voffB); PG8_STAGE(PG8_SA(1, 0), cA + kstep, voffA); PG8_STAGE(PG8_SB(1, 1), cB + hstep + kstep, voffB);
        PG8_WAIT_V(6); PG8_BAR;
    }
    for (;;) {
        const bool has_next = S.next(ui + 1, nxt);
        const int nnt = has_next ? K / BK / nxt.ns : nt; const size_t nkoff = has_next ? (size_t)nxt.ks * nnt * kstep : 0;
        const char* nA = has_next ? (const char*)g.A + (size_t)nxt.pm * tstep + nkoff : cA; const char* nB = has_next ? (const char*)g.Bt + (size_t)nxt.pn * tstep + nkoff : cB;
        for (int t = 0; t < nt; t += 2) {
            const bool last = (t == nt - 2);
            const char* a1 = cA + (size_t)(t + 1) * kstep;
            const char* a2 = last ? nA : cA + (size_t)(t + 2) * kstep; const char* b2 = last ? nB : cB + (size_t)(t + 2) * kstep;
            const char* a3 = a2 + kstep; const char* b3 = b2 + kstep;
            if (last && has_next) S.a_ready(nxt);
            if constexpr (SP2) {
            PG8_LDB(B0, 0, 0); PG8_LDB(B1, 0, 1); PG8_SCHED; PG8_LDA(At, 0, 0); PG8_STAGE(PG8_SA(1, 1), a1 + hstep, voffA);
            PG8_WAIT_V(8); PG8_WAIT_L(0); PG8_BAR; PG8_MMA(0, 0, At, B0); PG8_MMA(0, 1, At, B1); PG8_BAR; PG8_SCHED;
            PG8_LDA(At, 0, 1); PG8_STAGE(PG8_SB(0, 0), b2, voffB); PG8_STAGE(PG8_SB(0, 1), b2 + hstep, voffB); PG8_STAGE(PG8_SA(0, 0), a2, voffA);
            PG8_WAIT_V(8); PG8_WAIT_L(0); PG8_BAR; PG8_MMA(1, 0, At, B0); PG8_MMA(1, 1, At, B1); PG8_BAR; PG8_SCHED;
            PG8_LDB(B0, 1, 0); PG8_LDB(B1, 1, 1); PG8_SCHED; PG8_LDA(At, 1, 0); PG8_STAGE(PG8_SA(0, 1), a2 + hstep, voffA);
            PG8_WAIT_V(8); PG8_WAIT_L(0); PG8_BAR; PG8_MMA(0, 0, At, B0); PG8_MMA(0, 1, At, B1); PG8_BAR; PG8_SCHED;
            PG8_LDA(At, 1, 1); PG8_STAGE(PG8_SB(1, 0), b3, voffB); PG8_STAGE(PG8_SB(1, 1), b3 + hstep, voffB); PG8_STAGE(PG8_SA(1, 0), a3, voffA);
            PG8_WAIT_V(8); PG8_WAIT_L(0); PG8_BAR; PG8_MMA(1, 0, At, B0); PG8_MMA(1, 1, At, B1); PG8_BAR; PG8_SCHED;
            } else {
            PG8_LDB(B0, 0, 0); PG8_SCHED; PG8_LDA(At, 0, 0); PG8_STAGE(PG8_SA(1, 1), a1 + hstep, voffA);
            PG8_WAIT_L(8); PG8_BAR; PG8_WAIT_L(0); PG8_MMA(0, 0, At, B0); PG8_BAR; PG8_SCHED;
            PG8_LDB(B1, 0, 1); PG8_STAGE(PG8_SB(0, 0), b2, voffB);
            PG8_BAR; PG8_WAIT_L(0); PG8_MMA(0, 1, At, B1); PG8_BAR;
            PG8_LDA(At, 0, 1); PG8_STAGE(PG8_SA(0, 0), a2, voffA);
            PG8_BAR; PG8_WAIT_L(0); PG8_MMA(1, 0, At, B0); PG8_BAR; PG8_SCHED;
            PG8_STAGE(PG8_SB(0, 1), b2 + hstep, voffB);
            PG8_WAIT_V(6); PG8_BAR; PG8_MMA(1, 1, At, B1); PG8_BAR;
            PG8_LDB(B0, 1, 0); PG8_SCHED; PG8_LDA(At, 1, 0); PG8_STAGE(PG8_SA(0, 1), a2 + hstep, voffA);
            PG8_WAIT_L(8); PG8_BAR; PG8_WAIT_L(0); PG8_MMA(0, 0, At, B0); PG8_BAR; PG8_SCHED;
            PG8_LDB(B1, 1, 1); PG8_STAGE(PG8_SB(1, 0), b3, voffB);
            PG8_BAR; PG8_WAIT_L(0); PG8_MMA(0, 1, At, B1); PG8_BAR;
            PG8_LDA(At, 1, 1); PG8_STAGE(PG8_SA(1, 0), a3, voffA);
            PG8_BAR; PG8_WAIT_L(0); PG8_MMA(1, 0, At, B0); PG8_BAR; PG8_SCHED;
            PG8_STAGE(PG8_SB(1, 1), b3 + hstep, voffB);
            PG8_WAIT_V(6); PG8_BAR; PG8_MMA(1, 1, At, B1); PG8_BAR;
            }
        }
        if constexpr (ALIGN_EPI) { if (wr == 0) PG8_BAR; }
        if constexpr (!Epi::AFTER_DRAIN) { E(acc, cur, wr, wc, fr, fq); S.done(cur); }
        if (!has_next) break;
#pragma unroll
        for (int a = 0; a < 2; ++a)
#pragma unroll
            for (int b = 0; b < 2; ++b)
#pragma unroll
                for (int m = 0; m < 4; ++m)
#pragma unroll
                    for (int n = 0; n < 2; ++n) acc[a][b][m][n] = (f32x4){0.f, 0.f, 0.f, 0.f};
        cur = nxt; cA = nA; cB = nB; nt = nnt; ++ui;
        if constexpr (ALIGN_EPI) { if (wr == 1) PG8_BAR; }
    }
    PG8_WAIT_V(0);
    if constexpr (!ALIGN_EPI) { if (wr == 0) PG8_BAR; }
    PG8_BAR;
    if constexpr (Epi::AFTER_DRAIN) { E.fused(acc, cur, wr, wc, fr, fq, lds, wid, lane); S.done(cur); }
#undef PG8_SA
#undef PG8_SB
#undef PG8_STAGE
#undef PG8_LDA
#undef PG8_LDB
#undef PG8_MMA
#undef PG8_WAIT_V
#undef PG8_WAIT_L
#undef PG8_BAR
#undef PG8_SCHED
}
}
#ifndef PG8_SP2
#define PG8_SP2 true
#endif
#ifndef PG8_ALIGN
#define PG8_ALIGN true
#endif
#ifndef PROBE_REP
#define PROBE_REP -1
#endif
#ifndef REP_A
#define REP_A 1
#endif
#ifndef STAGGER_US1
#define STAGGER_US1 7
#define STAGGER_US5 9
#endif
#ifndef REP_G1
#define REP_G1 1
#endif
#ifndef REP_G4
#define REP_G4 1
#endif
#ifndef REP_G5
#define REP_G5 1
#endif
#ifndef REP_P0
#define REP_P0 1
#endif
#ifndef REP_B
#define REP_B 1
#endif
#ifndef REP_C
#define REP_C 1
#endif
#ifndef PROBE_P2MASK
#define PROBE_P2MASK 0
#endif
#ifndef MK_N_LAUNCHES
#define MK_N_LAUNCHES 1
#endif

constexpr int D = 1024, FF = 4096, NIN = 3072;
constexpr int MP = 8 * 8192, MS = 128 * 8, M = MP + MS;
constexpr int TP = 8192;
constexpr float EPS = 1e-6f;
constexpr int NWAVES = 8;
#define GAS __attribute__((address_space(1)))
#define LAS __attribute__((address_space(3)))
typedef unsigned short bf16;
typedef unsigned v4u __attribute__((ext_vector_type(4)));
typedef unsigned v2u __attribute__((ext_vector_type(2)));
typedef float f32x4 __attribute__((ext_vector_type(4)));
typedef short bf16x8 __attribute__((ext_vector_type(8)));
typedef short s16x4 __attribute__((ext_vector_type(4)));
typedef float f32x16 __attribute__((ext_vector_type(16)));

constexpr size_t MiB = 1u << 20;
constexpr size_t WS_WIN = 0, WS_WOUT = 6 * MiB, WS_WUP = 8 * MiB, WS_WDN = 16 * MiB;
constexpr size_t WS_RSTD0 = 24 * MiB;
constexpr size_t WS_ST1 = 25 * MiB, WS_ST2 = 30 * MiB;
constexpr size_t WS_LSE = 35 * MiB;
constexpr size_t WS_XB = 40 * MiB;
constexpr size_t WS_PROJ = 172 * MiB;
constexpr size_t WS_MIX = 564 * MiB;
constexpr size_t WS_HB = 696 * MiB;
constexpr size_t WS_QKVP = 1220 * MiB;
constexpr size_t WS_PART = 1510 * MiB;
constexpr size_t WS_BAR = 38 * MiB + 512 * 1024, WS_BAR_BYTES = 16384;
constexpr size_t WS_CNT = 39 * MiB;
constexpr size_t WS_END = 1592 * MiB;
static_assert(WS_XB + (size_t)M * D * 2 <= WS_PROJ && WS_PROJ + (size_t)M * NIN * 2 <= WS_MIX && WS_MIX + (size_t)M * D * 2 <= WS_HB && WS_HB + (size_t)M * FF * 2 <= WS_END, "d_ws map");
static_assert(WS_ST1 + (size_t)M * 64 <= WS_ST2 && WS_ST2 + (size_t)M * 64 <= WS_LSE && WS_LSE + (size_t)M * 48 <= WS_XB, "d_ws map 2");

constexpr size_t O_Y = 0;
constexpr size_t O_KVP0 = (size_t)M * D;
constexpr size_t O_KVP1 = O_KVP0 + 8ull * 128 * 512;
constexpr size_t O_KVP2 = O_KVP1 + 8ull * 512 * 512;
constexpr size_t O_CVP = O_KVP2 + 8ull * 2048 * 512;
constexpr size_t O_KVS0 = O_CVP + 8ull * 2 * 256;
constexpr size_t O_KVS1 = O_KVS0 + 128ull * 128 * 512;
constexpr size_t O_KVS2 = O_KVS1 + 128ull * 512 * 512;
constexpr size_t O_CVS = O_KVS2 + 128ull * 2048 * 512;
constexpr size_t O_END = O_CVS + 128ull * 2 * 256;

constexpr int P6_SPLIT = 16;
constexpr int LDS_BYTES = 163840;

__device__ __forceinline__ unsigned f2bf(float f) { unsigned u = __builtin_bit_cast(unsigned, f); return (u + 0x7fffu + ((u >> 16) & 1u)) >> 16; }
__device__ __forceinline__ unsigned pk2(float lo, float hi) { return f2bf(lo) | (f2bf(hi) << 16); }
__device__ __forceinline__ float bflo(unsigned w) { return __builtin_bit_cast(float, w << 16); }
__device__ __forceinline__ float bfhi(unsigned w) { return __builtin_bit_cast(float, w & 0xffff0000u); }
__device__ __forceinline__ float wave_sum(float v) {
#pragma unroll
    for (int o = 1; o < 64; o <<= 1) v += __shfl_xor(v, o);
    return v;
}

__device__ __forceinline__ unsigned att_cvtpk(float lo, float hi) { typedef float f2 __attribute__((ext_vector_type(2))); typedef __bf16 b2 __attribute__((ext_vector_type(2))); f2 v = {lo, hi}; b2 b = __builtin_convertvector(v, b2); return __builtin_bit_cast(unsigned, b); }
__device__ __forceinline__ const float* pick3(int g, const float* a, const float* b, const float* c) { return g == 0 ? a : (g == 1 ? b : c); }
struct Frame {
    LAS unsigned char* lds;
    int tid, lane, wave, vcu, G;
    const float *xp, *xs, *c0, *c1, *c2, *sconv, *g_attn, *w_in, *conv_w, *w_out, *g_mlp, *w_up, *w_down, *g_fin;
    float* out;
    bf16 *Win_t, *Wout_t, *Wup_t, *Wdn_t, *XB, *PROJ, *MIX, *HB, *QKVP;
    float *RSTD0, *ST1, *ST2, *LSE, *PART; unsigned* CNT;
};

__device__ __forceinline__ void p0_transpose_item(const float* W, const float* gk, int K, int N, bf16* WT, LAS float* scr, int item, int lane) {
    const int nblk = N / 32, kb = item / nblk, nb = item % nblk, k0 = 64 * kb, n0 = 32 * nb;
#pragma unroll 8
    for (int i = 0; i < 32; ++i) { const int kk = 2 * i + (lane >> 5); float v = W[(size_t)(k0 + kk) * N + n0 + (lane & 31)]; if (gk) v *= gk[k0 + kk]; scr[kk * 33 + (lane & 31)] = v; }
    asm volatile("s_waitcnt lgkmcnt(0)" ::: "memory");
    const int c = lane & 7;
#pragma unroll
    for (int j = 0; j < 4; ++j) { const int n = (lane >> 3) + 8 * j; const LAS float* s = scr + (8 * c) * 33 + n;
        v4u o; o.x = pk2(s[0 * 33], s[1 * 33]); o.y = pk2(s[2 * 33], s[3 * 33]); o.z = pk2(s[4 * 33], s[5 * 33]); o.w = pk2(s[6 * 33], s[7 * 33]);
        *(v4u*)(WT + (size_t)(n0 + n) * K + k0 + 8 * c) = o; }
    asm volatile("s_waitcnt lgkmcnt(0)" ::: "memory");
}
__device__ __forceinline__ void p0_prologue(Frame& F) {
    LAS float* scr = (LAS float*)(F.lds + F.wave * 16384);
    const int gw = F.vcu * NWAVES + F.wave, NGW = F.G * NWAVES;
    constexpr int I_IN = (D / 64) * (NIN / 32), I_O = (D / 64) * (D / 32), I_UP = (D / 64) * (FF / 32), I_DN = (FF / 64) * (D / 32);
    constexpr int NITEMS = I_IN + I_O + I_UP + I_DN;
    for (int it = gw; it < NITEMS; it += NGW) {
        int r = it;
        if (r < I_IN) { p0_transpose_item(F.w_in, F.g_attn, D, NIN, F.Win_t, scr, r, F.lane); continue; } r -= I_IN;
        if (r < I_O) { p0_transpose_item(F.w_out, nullptr, D, D, F.Wout_t, scr, r, F.lane); continue; } r -= I_O;
        if (r < I_UP) { p0_transpose_item(F.w_up, F.g_mlp, D, FF, F.Wup_t, scr, r, F.lane); continue; } r -= I_UP;
        p0_transpose_item(F.w_down, nullptr, FF, D, F.Wdn_t, scr, r, F.lane);
    }
    for (int m0_ = gw * 4; m0_ < M * REP_P0; m0_ += NGW * 4) { const int m0 = m0_ % M;
        const float* xrow = m0 < MP ? F.xp + (size_t)m0 * D : F.xs + (size_t)(m0 - MP) * D;
        f32x4 v[4][4]; float s[4];
#pragma unroll
        for (int r = 0; r < 4; ++r)
#pragma unroll
            for (int j = 0; j < 4; ++j) v[r][j] = ((const f32x4*)(xrow + (size_t)r * D))[F.lane + 64 * j];
#pragma unroll
        for (int r = 0; r < 4; ++r) { float t = 0.f;
#pragma unroll
            for (int j = 0; j < 4; ++j) t += (v[r][j].x * v[r][j].x + v[r][j].y * v[r][j].y) + (v[r][j].z * v[r][j].z + v[r][j].w * v[r][j].w);
            s[r] = wave_sum(t); }
#pragma unroll
        for (int r = 0; r < 4; ++r) { v2u* o8 = (v2u*)(F.XB + (size_t)(m0 + r) * D) + F.lane;
#pragma unroll
            for (int j = 0; j < 4; ++j) { v2u w; w.x = att_cvtpk(v[r][j].x, v[r][j].y); w.y = att_cvtpk(v[r][j].z, v[r][j].w); o8[64 * j] = w; }
            if (F.lane == 0) F.RSTD0[m0 + r] = __builtin_amdgcn_rsqf(s[r] * (1.0f / D) + EPS); }
    }
}

namespace att {
constexpr int VP = 128;
constexpr int WTILE = 160 * VP;
constexpr float C2 = 0.125f * 1.4426950408889634f;
typedef __amdgpu_buffer_rsrc_t rsrc_t;
__device__ __forceinline__ rsrc_t mk_rsrc(const void* p) { return __builtin_amdgcn_make_buffer_rsrc((void*)p, 0, 0x7fffffff, 0x00020000); }
__device__ __forceinline__ v4u bld16(rsrc_t r, int voff, int soff) { return __builtin_amdgcn_raw_buffer_load_b128(r, voff, soff, 0); }
__device__ __forceinline__ v2u bld8(rsrc_t r, int voff, int soff) { return __builtin_amdgcn_raw_buffer_load_b64(r, voff, soff, 0); }
__device__ __forceinline__ int crow(int r, int hi) { return (r & 3) + 8 * (r >> 2) + 4 * hi; }
__device__ __forceinline__ s16x4 vtr(const LAS unsigned char* p) { return __builtin_bit_cast(s16x4, __builtin_amdgcn_ds_read_tr16_b64_v4i16((LAS s16x4*)p)); }
__device__ __forceinline__ unsigned cvtpk(float lo, float hi) { typedef float f2 __attribute__((ext_vector_type(2))); typedef __bf16 b2 __attribute__((ext_vector_type(2))); f2 v = {lo, hi}; b2 b = __builtin_convertvector(v, b2); return __builtin_bit_cast(unsigned, b); }

__device__ __forceinline__ void prompt_tile(const rsrc_t rp, bf16* __restrict__ mixed, float* __restrict__ lse, LAS unsigned char* wl, int b, int g, int h, int r, int j, int lane_in) {
    int lane = lane_in; asm volatile("" : "+v"(lane));
    const int a = lane & 31, hi = lane >> 5, s = 2 * g, qs = 32 * j, rowb = b * TP, colq = g * 256 + h * 64, l8 = lane >> 3, c8 = lane & 7;
    const int L = TP >> s, vo = lane * 16;
    const int bq = (((g * 4 + h) * 8 + b) * TP + r * L + qs) * 128, bk = bq + 3 * 4 * 8 * TP * 128 - 128 * 128, bv = bk + 3 * 4 * 8 * TP * 128;
    v4u qraw[4], kraw[20], va[12], vb[8];
#pragma unroll
    for (int i = 0; i < 4; ++i) qraw[i] = bld16(rp, vo, bq + i * 1024);
#pragma unroll
    for (int i = 0; i < 20; ++i) kraw[i] = bld16(rp, vo, bk + i * 1024);
    const int wsw = l8 * VP + ((c8 ^ l8) * 16), rsw = a * VP;
#pragma unroll
    for (int i = 0; i < 4; ++i) *(LAS v4u*)(wl + 8 * i * VP + wsw) = qraw[i];
    bf16x8 qf[4];
#pragma unroll
    for (int d0 = 0; d0 < 4; ++d0) qf[d0] = *(const LAS bf16x8*)(wl + rsw + (((2 * d0 + hi) ^ (a & 7)) * 16));
#pragma unroll
    for (int i = 0; i < 20; ++i) *(LAS v4u*)(wl + 8 * i * VP + wsw) = kraw[i];
    asm volatile("" ::: "memory");
#pragma unroll
    for (int i = 0; i < 12; ++i) va[i] = bld16(rp, vo, bv + i * 1024);
    f32x16 S[5];
#pragma unroll
    for (int kb = 0; kb < 5; ++kb) { f32x16 acc = {};
#pragma unroll
        for (int d0 = 0; d0 < 4; ++d0) { const bf16x8 kf = *(const LAS bf16x8*)(wl + 32 * kb * VP + rsw + (((2 * d0 + hi) ^ (a & 7)) * 16)); acc = __builtin_amdgcn_mfma_f32_32x32x16_bf16(kf, qf[d0], acc, 0, 0, 0); }
        S[kb] = acc; }
    asm volatile("" ::: "memory");
#pragma unroll
    for (int i = 0; i < 8; ++i) vb[i] = bld16(rp, vo, bv + (12 + i) * 1024);
    float mr = -INFINITY; float bias[5];
#pragma unroll
    for (int kb = 0; kb < 5; ++kb) { const bool bv = (qs - 128 + 32 * kb) >= 0; bias[kb] = bv ? 0.f : -INFINITY; float bm = -INFINITY;
#pragma unroll
        for (int rr = 0; rr < 16; ++rr) { const int key = crow(rr, hi); float v = S[kb][rr];
            if (kb == 0) { v = key >= a ? v : -INFINITY; S[kb][rr] = v; } if (kb == 4) { v = key <= a ? v : -INFINITY; S[kb][rr] = v; }
            bm = fmaxf(bm, v); }
        mr = bv ? fmaxf(mr, bm) : mr; }
    mr = fmaxf(mr, __shfl_xor(mr, 32));
    const float mxs = mr * C2;
    float l = 0.f; v4u pw[5][2];
#pragma unroll
    for (int kb = 0; kb < 5; ++kb) { const float nb = bias[kb] - mxs; float p[16];
#pragma unroll
        for (int rr = 0; rr < 16; ++rr) { p[rr] = __builtin_amdgcn_exp2f(__builtin_fmaf(S[kb][rr], C2, nb)); l += p[rr]; }
#pragma unroll
        for (int st = 0; st < 2; ++st) { pw[kb][st].x = cvtpk(p[8 * st + 0], p[8 * st + 1]); pw[kb][st].y = cvtpk(p[8 * st + 2], p[8 * st + 3]); pw[kb][st].z = cvtpk(p[8 * st + 4], p[8 * st + 5]); pw[kb][st].w = cvtpk(p[8 * st + 6], p[8 * st + 7]); } }
    l += __shfl_xor(l, 32);
#pragma unroll
    for (int i = 0; i < 12; ++i) *(LAS v4u*)(wl + (8 * i + l8) * VP + c8 * 16) = va[i];
    f32x16 o[2]; o[0] = f32x16{}; o[1] = f32x16{};
    const LAS unsigned char* vbase = wl + (4 * hi + ((lane & 15) >> 2)) * VP + (16 * ((lane >> 4) & 1) + 4 * (lane & 3)) * 2;
#pragma unroll
    for (int kb = 0; kb < 5; ++kb) {
        if (kb == 3) {
#pragma unroll
            for (int i = 0; i < 8; ++i) *(LAS v4u*)(wl + (96 + 8 * i + l8) * VP + c8 * 16) = vb[i]; }
#pragma unroll
        for (int st = 0; st < 2; ++st) {
            const bf16x8 pa = __builtin_bit_cast(bf16x8, pw[kb][st]);
#pragma unroll
            for (int cc = 0; cc < 2; ++cc) {
                const s16x4 lo = vtr(vbase + (32 * kb + 16 * st) * VP + cc * 64), hh = vtr(vbase + (32 * kb + 16 * st + 8) * VP + cc * 64);
                const bf16x8 vf = (bf16x8){lo[0], lo[1], lo[2], lo[3], hh[0], hh[1], hh[2], hh[3]};
                o[cc] = __builtin_amdgcn_mfma_f32_32x32x16_bf16(pa, vf, o[cc], 0, 0, 0);
            }
        }
    }
    const float linv = 1.0f / l;
#pragma unroll
    for (int rr = 0; rr < 16; ++rr) { const int q = crow(rr, hi); const float li = __shfl(linv, q);
        const unsigned w = cvtpk(o[0][rr] * li, o[1][rr] * li); LAS bf16* op = (LAS bf16*)(wl + q * VP) + a; op[0] = (bf16)(w & 0xffffu); op[32] = (bf16)(w >> 16); }
#pragma unroll
    for (int i = 0; i < 4; ++i) { const v4u ov = *(const LAS v4u*)(wl + (8 * i + l8) * VP + c8 * 16);
        *(v4u*)(mixed + (size_t)(rowb + ((qs + 8 * i + l8) << s) + r) * D + colq + c8 * 8) = ov; }
    if (hi == 0) lse[(size_t)(rowb + ((qs + a) << s) + r) * 12 + g * 4 + h] = mxs + __builtin_amdgcn_logf(l);
}

__device__ __forceinline__ f32x4 kv_row(const rsrc_t rc, const rsrc_t rp, bool maybe_new, int W, int b, int idx, int sel, int g, int h, int c) {
    if (maybe_new) { const bool nw = idx >= W; const int idc = nw ? W - 1 : idx;
        const f32x4 cv = __builtin_bit_cast(f32x4, bld16(rc, ((b * W + idc) * 2 + sel) * 1024 + (h * 64 + 4 * c) * 4, 0));
        const v2u pw = bld8(rp, (MP + b * 8 + (nw ? idx - W : 0)) * (NIN * 2) + (768 + sel * 768 + g * 256 + h * 64 + 4 * c) * 2, 0);
        const f32x4 pv = {bflo(pw.x), bfhi(pw.x), bflo(pw.y), bfhi(pw.y)};
        return nw ? pv : cv; }
    return __builtin_bit_cast(f32x4, bld16(rc, ((b * W + idx) * 2 + sel) * 1024 + (h * 64 + 4 * c) * 4, 0));
}
__device__ __forceinline__ void sample_group(Frame& F, const rsrc_t rp, int b, int g, int h, int t, const int lane_in, f32x4& o_out, float& lse_out, float* kvout) {
    int lane = lane_in; asm volatile("" : "+v"(lane));
    const int rg = lane >> 4, c = lane & 15;
    const int W = 128 << (2 * g), sh = 2 * g;
    const rsrc_t rc = mk_rsrc(pick3(g, F.c0, F.c1, F.c2));
    const int qrow = MP + b * 8 + t;
    f32x4 q; { const v2u w = bld8(rp, qrow * (NIN * 2) + (g * 256 + h * 64 + 4 * c) * 2, 0); q = (f32x4){bflo(w.x), bfhi(w.x), bflo(w.y), bfhi(w.y)}; }
    f32x4 kv[33]; float sc[33];
    const bool cpy = t < (1 << (g + (g > 0 ? 1 : 0)));
    const rsrc_t ro = mk_rsrc(kvout); const int vo0 = (((b * W + W + t - 8 - (rg << sh)) * 2) * 256 + h * 64 + 4 * c) * 4, vstr = (4 << sh) * 2048;
#pragma unroll
    for (int i0 = 0; i0 < 33; i0 += 33) {
        asm volatile("" ::: "memory");
#pragma unroll
        for (int i = i0; i < i0 + 33 && i < 33; ++i) { int j = 4 * i + rg; j = j > 128 ? 128 : j; kv[i] = kv_row(rc, rp, i < 2, W, b, W + t - (j << sh), 0, g, h, c); }
#pragma unroll
        for (int i = i0; i < i0 + 33 && i < 33; ++i) { float p = (kv[i][0] * q[0] + kv[i][1] * q[1]) + (kv[i][2] * q[2] + kv[i][3] * q[3]);
            p += __shfl_xor(p, 1); p += __shfl_xor(p, 2); p += __shfl_xor(p, 4); p += __shfl_xor(p, 8);
            sc[i] = (4 * i + rg) <= 128 ? p * C2 : -INFINITY;
            { const int j = 4 * i + rg, idx = W + t - (j << sh); if (cpy && j <= 128 && idx >= 8 && idx < W) __builtin_amdgcn_raw_buffer_store_b128(__builtin_bit_cast(v4u, kv[i]), ro, vo0 - i * vstr, 0, 0); } } }
    float mx = sc[0];
#pragma unroll
    for (int i = 1; i < 33; ++i) mx = fmaxf(mx, sc[i]);
    mx = fmaxf(mx, __shfl_xor(mx, 16)); mx = fmaxf(mx, __shfl_xor(mx, 32));
    float l = 0.f;
#pragma unroll
    for (int i = 0; i < 33; ++i) { sc[i] = __builtin_amdgcn_exp2f(sc[i] - mx); l += sc[i]; }
    l += __shfl_xor(l, 16); l += __shfl_xor(l, 32);
    f32x4 o = {0.f, 0.f, 0.f, 0.f};
#pragma unroll
    for (int i0 = 0; i0 < 33; i0 += 33) {
        asm volatile("" ::: "memory");
#pragma unroll
        for (int i = i0; i < i0 + 33 && i < 33; ++i) { int j = 4 * i + rg; j = j > 128 ? 128 : j; kv[i] = kv_row(rc, rp, i < 2, W, b, W + t - (j << sh), 1, g, h, c); }
#pragma unroll
        for (int i = i0; i < i0 + 33 && i < 33; ++i) { o += kv[i] * sc[i];
            const int j = 4 * i + rg, idx = W + t - (j << sh); if (cpy && j <= 128 && idx >= 8 && idx < W) __builtin_amdgcn_raw_buffer_store_b128(__builtin_bit_cast(v4u, kv[i]), ro, vo0 - i * vstr + 1024, 0, 0); } }
#pragma unroll
    for (int e = 0; e < 4; ++e) { float v = o[e]; v += __shfl_xor(v, 16); v += __shfl_xor(v, 32); o[e] = v; }
    const float li = 1.0f / l;
    o_out = o * li; lse_out = mx + __builtin_amdgcn_logf(l);
}
__device__ __forceinline__ void sample_step(Frame& F, const rsrc_t rp, int task, int g, const int lane) {
    const int t = task & 7, h = (task >> 3) & 3, b = task >> 5, rg = lane >> 4, c = lane & 15;
    float* scr = F.PART + (size_t)task * 1024;
    f32x4 o; float ls; sample_group(F, rp, b, g, h, t, lane, o, ls, F.out + (g == 0 ? O_KVS0 : (g == 1 ? O_KVS1 : O_KVS2)));
    if (g < 2) { ((f32x4*)scr)[g * 64 + lane] = o; scr[768 + g * 64 + lane] = ls; return; }
    f32x4 o0 = ((const f32x4*)scr)[lane], o1 = ((const f32x4*)scr)[64 + lane], o2 = o;
    const float l0 = scr[768 + lane], l1 = scr[768 + 64 + lane], l2 = ls;
    const float mx = fmaxf(l0, fmaxf(l1, l2)); const float e0 = __builtin_amdgcn_exp2f(l0 - mx), e1 = __builtin_amdgcn_exp2f(l1 - mx), e2 = __builtin_amdgcn_exp2f(l2 - mx);
    const float inv = 1.0f / (e0 + e1 + e2);
    o0 = o0 * (e0 * inv); o1 = o1 * (e1 * inv); o2 = o2 * (e2 * inv);
    if (rg == 0) { bf16* op = F.MIX + (size_t)(MP + b * 8 + t) * D + h * 64 + 4 * c; v2u w;
        w.x = cvtpk(o0[0], o0[1]); w.y = cvtpk(o0[2], o0[3]); *(v2u*)(op) = w;
        w.x = cvtpk(o1[0], o1[1]); w.y = cvtpk(o1[2], o1[3]); *(v2u*)(op + 256) = w;
        w.x = cvtpk(o2[0], o2[1]); w.y = cvtpk(o2[2], o2[3]); *(v2u*)(op + 512) = w; }
}
}

__device__ __forceinline__ void unpack8(const v4u w, float (&f)[8]) { f[0] = bflo(w.x); f[1] = bfhi(w.x); f[2] = bflo(w.y); f[3] = bfhi(w.y); f[4] = bflo(w.z); f[5] = bfhi(w.z); f[6] = bflo(w.w); f[7] = bfhi(w.w); }
__device__ __forceinline__ void conv_u(const bf16* proj, size_t row, int ch, float (&u)[8]) {
    float cf[8], hf[8]; unpack8(*(const v4u*)(proj + row * NIN + 2560 + 8 * ch), cf); unpack8(*(const v4u*)(proj + row * NIN + 2816 + 8 * ch), hf);
#pragma unroll
    for (int e = 0; e < 8; ++e) u[e] = cf[e] * hf[e];
}
__device__ __forceinline__ void ld8f(const float* p, float (&u)[8]) { const f32x4 a = *(const f32x4*)p, b = *(const f32x4*)(p + 4); u[0] = a[0]; u[1] = a[1]; u[2] = a[2]; u[3] = a[3]; u[4] = b[0]; u[5] = b[1]; u[6] = b[2]; u[7] = b[3]; }

__device__ __forceinline__ void conv_item(Frame& F, int it_in) {
    int it = it_in; asm volatile("" : "+v"(it));

        const int ch = it & 31, row0 = (it >> 5) * 4; const bool smp = row0 >= MP;
        const int t0 = smp ? ((row0 - MP) & 7) : (row0 & (TP - 1)), b = smp ? ((row0 - MP) >> 3) : (row0 >> 13);
        v4u cw[6], hw[6], bw[4];
#pragma unroll
        for (int k = 0; k < 6; ++k) { const int row = row0 - 2 + k; if (k >= 2 || t0 > 0) { cw[k] = *(const v4u*)(F.PROJ + (size_t)row * NIN + 2560 + 8 * ch); hw[k] = *(const v4u*)(F.PROJ + (size_t)row * NIN + 2816 + 8 * ch); } else { cw[k] = (v4u){0u, 0u, 0u, 0u}; hw[k] = cw[k]; } }
#pragma unroll
        for (int k = 0; k < 4; ++k) bw[k] = *(const v4u*)(F.PROJ + (size_t)(row0 + k) * NIN + 2304 + 8 * ch);
        float w0[8], w1[8], w2[8]; ld8f(F.conv_w + 8 * ch, w0); ld8f(F.conv_w + 256 + 8 * ch, w1); ld8f(F.conv_w + 512 + 8 * ch, w2);
        float u[6][8];
#pragma unroll
        for (int k = 0; k < 6; ++k) { float cf[8], hf[8]; unpack8(cw[k], cf); unpack8(hw[k], hf);
#pragma unroll
            for (int e = 0; e < 8; ++e) u[k][e] = cf[e] * hf[e]; }
        if (smp && t0 == 0) { ld8f(F.sconv + ((size_t)b * 2 + 0) * 256 + 8 * ch, u[0]); ld8f(F.sconv + ((size_t)b * 2 + 1) * 256 + 8 * ch, u[1]); }
#pragma unroll
        for (int k = 0; k < 4; ++k) { float bg[8], y[8]; unpack8(bw[k], bg);
#pragma unroll
            for (int e = 0; e < 8; ++e) y[e] = bg[e] * (w0[e] * u[k][e] + w1[e] * u[k + 1][e] + w2[e] * u[k + 2][e]);
            v4u o; o.x = att::cvtpk(y[0], y[1]); o.y = att::cvtpk(y[2], y[3]); o.z = att::cvtpk(y[4], y[5]); o.w = att::cvtpk(y[6], y[7]);
            *(v4u*)(F.MIX + (size_t)(row0 + k) * D + 768 + 8 * ch) = o; }
}
__device__ __forceinline__ void p2_mixers(Frame& F, const int mask) {
    int tid_ = F.tid; asm volatile("" : "+v"(tid_));
    const int lane_ = tid_ & 63;
    const int gt = F.vcu * (NWAVES * 64) + tid_, NGT = F.G * NWAVES * 64;
    const int gw = F.vcu * NWAVES + F.wave, NGW = F.G * NWAVES;
    const att::rsrc_t rp = att::mk_rsrc(F.PROJ), rq = att::mk_rsrc(F.QKVP);
    constexpr int NSTASK = 128 * 4 * 8; int sstep = 0; const int nsteps = gw < NSTASK ? 3 * ((NSTASK - gw + NGW - 1) / NGW) : 0;
    { LAS unsigned char* wl = F.lds + F.wave * att::WTILE;
      constexpr int NCONV = (M / 4) * 32; int cit = gt;
      for (int su = F.vcu; su < 512 || sstep < nsteps || cit < NCONV; su += F.G) { const bool has_su = su < 512; const int b = su >> 6, h = (su >> 4) & 3, rg = su & 15;
#pragma unroll 1
        for (int i = 0; i < 6; ++i) { const int k = F.wave + 8 * i, g = k >> 4, kk = k & 15, tpr = 16 >> (2 * g), r = kk / tpr, j = rg * tpr + kk % tpr;
            if (has_su) att::prompt_tile(rq, F.MIX, F.LSE, wl, b, g, h, r, j, lane_);
            if (!(i & 1) && cit < NCONV) { conv_item(F, cit); cit += NGT; }
            if ((i & 1) && sstep < nsteps) { att::sample_step(F, rp, gw + (sstep / 3) * NGW, sstep % 3, lane_); ++sstep; } }
        if (!has_su) continue;
        asm volatile("s_waitcnt vmcnt(0)" ::: "memory"); __syncthreads(); __builtin_amdgcn_fence(__ATOMIC_ACQUIRE, "workgroup");
        const size_t row0 = (size_t)b * TP + rg * 512;
#pragma unroll 1
        for (int i0 = 0; i0 < 8; i0 += 4) { float ls[4][3]; v4u mw[4][3];
#pragma unroll
            for (int k = 0; k < 4; ++k) { const int it = tid_ + 512 * (i0 + k), ch = it & 7; const size_t row = row0 + (it >> 3);
#pragma unroll
                for (int g = 0; g < 3; ++g) { ls[k][g] = F.LSE[row * 12 + 4 * g + h]; mw[k][g] = *(const v4u*)(F.MIX + row * D + g * 256 + h * 64 + 8 * ch); } }
#pragma unroll
            for (int k = 0; k < 4; ++k) { const int it = tid_ + 512 * (i0 + k), ch = it & 7; const size_t row = row0 + (it >> 3);
                const float mx = fmaxf(ls[k][0], fmaxf(ls[k][1], ls[k][2])); const float e0 = __builtin_amdgcn_exp2f(ls[k][0] - mx), e1 = __builtin_amdgcn_exp2f(ls[k][1] - mx), e2 = __builtin_amdgcn_exp2f(ls[k][2] - mx);
                const float inv = 1.0f / (e0 + e1 + e2); const float al[3] = {e0 * inv, e1 * inv, e2 * inv};
#pragma unroll
                for (int g = 0; g < 3; ++g) { float f[8]; unpack8(mw[k][g], f);
                    v4u o; o.x = att::cvtpk(f[0] * al[g], f[1] * al[g]); o.y = att::cvtpk(f[2] * al[g], f[3] * al[g]); o.z = att::cvtpk(f[4] * al[g], f[5] * al[g]); o.w = att::cvtpk(f[6] * al[g], f[7] * al[g]);
                    *(v4u*)(F.MIX + row * D + g * 256 + h * 64 + 8 * ch) = o; } }
        }
      } }
    if (mask & 8) for (int g = 0; g < 3; ++g) {
        const int W = 128 << (2 * g); float* dst = F.out + (g == 0 ? O_KVP0 : (g == 1 ? O_KVP1 : O_KVP2));
        { const int NK = 8 * W * 64;
          for (int it0 = gt; it0 < NK; it0 += 4 * NGT) { v4u w[4];
#pragma unroll
            for (int k = 0; k < 4; ++k) { const int it = it0 + k * NGT; if (it < NK) { const int ch = it & 31, sel = (it >> 5) & 1, br = it >> 6, rr = br % W, b = br / W;
                const int t = TP - W + rr, sh = 2 * g, prow = (t & ((1 << sh) - 1)) * (TP >> sh) + (t >> sh);
                w[k] = *(const v4u*)(F.QKVP + ((size_t)(((((1 + sel) * 3 + g) * 4 + (ch >> 3)) * 8 + b) * TP + prow)) * 64 + 8 * (ch & 7)); } }
#pragma unroll
            for (int k = 0; k < 4; ++k) { const int it = it0 + k * NGT; if (it < NK) { float f[8]; unpack8(w[k], f);
                float* o = dst + (size_t)it * 8; *(f32x4*)o = (f32x4){f[0], f[1], f[2], f[3]}; *(f32x4*)(o + 4) = (f32x4){f[4], f[5], f[6], f[7]}; } } } }
        float* dsts = F.out + (g == 0 ? O_KVS0 : (g == 1 ? O_KVS1 : O_KVS2));
        for (int it = gt; it < 128 * 8 * 64; it += NGT) { const int ch = it & 31, sel = (it >> 5) & 1, bt = it >> 6, t = bt & 7, b = bt >> 3;
            float f[8]; unpack8(*(const v4u*)(F.PROJ + ((size_t)MP + b * 8 + t) * NIN + 768 + sel * 768 + g * 256 + 8 * ch), f);
            float* o = dsts + (((size_t)b * W + (W - 8 + t)) * 2 + sel) * 256 + 8 * ch; *(f32x4*)o = (f32x4){f[0], f[1], f[2], f[3]}; *(f32x4*)(o + 4) = (f32x4){f[4], f[5], f[6], f[7]}; }
    }
    for (int it = gt; it < 8 * 2 * 32; it += NGT) { const int ch = it & 31, j = (it >> 5) & 1, b = it >> 6; float u[8]; conv_u(F.PROJ, (size_t)b * TP + TP - 2 + j, ch, u);
        float* o = F.out + O_CVP + (size_t)it * 8; *(f32x4*)o = (f32x4){u[0], u[1], u[2], u[3]}; *(f32x4*)(o + 4) = (f32x4){u[4], u[5], u[6], u[7]}; }
    for (int it = gt; it < 128 * 2 * 32; it += NGT) { const int ch = it & 31, j = (it >> 5) & 1, b = it >> 6; float u[8]; conv_u(F.PROJ, (size_t)MP + b * 8 + 6 + j, ch, u);
        float* o = F.out + O_CVS + (size_t)it * 8; *(f32x4*)o = (f32x4){u[0], u[1], u[2], u[3]}; *(f32x4*)(o + 4) = (f32x4){u[4], u[5], u[6], u[7]}; }
}
__device__ __forceinline__ void p6_final(Frame& F) {
    const int gw = F.vcu * NWAVES + F.wave, NGW = F.G * NWAVES;
    f32x4 gf[4];
#pragma unroll
    for (int j = 0; j < 4; ++j) gf[j] = ((const f32x4*)F.g_fin)[2 * (F.lane + 64 * (j >> 1)) + (j & 1)];
    for (int m0 = gw * 4; m0 < M; m0 += NGW * 4) {
        float sp[4]; v4u v[4][2];
#pragma unroll
        for (int r = 0; r < 4; ++r) sp[r] = F.ST2[(size_t)(m0 + r) * 16 + (F.lane & 15)];
#pragma unroll
        for (int r = 0; r < 4; ++r)
#pragma unroll
            for (int j = 0; j < 2; ++j) v[r][j] = ((const v4u*)(F.MIX + (size_t)(m0 + r) * D))[F.lane + 64 * j];
#pragma unroll
        for (int r = 0; r < 4; ++r) { float ss = sp[r]; ss += __shfl_xor(ss, 1); ss += __shfl_xor(ss, 2); ss += __shfl_xor(ss, 4); ss += __shfl_xor(ss, 8);
            const float rstd = __builtin_amdgcn_rsqf(ss * (1.0f / D) + EPS);
#pragma unroll
            for (int j = 0; j < 2; ++j) { float f[8]; unpack8(v[r][j], f); f32x4* o = (f32x4*)(F.out + (size_t)(m0 + r) * D) + 2 * (F.lane + 64 * j);
                o[0] = (f32x4){f[0], f[1], f[2], f[3]} * rstd * gf[2 * j]; o[1] = (f32x4){f[4], f[5], f[6], f[7]} * rstd * gf[2 * j + 1]; } }
    }
}

__device__ __forceinline__ void p6_tail_reduce(Frame& F, const pg8::StaticOrder& S0, const int nfull, const int split) {
    const int gt = F.vcu * (NWAVES * 64) + F.tid, NGT = F.G * NWAVES * 64; const int ntail = S0.nwg - nfull;
    for (int it = gt; it < ntail * 256 * 32; it += NGT) {
        const int ch = it & 31, rw = (it >> 5) & 255, ti = it >> 13; pg8::Unit u; S0.tile(nfull + ti, u);
        const float* p = F.PART + (size_t)ti * split * 65536 + rw * 256 + ch * 8;
        f32x4 s0 = {0.f, 0.f, 0.f, 0.f}, s1 = s0;
#pragma unroll 1
        for (int k0 = 0; k0 < split; k0 += 8) { f32x4 a[8], b[8];
#pragma unroll
            for (int k = 0; k < 8; ++k) { const int kk = k0 + k < split ? k0 + k : 0; a[k] = *(const f32x4*)(p + (size_t)kk * 65536); b[k] = *(const f32x4*)(p + (size_t)kk * 65536 + 4); }
#pragma unroll
            for (int k = 0; k < 8; ++k) if (k0 + k < split) { s0 += a[k]; s1 += b[k]; } }
        const size_t row = (size_t)u.pm * 256 + rw; const size_t off = row * D + u.pn * 256 + ch * 8;
        float xr[8]; unpack8(*(const v4u*)(F.XB + off), xr);
        float o[8] = {s0[0] + xr[0], s0[1] + xr[1], s0[2] + xr[2], s0[3] + xr[3], s1[0] + xr[4], s1[1] + xr[5], s1[2] + xr[6], s1[3] + xr[7]};
        v4u w; w.x = att::cvtpk(o[0], o[1]); w.y = att::cvtpk(o[2], o[3]); w.z = att::cvtpk(o[4], o[5]); w.w = att::cvtpk(o[6], o[7]);
        *(v4u*)(F.MIX + off) = w;
        float ss = ((o[0] * o[0] + o[1] * o[1]) + (o[2] * o[2] + o[3] * o[3])) + ((o[4] * o[4] + o[5] * o[5]) + (o[6] * o[6] + o[7] * o[7]));
        ss += __shfl_xor(ss, 1); ss += __shfl_xor(ss, 2); ss += __shfl_xor(ss, 4); ss += __shfl_xor(ss, 8); ss += __shfl_xor(ss, 16);
        if (ch < 4) F.ST2[row * 16 + u.pn * 4 + ch] = ch == 0 ? ss : 0.f;
    }
}
__device__ __forceinline__ void tail_copy(Frame& F, int first, int count, int n_busy) {
    const int bid = (int)blockIdx.x; if (bid < n_busy) return;
    const int rank = bid - n_busy, nidle = F.G - n_busy, toff = F.tid * 16;
    const __amdgpu_buffer_rsrc_t rs_ = __builtin_amdgcn_make_buffer_rsrc((void*)F.c2, 0, 0x7fffffff, 0x00020000), rd_ = __builtin_amdgcn_make_buffer_rsrc((void*)(F.out + O_KVS2), 0, 0x7fffffff, 0x00020000);
    for (int k0 = rank * 4; k0 < count; k0 += nidle * 4) {
        v4u cp[8]; int dof[4];
#pragma unroll
        for (int k = 0; k < 4; ++k) { int blk = first + (k0 + k < count ? k0 + k : count - 1); blk = blk >= pg8::CP_NBLK ? pg8::CP_NBLK - 1 : blk; const int b = blk >> 7, q = blk & 127; dof[k] = ((b * 2048 + 16 * q) * 512) * 4;
            cp[2 * k] = __builtin_amdgcn_raw_buffer_load_b128(rs_, toff, dof[k] + 16384, 2); cp[2 * k + 1] = __builtin_amdgcn_raw_buffer_load_b128(rs_, toff, dof[k] + 16384 + 8192, 2); }
#pragma unroll
        for (int k = 0; k < 4; ++k) { __builtin_amdgcn_raw_buffer_store_b128(cp[2 * k], rd_, toff, dof[k], 2); __builtin_amdgcn_raw_buffer_store_b128(cp[2 * k + 1], rd_, toff, dof[k] + 8192, 2); }
    }
}
__device__ __forceinline__ void stagger_start(int us) {
    const unsigned long long t0 = __builtin_amdgcn_s_memrealtime(), dt = (unsigned long long)(((blockIdx.x >> 3) & 3) * us * 100);
    while (__builtin_amdgcn_s_memrealtime() - t0 < dt) __builtin_amdgcn_s_sleep(16);
}
#define XB_TMO      128
#define XB_XCNT(j)  (256  + 64 * (j))
#define XB_XSUB(j)  (1280 + 64 * (j))
#define XB_XGEN(j)  (2304 + 64 * (j))
#define XB_TOP      3328
#define XB_TOPGEN   3392
#define XCD_BAR_WORDS 3456
#define XB_SPIN_CAP (1u << 18)
__device__ __forceinline__ unsigned xb_ld(unsigned* p)              { return __hip_atomic_load(p, __ATOMIC_RELAXED, __HIP_MEMORY_SCOPE_AGENT); }
__device__ __forceinline__ unsigned xb_add(unsigned* p, unsigned v) { return __hip_atomic_fetch_add(p, v, __ATOMIC_RELAXED, __HIP_MEMORY_SCOPE_AGENT); }
__device__ __forceinline__ unsigned xb_xcc_id() { return (unsigned)__builtin_amdgcn_s_getreg((3 << 11) | 20) & 0xFu; }
#define XB_SPIN(cond, bar) do { unsigned _sp = 0; while (cond) { __builtin_amdgcn_s_sleep(1); \
    if ((++_sp & 255u) == 0u) { if (xb_ld(&(bar)[XB_TMO])) break; if (_sp > XB_SPIN_CAP) { atomicAdd(&(bar)[XB_TMO], 1u); break; } } } } while (0)
struct XcdBarrier { unsigned* bar; unsigned x, nloc, nx; };
__device__ __forceinline__ void xcd_barrier_complete(unsigned* bar, unsigned x, unsigned& nloc, unsigned& nx) {
    const unsigned G = gridDim.x * gridDim.y * gridDim.z;
    unsigned sum, cnt, mine, sp = 0u;
    for (;;) {
        sum = 0u; cnt = 0u; mine = 0u;
#pragma unroll
        for (unsigned j = 0; j < 16; ++j) { const unsigned c = xb_ld(&bar[XB_XCNT(j)]); sum += c; cnt += (c > 0u) ? 1u : 0u; mine = (j == x) ? c : mine; }
        if (sum == G) break;
        __builtin_amdgcn_s_sleep(1);
        if ((++sp & 255u) == 0u) { if (xb_ld(&bar[XB_TMO])) break; if (sp > XB_SPIN_CAP) { atomicAdd(&bar[XB_TMO], 1u); break; } }
    }
    nloc = mine > 0u ? mine : 1u; nx = cnt > 0u ? cnt : 1u;
}
__device__ __forceinline__ void xcd_barrier(XcdBarrier& b) {
    asm volatile("s_waitcnt vmcnt(0)" ::: "memory");
    __syncthreads();
    if (threadIdx.x == 0) {
        unsigned* bar = b.bar;
        __builtin_amdgcn_s_waitcnt(0);
        if (b.nloc == 0u) xcd_barrier_complete(bar, b.x, b.nloc, b.nx);
        const unsigned nloc = b.nloc, nx = b.nx;
        const unsigned old = xb_add(&bar[XB_XSUB(b.x)], 1u);
        const unsigned gen = old / nloc;
        if (old + 1u == (gen + 1u) * nloc) {
            __builtin_amdgcn_fence(__ATOMIC_RELEASE, "agent");
            asm volatile("s_waitcnt vmcnt(0)" ::: "memory");
            const unsigned og = xb_add(&bar[XB_TOP], 1u);
            const unsigned tg = og / nx;
            if (og + 1u == (tg + 1u) * nx) xb_add(&bar[XB_TOPGEN], 1u);
            else XB_SPIN(xb_ld(&bar[XB_TOPGEN]) == tg, bar);
            __builtin_amdgcn_fence(__ATOMIC_ACQUIRE, "agent");
            xb_add(&bar[XB_XGEN(b.x)], 1u);
            asm volatile("s_waitcnt vmcnt(0)" ::: "memory");
        } else {
            XB_SPIN(xb_ld(&bar[XB_XGEN(b.x)]) == gen, bar);
            __builtin_amdgcn_fence(__ATOMIC_ACQUIRE, "agent");
            asm volatile("s_waitcnt vmcnt(0)" ::: "memory");
        }
    }
    __syncthreads();
}
struct Args { const float* in[14]; float* out; unsigned char* ws; int ph_lo, ph_hi, probe, pad; };
__global__ void __launch_bounds__(NWAVES * 64, 2) mega_fwd(Args args) {
    extern __shared__ __attribute__((aligned(16))) unsigned char lds[];
    cg::grid_group grid = cg::this_grid();
    Frame F;
    F.lds = (LAS unsigned char*)lds;
    F.tid = threadIdx.x; F.lane = F.tid & 63; F.wave = __builtin_amdgcn_readfirstlane(F.tid >> 6);
    F.G = gridDim.x; { const int bx = blockIdx.x; F.vcu = (F.G % 8 == 0) ? (bx % 8) * (F.G / 8) + bx / 8 : bx; }
    unsigned char* ws = args.ws;
    F.xp = args.in[0]; F.xs = args.in[1]; F.c0 = args.in[2]; F.c1 = args.in[3]; F.c2 = args.in[4]; F.sconv = args.in[5]; F.g_attn = args.in[6]; F.w_in = args.in[7];
    F.conv_w = args.in[8]; F.w_out = args.in[9]; F.g_mlp = args.in[10]; F.w_up = args.in[11]; F.w_down = args.in[12]; F.g_fin = args.in[13]; F.out = args.out;
    F.Win_t = (bf16*)(ws + WS_WIN); F.Wout_t = (bf16*)(ws + WS_WOUT); F.Wup_t = (bf16*)(ws + WS_WUP); F.Wdn_t = (bf16*)(ws + WS_WDN);
    F.XB = (bf16*)(ws + WS_XB); F.PROJ = (bf16*)(ws + WS_PROJ); F.MIX = (bf16*)(ws + WS_MIX); F.HB = (bf16*)(ws + WS_HB); F.QKVP = (bf16*)(ws + WS_QKVP);
    F.RSTD0 = (float*)(ws + WS_RSTD0); F.ST1 = (float*)(ws + WS_ST1); F.ST2 = (float*)(ws + WS_ST2); F.LSE = (float*)(ws + WS_LSE); F.PART = (float*)(ws + WS_PART); F.PART = (float*)(ws + WS_PART); F.CNT = (unsigned*)(ws + WS_CNT);
    const int lo = args.ph_lo, hi = args.ph_hi;
    XcdBarrier xbar; xbar.bar = (unsigned*)(ws + WS_BAR); xbar.x = xb_xcc_id(); xbar.nloc = 0u; xbar.nx = 0u;
    if (hi - lo > 1 && threadIdx.x == 0) (void)xb_add(&xbar.bar[XB_XCNT(xbar.x)], 1u);
#define IN(k) (lo <= (k) && (k) < hi)
#define SEAM(k) do { if (IN(k) && IN((k) + 1)) xcd_barrier(xbar); } while (0)
    if (args.probe == 0x7fffffff) grid.sync();

    if (IN(0)) { p0_prologue(F); if (PROBE_REP == 0) p0_prologue(F); }
    SEAM(0);
    if (IN(1)) {
        pg8::Gemm g{F.XB, F.Win_t, M, NIN, D}; pg8::StaticOrder S; S.init(M, NIN, F.G, (int)blockIdx.x, REP_G1);
        pg8::EpiScaleBf16<0> E{F.PROJ, NIN, F.RSTD0, EPS, pg8::CopyJob{nullptr, nullptr, 0}, F.QKVP, MP};
        pg8::gemm_phase<pg8::EpiScaleBf16<0>, pg8::StaticOrder, PG8_ALIGN, PG8_SP2>(F.lds, g, S, E);
        tail_copy(F, 0, 4608, S.nwg % F.G);
    }
    SEAM(1);
    if (IN(2)) p2_mixers(F, 15);
    SEAM(2);
    if (IN(4)) {
        pg8::Gemm g{F.MIX, F.Wout_t, M, D, D}; pg8::StaticOrder S; S.init(M, D, F.G, (int)blockIdx.x, REP_G4);
        pg8::EpiResBf16 E{F.XB, F.XB, F.ST1};
        pg8::gemm_phase<pg8::EpiResBf16, pg8::StaticOrder, PG8_ALIGN, PG8_SP2>(F.lds, g, S, E);
        tail_copy(F, 4608, 6720, S.nwg % F.G);
    }
    SEAM(4);
    if (IN(5)) {
        pg8::Gemm g{F.XB, F.Wup_t, M, FF, D}; pg8::StaticOrder S; S.init(M, FF, F.G, (int)blockIdx.x, REP_G5);
        pg8::EpiScaleBf16<1> E{F.HB, FF, F.ST1, EPS, pg8::CopyJob{F.c2, F.out + O_KVS2, 0}, nullptr, 0};
        pg8::gemm_phase<pg8::EpiScaleBf16<1>, pg8::StaticOrder, PG8_ALIGN, PG8_SP2>(F.lds, g, S, E);
        tail_copy(F, 4608 + 6720, pg8::CP_NBLK - 4608 - 6720, S.nwg % F.G);
    }
    SEAM(5);
    if (IN(6)) {
        constexpr int NWG6 = (M / 256) * (D / 256);
        int nfull = (NWG6 / F.G) * F.G, ntail = NWG6 - nfull, split = P6_SPLIT; const int cap = F.G < 256 ? F.G : 256;
        while (split > 1 && ntail * split > cap) split >>= 1;
        if (ntail * split > cap || hi - lo == 1) { nfull = NWG6; ntail = 0; }
        pg8::Gemm g{F.HB, F.Wdn_t, M, D, FF}; pg8::StaticOrder S; S.init(M, D, F.G, (int)blockIdx.x, 1, nfull);
        pg8::EpiResBf16 E{F.XB, F.MIX, F.ST2};
        pg8::gemm_phase<pg8::EpiResBf16, pg8::StaticOrder, PG8_ALIGN, PG8_SP2>(F.lds, g, S, E);
        if (ntail > 0) {
            pg8::StaticOrder S0; S0.init(M, D, F.G, (int)blockIdx.x); const pg8::TailOrder T{S0, nfull, split};
            pg8::EpiPartial EP{F.PART, nfull};
            pg8::gemm_phase<pg8::EpiPartial, pg8::TailOrder, PG8_ALIGN, PG8_SP2>(F.lds, g, T, EP);
            xcd_barrier(xbar);
            p6_tail_reduce(F, S0, nfull, split);
        }
    }
    SEAM(6);
    if (IN(7)) p6_final(F);
#undef IN
#undef SEAM
}

extern "C" void kernel_launch(void* const* d_in, const int* in_sizes, int n_in, void* d_out, int out_size, void* d_ws, size_t ws_size, hipStream_t stream) {
    static int grid = 0;
    if (grid == 0) {
        if (n_in != 14 || in_sizes[0] != MP * D || (size_t)out_size != O_END || ws_size < WS_END) { fprintf(stderr, "kernel_launch: unexpected shapes (n_in %d, in0 %d, out %d, ws %zu); nothing launched\n", n_in, n_in > 0 ? in_sizes[0] : -1, out_size, ws_size); grid = -1; return; }
        int dev = 0, cus = 0, per_cu = 0;
        if (hipGetDevice(&dev) != hipSuccess || hipDeviceGetAttribute(&cus, hipDeviceAttributeMultiprocessorCount, dev) != hipSuccess) { grid = -1; return; }
        if (hipFuncSetAttribute((const void*)mega_fwd, hipFuncAttributeMaxDynamicSharedMemorySize, LDS_BYTES) != hipSuccess) { fprintf(stderr, "kernel_launch: hipFuncSetAttribute failed\n"); grid = -1; return; }
        if (hipOccupancyMaxActiveBlocksPerMultiprocessor(&per_cu, (const void*)mega_fwd, NWAVES * 64, LDS_BYTES) != hipSuccess || per_cu < 1) { fprintf(stderr, "kernel_launch: occupancy query failed (%d)\n", per_cu); (void)hipGetLastError(); grid = -1; return; }
        grid = cus;
    }
    if (grid < 0) return;
    Args a{};
    for (int i = 0; i < 14; ++i) a.in[i] = (const float*)d_in[i];
    a.out = (float*)d_out; a.ws = (unsigned char*)d_ws; a.probe = PROBE_P2MASK;
    if (MK_N_LAUNCHES == 1) {
        if (hipMemsetAsync((char*)d_ws + WS_BAR, 0, WS_BAR_BYTES, stream) != hipSuccess) { fprintf(stderr, "kernel_launch: hipMemsetAsync of the barrier words failed\n"); return; }
        a.ph_lo = 0; a.ph_hi = 8;
        void* kargs[] = {&a};
        const hipError_t e = hipLaunchCooperativeKernel((const void*)mega_fwd, dim3(grid), dim3(NWAVES * 64), kargs, LDS_BYTES, stream);
        if (e != hipSuccess) fprintf(stderr, "kernel_launch: cooperative launch failed: %s (grid %d)\n", hipGetErrorString(e), grid);
    } else {
        for (int p = 0; p < 8; ++p) { a.ph_lo = p; a.ph_hi = p + 1; hipLaunchKernelGGL(mega_fwd, dim3(grid), dim3(NWAVES * 64), LDS_BYTES, stream, a); }
    }
}
```

```cpp
#include <hip/hip_runtime.h>
#include <cstdio>
#include <cstdint>
#include <hip/hip_cooperative_groups.h>
namespace cg = cooperative_groups;
namespace pg8 {
#define PG8_LAS __attribute__((address_space(3)))
typedef unsigned short bf16_t;
typedef short bf16x8 __attribute__((ext_vector_type(8)));
typedef float f32x4 __attribute__((ext_vector_type(4)));
typedef unsigned u32x4 __attribute__((ext_vector_type(4)));
constexpr int BM = 256, BK = 64, HALF = 128, HTB = HALF * BK * 2  , STAGE_BYTES = 8 * HTB, NXCD = 8, WGM = 8;

__host__ __device__ __forceinline__ int lds_byte(int r, int c) { const int st = (r >> 4) * 2 + (c >> 5), rr = r & 15, cc = c & 31, ob = rr * 64 + cc * 2; return st * 1024 + (ob ^ (((ob >> 9) & 1) << 5)); }
__host__ __device__ __forceinline__ void stage_rc(int b, int& R, int& C) { const int st = b / 1024, sb = b % 1024, swz = sb ^ (((sb >> 9) & 1) << 5); R = (st >> 1) * 16 + swz / 64; C = (st & 1) * 32 + (swz % 64) / 2; }
__host__ __device__ __forceinline__ int perm32(int rho) { const int n = rho >> 4, i = rho & 15; return 8 * (i >> 2) + 4 * n + (i & 3); }

struct Unit { int pm, pn, lin, ks, ns; };
struct Gemm { const bf16_t* A; const bf16_t* Bt; int M, N, K; };

struct StaticOrder {
    int nM, nN, nwg, G, c, rep, lim;
    __host__ __device__ void init(int M, int N, int G_, int c_, int rep_ = 1, int lim_ = 0) { nM = M / BM; nN = N / BM; nwg = nM * nN; G = G_; c = c_; rep = rep_; lim = lim_ > 0 ? lim_ : nwg; }
    __host__ __device__ void tile(int wgid, Unit& u) const {
        { const int q = nwg / NXCD, r = nwg % NXCD, xcd = wgid % NXCD, off = wgid / NXCD; wgid = (xcd < r ? xcd * (q + 1) : r * (q + 1) + (xcd - r) * q) + off; }
        const int nig = WGM * nN, gid = wgid / nig, fm = gid * WGM, gsz = (nM - fm) < WGM ? (nM - fm) : WGM;
        u.pm = fm + ((wgid % nig) % gsz); u.pn = (wgid % nig) / gsz;
    }
    __host__ __device__ bool next(int i, Unit& u) const {
        long L = (long)i * G + c; if (L >= (long)lim * rep) return false; L %= lim;
        u.lin = (int)L; u.ks = 0; u.ns = 1; tile((int)L, u); return true;
    }
    __device__ __forceinline__ void a_ready(const Unit&) const {}
    __device__ __forceinline__ void done(const Unit&) const {}
};
struct TailOrder {
    StaticOrder so; int first, S;
    __device__ bool next(int i, Unit& u) const {
        if (i > 0) return false; const int item = so.c; if (item >= (so.nwg - first) * S) return false;
        u.lin = first + item / S; u.ks = item % S; u.ns = S; so.tile(u.lin, u); return true;
    }
    __device__ __forceinline__ void a_ready(const Unit&) const {}
    __device__ __forceinline__ void done(const Unit&) const {}
};

__device__ __forceinline__ unsigned cvt_pk_bf16(float lo, float hi) { unsigned r; asm volatile("v_cvt_pk_bf16_f32 %0, %1, %2" : "=v"(r) : "v"(lo), "v"(hi)); return r; }
typedef float f32x2 __attribute__((ext_vector_type(2)));
constexpr int CP_NBLK = 128 * 128;
struct CopyJob { const float* s2; float* d2; int on; };
template <int MODE> struct EpiScaleBf16 {
    static constexpr bool PERM = true, AFTER_DRAIN = false;
    bf16_t* O; int ldc; const float* rs; float eps; CopyJob cj; bf16_t* QKVP; int perm_rows;
    __device__ __forceinline__ void operator()(const f32x4 (&acc)[2][2][4][2], const Unit& u, int wr, int wc, int fr, int fq) const {
        const int row0 = u.pm * BM + wr * 64 + fr; const int col0 = u.pn * BM + wc * 32 + 8 * fq;
        float sc[8];
        if (MODE == 0) {
#pragma unroll
            for (int i = 0; i < 8; ++i) sc[i] = rs[row0 + (i >> 2) * HALF + (i & 3) * 16];
        } else {
            f32x4 pv[8];
#pragma unroll
            for (int i = 0; i < 8; ++i) pv[i] = *(const f32x4*)(rs + (size_t)(row0 + (i >> 2) * HALF + (i & 3) * 16) * 16 + 4 * fq);
#pragma unroll
            for (int i = 0; i < 8; ++i) { float ss = (pv[i][0] + pv[i][1]) + (pv[i][2] + pv[i][3]); ss += __shfl_xor(ss, 16); ss += __shfl_xor(ss, 32);
                sc[i] = __builtin_amdgcn_rsqf(ss * (1.0f / 1024.0f) + eps); }
        }
        u32x4 cp[8]; int so[4], dof[4]; const int toff = threadIdx.x * 16;
        if (MODE == 1 && cj.on) {
#pragma unroll
            for (int k = 0; k < 4; ++k) { int blk = __builtin_amdgcn_readfirstlane(4 * u.lin + k); blk = blk >= CP_NBLK ? CP_NBLK - 1 : blk;
                const int b = blk >> 7, q = blk & 127; dof[k] = ((b * 2048 + 16 * q) * 512) * 4; so[k] = dof[k] + 8 * 512 * 4; }
            const __amdgpu_buffer_rsrc_t rs_ = __builtin_amdgcn_make_buffer_rsrc((void*)cj.s2, 0, 0x7fffffff, 0x00020000);
#pragma unroll
            for (int k = 0; k < 4; ++k) { cp[2 * k] = __builtin_amdgcn_raw_buffer_load_b128(rs_, toff, so[k], 2); cp[2 * k + 1] = __builtin_amdgcn_raw_buffer_load_b128(rs_, toff, so[k] + 8192, 2); }
            asm volatile("" ::: "memory");
        }
#pragma unroll
        for (int ai = 0; ai < 2; ++ai)
#pragma unroll
            for (int m = 0; m < 4; ++m) { const int row = row0 + ai * HALF + m * 16; const float s1 = sc[ai * 4 + m];
                bf16_t* rowp = O + (size_t)row * ldc + col0; int bjs = HALF;
                if (MODE == 0 && QKVP != nullptr && u.pn < 9 && u.pm * BM < perm_rows) {
                    const int sel = u.pn / 3, g = u.pn - 3 * sel, sh = 2 * g, b = row >> 13, t = row & 8191, prow = (t & ((1 << sh) - 1)) * (8192 >> sh) + (t >> sh);
                    rowp = QKVP + ((size_t)((((sel * 3 + g) * 4 + (wc >> 1)) * 8 + b) * 8192 + prow)) * 64 + (wc & 1) * 32 + 8 * fq; bjs = 2 * 8 * 8192 * 64; }
#pragma unroll
                for (int bj = 0; bj < 2; ++bj) { f32x4 v0 = acc[ai][bj][m][0] * s1, v1 = acc[ai][bj][m][1] * s1;
                    if (MODE == 1) {
#pragma unroll
                        for (int e = 0; e < 4; ++e) { const float x0 = fmaxf(v0[e], 0.f), x1 = fmaxf(v1[e], 0.f); v0[e] = x0 * x0; v1[e] = x1 * x1; } }
                    u32x4 w; w.x = cvt_pk_bf16(v0[0], v0[1]); w.y = cvt_pk_bf16(v0[2], v0[3]); w.z = cvt_pk_bf16(v1[0], v1[1]); w.w = cvt_pk_bf16(v1[2], v1[3]);
                    *(u32x4*)(rowp + (size_t)bj * bjs) = w; } }
        if (MODE == 1 && cj.on) {
            asm volatile("" ::: "memory");
            const __amdgpu_buffer_rsrc_t rd_ = __builtin_amdgcn_make_buffer_rsrc((void*)cj.d2, 0, 0x7fffffff, 0x00020000);
#pragma unroll
            for (int k = 0; k < 4; ++k) { __builtin_amdgcn_raw_buffer_store_b128(cp[2 * k], rd_, toff, dof[k], 2); __builtin_amdgcn_raw_buffer_store_b128(cp[2 * k + 1], rd_, toff, dof[k] + 8192, 2); }
        }
    }
};
struct EpiResBf16 {
    static constexpr bool PERM = true, AFTER_DRAIN = false;
    const bf16_t* xin; bf16_t* xio; float* stats;
    __device__ __forceinline__ void operator()(const f32x4 (&acc)[2][2][4][2], const Unit& u, int wr, int wc, int fr, int fq) const {
        const int row0 = u.pm * BM + wr * 64 + fr; const int col0 = u.pn * BM + wc * 32 + 8 * fq;
#pragma unroll
        for (int ai = 0; ai < 2; ++ai) { u32x4 rw[4][2];
#pragma unroll
            for (int m = 0; m < 4; ++m)
#pragma unroll
                for (int bj = 0; bj < 2; ++bj) rw[m][bj] = *(const u32x4*)(xin + (size_t)(row0 + ai * HALF + m * 16) * 1024 + col0 + bj * HALF);
#pragma unroll
            for (int m = 0; m < 4; ++m) { const int row = row0 + ai * HALF + m * 16; float ss = 0.f;
#pragma unroll
                for (int bj = 0; bj < 2; ++bj) { const u32x4 r = rw[m][bj];
                    f32x4 o0 = acc[ai][bj][m][0], o1 = acc[ai][bj][m][1];
                    o0[0] += __builtin_bit_cast(float, r.x << 16); o0[1] += __builtin_bit_cast(float, r.x & 0xffff0000u); o0[2] += __builtin_bit_cast(float, r.y << 16); o0[3] += __builtin_bit_cast(float, r.y & 0xffff0000u);
                    o1[0] += __builtin_bit_cast(float, r.z << 16); o1[1] += __builtin_bit_cast(float, r.z & 0xffff0000u); o1[2] += __builtin_bit_cast(float, r.w << 16); o1[3] += __builtin_bit_cast(float, r.w & 0xffff0000u);
                    u32x4 w; w.x = cvt_pk_bf16(o0[0], o0[1]); w.y = cvt_pk_bf16(o0[2], o0[3]); w.z = cvt_pk_bf16(o1[0], o1[1]); w.w = cvt_pk_bf16(o1[2], o1[3]);
                    *(u32x4*)(xio + (size_t)row * 1024 + col0 + bj * HALF) = w;
                    ss += ((o0[0] * o0[0] + o0[1] * o0[1]) + (o0[2] * o0[2] + o0[3] * o0[3])) + ((o1[0] * o1[0] + o1[1] * o1[1]) + (o1[2] * o1[2] + o1[3] * o1[3])); }
                ss += __shfl_xor(ss, 16); ss += __shfl_xor(ss, 32);
                if (fq == 0) stats[(size_t)row * 16 + u.pn * 4 + wc] = ss; }
            asm volatile("" ::: "memory"); }
    }
};
struct EpiPartial {
    static constexpr bool PERM = true, AFTER_DRAIN = false;
    float* part; int first;
    __device__ __forceinline__ void operator()(const f32x4 (&acc)[2][2][4][2], const Unit& u, int wr, int wc, int fr, int fq) const {
        float* base = part + (size_t)((u.lin - first) * u.ns + u.ks) * 65536 + (wr * 64 + fr) * 256 + wc * 32 + 8 * fq;
#pragma unroll
        for (int ai = 0; ai < 2; ++ai)
#pragma unroll
            for (int m = 0; m < 4; ++m)
#pragma unroll
                for (int bj = 0; bj < 2; ++bj) { float* p = base + (ai * HALF + m * 16) * 256 + bj * HALF; *(f32x4*)p = acc[ai][bj][m][0]; *(f32x4*)(p + 4) = acc[ai][bj][m][1]; }
    }
};
template <class Epi, class Sched, bool ALIGN_EPI = false, bool SP2 = false>
__device__ __forceinline__ void gemm_phase(PG8_LAS unsigned char* lds, const Gemm g, const Sched& S, const Epi& E) {
    const int tid = threadIdx.x, wid = __builtin_amdgcn_readfirstlane(tid >> 6), lane = tid & 63, wr = wid >> 2, wc = wid & 3, fr = lane & 15, fq = lane >> 4;
    const int K = g.K;
    unsigned voffA[2], voffB[2];
#pragma unroll
    for (int i = 0; i < 2; ++i) { int R, C; stage_rc(tid * 16 + i * 8192, R, C); const int Rb = Epi::PERM ? ((R & ~31) + perm32(R & 31)) : R;
        voffA[i] = (unsigned)(R * K + C) * 2u; voffB[i] = (unsigned)(Rb * K + C) * 2u; }
    const size_t kstep = (size_t)(BK * 2);
    const size_t hstep = (size_t)HALF * K * 2;
    const size_t tstep = 2 * hstep;
    const unsigned ldsw = (unsigned)wid * 1024u;
    const int aoff = lds_byte(wr * 64 + fr, fq * 8), boff = lds_byte(wc * 32 + fr, fq * 8);
#define PG8_SA(b, h) (((b) * 2 + (h)) * HTB)
#define PG8_SB(b, h) ((4 + (b) * 2 + (h)) * HTB)
#define PG8_STAGE(bufoff, gbase, voff) do { _Pragma("unroll") for (int _i = 0; _i < 2; ++_i) \
        __builtin_amdgcn_global_load_lds((const unsigned*)((const char*)(gbase) + (voff)[_i]), (PG8_LAS unsigned*)(lds + (bufoff) + ldsw + _i * 8192), 16, 0, 0); } while (0)
#define PG8_LDA(dst, b, h) do { _Pragma("unroll") for (int m = 0; m < 4; ++m) _Pragma("unroll") for (int k = 0; k < 2; ++k) dst[m][k] = *(const PG8_LAS bf16x8*)(lds + PG8_SA(b, h) + aoff + m * 2048 + k * 1024); } while (0)
#define PG8_LDB(dst, b, h) do { _Pragma("unroll") for (int n = 0; n < 2; ++n) _Pragma("unroll") for (int k = 0; k < 2; ++k) dst[n][k] = *(const PG8_LAS bf16x8*)(lds + PG8_SB(b, h) + boff + n * 2048 + k * 1024); } while (0)
#define PG8_MMA(ai, bj, At, Bt) do { __builtin_amdgcn_s_setprio(1); _Pragma("unroll") for (int m = 0; m < 4; ++m) _Pragma("unroll") for (int n = 0; n < 2; ++n) _Pragma("unroll") for (int k = 0; k < 2; ++k) \
        acc[ai][bj][m][n] = __builtin_amdgcn_mfma_f32_16x16x32_bf16(Bt[n][k], At[m][k], acc[ai][bj][m][n], 0, 0, 0); __builtin_amdgcn_s_setprio(0); } while (0)
#define PG8_WAIT_V(n) asm volatile("s_waitcnt vmcnt(" #n ")" ::: "memory")
#define PG8_WAIT_L(n) asm volatile("s_waitcnt lgkmcnt(" #n ")" ::: "memory")
#define PG8_BAR __builtin_amdgcn_s_barrier()
#define PG8_SCHED __builtin_amdgcn_sched_barrier(0)
    Unit cur, nxt; int ui = 0;
    if (!S.next(0, cur)) return;
    f32x4 acc[2][2][4][2];
#pragma unroll
    for (int a = 0; a < 2; ++a)
#pragma unroll
        for (int b = 0; b < 2; ++b)
#pragma unroll
            for (int m = 0; m < 4; ++m)
#pragma unroll
                for (int n = 0; n < 2; ++n) acc[a][b][m][n] = (f32x4){0.f, 0.f, 0.f, 0.f};
    bf16x8 At[4][2], B0[2][2], B1[2][2];
    int nt = K / BK / cur.ns; const size_t koff = (size_t)cur.ks * nt * kstep;
    const char* cA = (const char*)g.A + (size_t)cur.pm * tstep + koff; const char* cB = (const char*)g.Bt + (size_t)cur.pn * tstep + koff;
    S.a_ready(cur);
    if constexpr (SP2) {
        PG8_STAGE(PG8_SB(0, 0), cB, voffB); PG8_STAGE(PG8_SB(0, 1), cB + hstep, voffB); PG8_STAGE(PG8_SA(0, 0), cA, voffA); PG8_STAGE(PG8_SA(0, 1), cA + hstep, voffA);
        if (wr == 1) PG8_BAR;
        PG8_WAIT_V(2); PG8_BAR;
        PG8_STAGE(PG8_SB(1, 0), cB + kstep, voffB); PG8_STAGE(PG8_SA(1, 0), cA + kstep, voffA); PG8_STAGE(PG8_SB(1, 1), cB + hstep + kstep, voffB);
        PG8_WAIT_V(6); PG8_BAR;
    } else {
        PG8_STAGE(PG8_SB(0, 0), cB, voffB); PG8_STAGE(PG8_SA(0, 0), cA, voffA); PG8_STAGE(PG8_SB(0, 1), cB + hstep, voffB); PG8_STAGE(PG8_SA(0, 1), cA + hstep, voffA);
        if (wr == 1) PG8_BAR;
        PG8_WAIT_V(4); PG8_BAR;
        PG8_STAGE(PG8_SB(1, 0), cB + kstep, voffB); PG8_STAGE(PG8_SA(1, 0), cA + kstep, voffA); PG8_STAGE(PG8_SB(1, 1), cB + hstep + kstep, voffB);
        PG8_WAIT_V(6); PG8_BAR;
    }
    for (;;) {
        const bool has_next = S.next(ui + 1, nxt);
        const int nnt = has_next ? K / BK / nxt.ns : nt; const size_t nkoff = has_next ? (size_t)nxt.ks * nnt * kstep : 0;
        const char* nA = has_next ? (const char*)g.A + (size_t)nxt.pm * tstep + nkoff : cA; const char* nB = has_next ? (const char*)g.Bt + (size_t)nxt.pn * tstep + nkoff : cB;
        for (int t = 0; t < nt; t += 2) {
            const bool last = (t == nt - 2);
            const char* a1 = cA + (size_t)(t + 1) * kstep;
            const char* a2 = last ? nA : cA + (size_t)(t + 2) * kstep; const char* b2 = last ? nB : cB + (size_t)(t + 2) * kstep;
            const char* a3 = a2 + kstep; const char* b3 = b2 + kstep;
            if (last && has_next) S.a_ready(nxt);
            if constexpr (SP2) {
            PG8_LDB(B0, 0, 0); PG8_LDB(B1, 0, 1); PG8_SCHED; PG8_LDA(At, 0, 0); PG8_STAGE(PG8_SA(1, 1), a1 + hstep, voffA);
            PG8_WAIT_V(8); PG8_WAIT_L(0); PG8_BAR; PG8_MMA(0, 0, At, B0); PG8_MMA(0, 1, At, B1); PG8_BAR; PG8_SCHED;
            PG8_LDA(At, 0, 1); PG8_STAGE(PG8_SB(0, 0), b2, voffB); PG8_STAGE(PG8_SB(0, 1), b2 + hstep, voffB); PG8_STAGE(PG8_SA(0, 0), a2, voffA);
            PG8_WAIT_V(8); PG8_WAIT_L(0); PG8_BAR; PG8_MMA(1, 0, At, B0); PG8_MMA(1, 1, At, B1); PG8_BAR; PG8_SCHED;
            PG8_LDB(B0, 1, 0); PG8_LDB(B1, 1, 1); PG8_SCHED; PG8_LDA(At, 1, 0); PG8_STAGE(PG8_SA(0, 1), a2 + hstep, voffA);
            PG8_WAIT_V(8); PG8_WAIT_L(0); PG8_BAR; PG8_MMA(0, 0, At, B0); PG8_MMA(0, 1, At, B1); PG8_BAR; PG8_SCHED;
            PG8_LDA(At, 1, 1); PG8_STAGE(PG8_SB(1, 0), b3, voffB); PG8_STAGE(PG8_SB(1, 1), b3 + hstep, voffB); PG8_STAGE(PG8_SA(1, 0), a3, voffA);
            PG8_WAIT_V(8); PG8_WAIT_L(0); PG8_BAR; PG8_MMA(1, 0, At, B0); PG8_MMA(1, 1, At, B1); PG8_BAR; PG8_SCHED;
            } else {
            PG8_LDB(B0, 0, 0); PG8_SCHED; PG8_LDA(At, 0, 0); PG8_STAGE(PG8_SA(1, 1), a1 + hstep, voffA);
            PG8_WAIT_L(8); PG8_BAR; PG8_WAIT_L(0); PG8_MMA(0, 0, At, B0); PG8_BAR; PG8_SCHED;
            PG8_LDB(B1, 0, 1); PG8_STAGE(PG8_SB(0, 0), b2, voffB);
            PG8_BAR; PG8_WAIT_L(0); PG8_MMA(0, 1, At, B1); PG8_BAR;
            PG8_LDA(At, 0, 1); PG8_STAGE(PG8_SA(0, 0), a2, voffA);
            PG8_BAR; PG8_WAIT_L(0); PG8_MMA(1, 0, At, B0); PG8_BAR; PG8_SCHED;
            PG8_STAGE(PG8_SB(0, 1), b2 + hstep, voffB);
            PG8_WAIT_V(6); PG8_BAR; PG8_MMA(1, 1, At, B1); PG8_BAR;
            PG8_LDB(B0, 1, 0); PG8_SCHED; PG8_LDA(At, 1, 0); PG8_STAGE(PG8_SA(0, 1), a2 + hstep, voffA);
            PG8_WAIT_L(8); PG8_BAR; PG8_WAIT_L(0); PG8_MMA(0, 0, At, B0); PG8_BAR; PG8_SCHED;
            PG8_LDB(B1, 1, 1); PG8_STAGE(PG8_SB(1, 0), b3, voffB);
            PG8_BAR; PG8_WAIT_L(0); PG8_MMA(0, 1, At, B1); PG8_BAR;
            PG8_LDA(At, 1, 1); PG8_STAGE(PG8_SA(1, 0), a3, voffA);
            PG8_BAR; PG8_WAIT_L(0); PG8_MMA(1, 0, At, B0); PG8_BAR; PG8_SCHED;
            PG8_STAGE(PG8_SB(1, 1), b3 + hstep, voffB);
            PG8_WAIT_V(6); PG8_BAR; PG8_MMA(1, 1, At, B1); PG8_BAR;
            }
        }
        if constexpr (ALIGN_EPI) { if (wr == 0) PG8_BAR; }
        if constexpr (!Epi::AFTER_DRAIN) { E(acc, cur, wr, wc, fr, fq); S.done(cur); }
        if (!has_next) break;
#pragma unroll
        for (int a = 0; a < 2; ++a)
#pragma unroll
            for (int b = 0; b < 2; ++b)
#pragma unroll
                for (int m = 0; m < 4; ++m)
#pragma unroll
                    for (int n = 0; n < 2; ++n) acc[a][b][m][n] = (f32x4){0.f, 0.f, 0.f, 0.f};
        cur = nxt; cA = nA; cB = nB; nt = nnt; ++ui;
        if constexpr (ALIGN_EPI) { if (wr == 1) PG8_BAR; }
    }
    PG8_WAIT_V(0);
    if constexpr (!ALIGN_EPI) { if (wr == 0) PG8_BAR; }
    PG8_BAR;
    if constexpr (Epi::AFTER_DRAIN) { E.fused(acc, cur, wr, wc, fr, fq, lds, wid, lane); S.done(cur); }
#undef PG8_SA
#undef PG8_SB
#undef PG8_STAGE
#undef PG8_LDA
#undef PG8_LDB
#undef PG8_MMA
#undef PG8_WAIT_V
#undef PG8_WAIT_L
#undef PG8_BAR
#undef PG8_SCHED
}
}
#ifndef PG8_SP2
#define PG8_SP2 true
#endif
#ifndef PG8_ALIGN
#define PG8_ALIGN true
#endif
#ifndef PROBE_REP
#define PROBE_REP -1
#endif
#ifndef REP_A
#define REP_A 1
#endif
#ifndef STAGGER_US1
#define STAGGER_US1 7
#define STAGGER_US5 9
#endif
#ifndef REP_G1
#define REP_G1 1
#endif
#ifndef REP_G4
#define REP_G4 1
#endif
#ifndef REP_G5
#define REP_G5 1
#endif
#ifndef REP_P0
#define REP_P0 1
#endif
#ifndef REP_B
#define REP_B 1
#endif
#ifndef REP_C
#define REP_C 1
#endif
#ifndef PROBE_P2MASK
#define PROBE_P2MASK 0
#endif
#ifndef MK_N_LAUNCHES
#define MK_N_LAUNCHES 1
#endif

constexpr int D = 1024, FF = 4096, NIN = 3072;
constexpr int MP = 8 * 8192, MS = 128 * 8, M = MP + MS;
constexpr int TP = 8192;
constexpr float EPS = 1e-6f;
constexpr int NWAVES = 8;
#define GAS __attribute__((address_space(1)))
#define LAS __attribute__((address_space(3)))
typedef unsigned short bf16;
typedef unsigned v4u __attribute__((ext_vector_type(4)));
typedef unsigned v2u __attribute__((ext_vector_type(2)));
typedef float f32x4 __attribute__((ext_vector_type(4)));
typedef short bf16x8 __attribute__((ext_vector_type(8)));
typedef short s16x4 __attribute__((ext_vector_type(4)));
typedef float f32x16 __attribute__((ext_vector_type(16)));

constexpr size_t MiB = 1u << 20;
constexpr size_t WS_WIN = 0, WS_WOUT = 6 * MiB, WS_WUP = 8 * MiB, WS_WDN = 16 * MiB;
constexpr size_t WS_RSTD0 = 24 * MiB;
constexpr size_t WS_ST1 = 25 * MiB, WS_ST2 = 30 * MiB;
constexpr size_t WS_LSE = 35 * MiB;
constexpr size_t WS_XB = 40 * MiB;
constexpr size_t WS_PROJ = 172 * MiB;
constexpr size_t WS_MIX = 564 * MiB;
constexpr size_t WS_HB = 696 * MiB;
constexpr size_t WS_QKVP = 1220 * MiB;
constexpr size_t WS_PART = 1510 * MiB;
constexpr size_t WS_BAR = 38 * MiB + 512 * 1024, WS_BAR_BYTES = 16384;
constexpr size_t WS_CNT = 39 * MiB;
constexpr size_t WS_END = 1592 * MiB;
static_assert(WS_XB + (size_t)M * D * 2 <= WS_PROJ && WS_PROJ + (size_t)M * NIN * 2 <= WS_MIX && WS_MIX + (size_t)M * D * 2 <= WS_HB && WS_HB + (size_t)M * FF * 2 <= WS_END, "d_ws map");
static_assert(WS_ST1 + (size_t)M * 64 <= WS_ST2 && WS_ST2 + (size_t)M * 64 <= WS_LSE && WS_LSE + (size_t)M * 48 <= WS_XB, "d_ws map 2");

constexpr size_t O_Y = 0;
constexpr size_t O_KVP0 = (size_t)M * D;
constexpr size_t O_KVP1 = O_KVP0 + 8ull * 128 * 512;
constexpr size_t O_KVP2 = O_KVP1 + 8ull * 512 * 512;
constexpr size_t O_CVP = O_KVP2 + 8ull * 2048 * 512;
constexpr size_t O_KVS0 = O_CVP + 8ull * 2 * 256;
constexpr size_t O_KVS1 = O_KVS0 + 128ull * 128 * 512;
constexpr size_t O_KVS2 = O_KVS1 + 128ull * 512 * 512;
constexpr size_t O_CVS = O_KVS2 + 128ull * 2048 * 512;
constexpr size_t O_END = O_CVS + 128ull * 2 * 256;

constexpr int P6_SPLIT = 16;
constexpr int LDS_BYTES = 163840;

__device__ __forceinline__ unsigned f2bf(float f) { unsigned u = __builtin_bit_cast(unsigned, f); return (u + 0x7fffu + ((u >> 16) & 1u)) >> 16; }
__device__ __forceinline__ unsigned pk2(float lo, float hi) { return f2bf(lo) | (f2bf(hi) << 16); }
__device__ __forceinline__ float bflo(unsigned w) { return __builtin_bit_cast(float, w << 16); }
__device__ __forceinline__ float bfhi(unsigned w) { return __builtin_bit_cast(float, w & 0xffff0000u); }
__device__ __forceinline__ float wave_sum(float v) {
#pragma unroll
    for (int o = 1; o < 64; o <<= 1) v += __shfl_xor(v, o);
    return v;
}

__device__ __forceinline__ unsigned att_cvtpk(float lo, float hi) { typedef float f2 __attribute__((ext_vector_type(2))); typedef __bf16 b2 __attribute__((ext_vector_type(2))); f2 v = {lo, hi}; b2 b = __builtin_convertvector(v, b2); return __builtin_bit_cast(unsigned, b); }
__device__ __forceinline__ const float* pick3(int g, const float* a, const float* b, const float* c) { return g == 0 ? a : (g == 1 ? b : c); }
struct Frame {
    LAS unsigned char* lds;
    int tid, lane, wave, vcu, G;
    const float *xp, *xs, *c0, *c1, *c2, *sconv, *g_attn, *w_in, *conv_w, *w_out, *g_mlp, *w_up, *w_down, *g_fin;
    float* out;
    bf16 *Win_t, *Wout_t, *Wup_t, *Wdn_t, *XB, *PROJ, *MIX, *HB, *QKVP;
    float *RSTD0, *ST1, *ST2, *LSE, *PART; unsigned* CNT;
};

__device__ __forceinline__ void p0_transpose_item(const float* W, const float* gk, int K, int N, bf16* WT, LAS float* scr, int item, int lane) {
    const int nblk = N / 32, kb = item / nblk, nb = item % nblk, k0 = 64 * kb, n0 = 32 * nb;
#pragma unroll 8
    for (int i = 0; i < 32; ++i) { const int kk = 2 * i + (lane >> 5); float v = W[(size_t)(k0 + kk) * N + n0 + (lane & 31)]; if (gk) v *= gk[k0 + kk]; scr[kk * 33 + (lane & 31)] = v; }
    asm volatile("s_waitcnt lgkmcnt(0)" ::: "memory");
    const int c = lane & 7;
#pragma unroll
    for (int j = 0; j < 4; ++j) { const int n = (lane >> 3) + 8 * j; const LAS float* s = scr + (8 * c) * 33 + n;
        v4u o; o.x = pk2(s[0 * 33], s[1 * 33]); o.y = pk2(s[2 * 33], s[3 * 33]); o.z = pk2(s[4 * 33], s[5 * 33]); o.w = pk2(s[6 * 33], s[7 * 33]);
        *(v4u*)(WT + (size_t)(n0 + n) * K + k0 + 8 * c) = o; }
    asm volatile("s_waitcnt lgkmcnt(0)" ::: "memory");
}
__device__ __forceinline__ void p0_prologue(Frame& F) {
    LAS float* scr = (LAS float*)(F.lds + F.wave * 16384);
    const int gw = F.vcu * NWAVES + F.wave, NGW = F.G * NWAVES;
    constexpr int I_IN = (D / 64) * (NIN / 32), I_O = (D / 64) * (D / 32), I_UP = (D / 64) * (FF / 32), I_DN = (FF / 64) * (D / 32);
    constexpr int NITEMS = I_IN + I_O + I_UP + I_DN;
    int it = gw;
    for (int m0_ = gw * 4; m0_ < M || it < NITEMS; m0_ += NGW * 4) { const bool hr = m0_ < M; const int m0 = hr ? m0_ : 0;
        const float* xrow = m0 < MP ? F.xp + (size_t)m0 * D : F.xs + (size_t)(m0 - MP) * D;
        f32x4 v[4][4]; float s[4];
#pragma unroll
        for (int r = 0; r < 4; ++r)
#pragma unroll
            for (int j = 0; j < 4; ++j) v[r][j] = ((const f32x4*)(xrow + (size_t)r * D))[F.lane + 64 * j];
        if (it < NITEMS) { int r = it; it += NGW;
            if (r < I_IN) p0_transpose_item(F.w_in, F.g_attn, D, NIN, F.Win_t, scr, r, F.lane);
            else if ((r -= I_IN) < I_O) p0_transpose_item(F.w_out, nullptr, D, D, F.Wout_t, scr, r, F.lane);
            else if ((r -= I_O) < I_UP) p0_transpose_item(F.w_up, F.g_mlp, D, FF, F.Wup_t, scr, r, F.lane);
            else p0_transpose_item(F.w_down, nullptr, FF, D, F.Wdn_t, scr, r - I_UP, F.lane); }
        if (!hr) continue;
#pragma unroll
        for (int r = 0; r < 4; ++r) { float t = 0.f;
#pragma unroll
            for (int j = 0; j < 4; ++j) t += (v[r][j].x * v[r][j].x + v[r][j].y * v[r][j].y) + (v[r][j].z * v[r][j].z + v[r][j].w * v[r][j].w);
            s[r] = wave_sum(t); }
#pragma unroll
        for (int r = 0; r < 4; ++r) { v2u* o8 = (v2u*)(F.XB + (size_t)(m0 + r) * D) + F.lane;
#pragma unroll
            for (int j = 0; j < 4; ++j) { v2u w; w.x = att_cvtpk(v[r][j].x, v[r][j].y); w.y = att_cvtpk(v[r][j].z, v[r][j].w); o8[64 * j] = w; }
            if (F.lane == 0) F.RSTD0[m0 + r] = __builtin_amdgcn_rsqf(s[r] * (1.0f / D) + EPS); }
    }
}

namespace att {
constexpr int VP = 128;
constexpr int WTILE = 160 * VP;
constexpr float C2 = 0.125f * 1.4426950408889634f;
typedef __amdgpu_buffer_rsrc_t rsrc_t;
__device__ __forceinline__ rsrc_t mk_rsrc(const void* p) { return __builtin_amdgcn_make_buffer_rsrc((void*)p, 0, 0x7fffffff, 0x00020000); }
__device__ __forceinline__ v4u bld16(rsrc_t r, int voff, int soff) { return __builtin_amdgcn_raw_buffer_load_b128(r, voff, soff, 0); }
__device__ __forceinline__ v2u bld8(rsrc_t r, int voff, int soff) { return __builtin_amdgcn_raw_buffer_load_b64(r, voff, soff, 0); }
__device__ __forceinline__ int crow(int r, int hi) { return (r & 3) + 8 * (r >> 2) + 4 * hi; }
__device__ __forceinline__ s16x4 vtr(const LAS unsigned char* p) { return __builtin_bit_cast(s16x4, __builtin_amdgcn_ds_read_tr16_b64_v4i16((LAS s16x4*)p)); }
__device__ __forceinline__ unsigned cvtpk(float lo, float hi) { typedef float f2 __attribute__((ext_vector_type(2))); typedef __bf16 b2 __attribute__((ext_vector_type(2))); f2 v = {lo, hi}; b2 b = __builtin_convertvector(v, b2); return __builtin_bit_cast(unsigned, b); }

__device__ __forceinline__ void prompt_tile(const rsrc_t rp, bf16* __restrict__ mixed, float* __restrict__ lse, LAS unsigned char* wl, int b, int g, int h, int r, int j, int lane_in) {
    int lane = lane_in; asm volatile("" : "+v"(lane));
    const int a = lane & 31, hi = lane >> 5, s = 2 * g, qs = 32 * j, rowb = b * TP, colq = g * 256 + h * 64, l8 = lane >> 3, c8 = lane & 7;
    const int L = TP >> s, vo = lane * 16;
    const int bq = (((g * 4 + h) * 8 + b) * TP + r * L + qs) * 128, bk = bq + 3 * 4 * 8 * TP * 128 - 128 * 128, bv = bk + 3 * 4 * 8 * TP * 128;
    v4u qraw[4], kraw[20], va[12], vb[8];
#pragma unroll
    for (int i = 0; i < 4; ++i) qraw[i] = bld16(rp, vo, bq + i * 1024);
#pragma unroll
    for (int i = 0; i < 20; ++i) kraw[i] = bld16(rp, vo, bk + i * 1024);
    const int wsw = l8 * VP + ((c8 ^ l8) * 16), rsw = a * VP;
#pragma unroll
    for (int i = 0; i < 4; ++i) *(LAS v4u*)(wl + 8 * i * VP + wsw) = qraw[i];
    bf16x8 qf[4];
#pragma unroll
    for (int d0 = 0; d0 < 4; ++d0) qf[d0] = *(const LAS bf16x8*)(wl + rsw + (((2 * d0 + hi) ^ (a & 7)) * 16));
#pragma unroll
    for (int i = 0; i < 20; ++i) *(LAS v4u*)(wl + 8 * i * VP + wsw) = kraw[i];
    asm volatile("" ::: "memory");
#pragma unroll
    for (int i = 0; i < 12; ++i) va[i] = bld16(rp, vo, bv + i * 1024);
    f32x16 S[5];
#pragma unroll
    for (int kb = 0; kb < 5; ++kb) { f32x16 acc = {};
#pragma unroll
        for (int d0 = 0; d0 < 4; ++d0) { const bf16x8 kf = *(const LAS bf16x8*)(wl + 32 * kb * VP + rsw + (((2 * d0 + hi) ^ (a & 7)) * 16)); acc = __builtin_amdgcn_mfma_f32_32x32x16_bf16(kf, qf[d0], acc, 0, 0, 0); }
        S[kb] = acc; }
    asm volatile("" ::: "memory");
#pragma unroll
    for (int i = 0; i < 8; ++i) vb[i] = bld16(rp, vo, bv + (12 + i) * 1024);
    float mr = -INFINITY; float bias[5];
#pragma unroll
    for (int kb = 0; kb < 5; ++kb) { const bool bv = (qs - 128 + 32 * kb) >= 0; bias[kb] = bv ? 0.f : -INFINITY; float bm = -INFINITY;
#pragma unroll
        for (int rr = 0; rr < 16; ++rr) { const int key = crow(rr, hi); float v = S[kb][rr];
            if (kb == 0) { v = key >= a ? v : -INFINITY; S[kb][rr] = v; } if (kb == 4) { v = key <= a ? v : -INFINITY; S[kb][rr] = v; }
            bm = fmaxf(bm, v); }
        mr = bv ? fmaxf(mr, bm) : mr; }
    mr = fmaxf(mr, __shfl_xor(mr, 32));
    const float mxs = mr * C2;
    float l = 0.f; v4u pw[5][2];
#pragma unroll
    for (int kb = 0; kb < 5; ++kb) { const float nb = bias[kb] - mxs; float p[16];
#pragma unroll
        for (int rr = 0; rr < 16; ++rr) { p[rr] = __builtin_amdgcn_exp2f(__builtin_fmaf(S[kb][rr], C2, nb)); l += p[rr]; }
#pragma unroll
        for (int st = 0; st < 2; ++st) { pw[kb][st].x = cvtpk(p[8 * st + 0], p[8 * st + 1]); pw[kb][st].y = cvtpk(p[8 * st + 2], p[8 * st + 3]); pw[kb][st].z = cvtpk(p[8 * st + 4], p[8 * st + 5]); pw[kb][st].w = cvtpk(p[8 * st + 6], p[8 * st + 7]); } }
    l += __shfl_xor(l, 32);
#pragma unroll
    for (int i = 0; i < 12; ++i) *(LAS v4u*)(wl + (8 * i + l8) * VP + c8 * 16) = va[i];
    f32x16 o[2]; o[0] = f32x16{}; o[1] = f32x16{};
    const LAS unsigned char* vbase = wl + (4 * hi + ((lane & 15) >> 2)) * VP + (16 * ((lane >> 4) & 1) + 4 * (lane & 3)) * 2;
#pragma unroll
    for (int kb = 0; kb < 5; ++kb) {
        if (kb == 3) {
#pragma unroll
            for (int i = 0; i < 8; ++i) *(LAS v4u*)(wl + (96 + 8 * i + l8) * VP + c8 * 16) = vb[i]; }
#pragma unroll
        for (int st = 0; st < 2; ++st) {
            const bf16x8 pa = __builtin_bit_cast(bf16x8, pw[kb][st]);
#pragma unroll
            for (int cc = 0; cc < 2; ++cc) {
                const s16x4 lo = vtr(vbase + (32 * kb + 16 * st) * VP + cc * 64), hh = vtr(vbase + (32 * kb + 16 * st + 8) * VP + cc * 64);
                const bf16x8 vf = (bf16x8){lo[0], lo[1], lo[2], lo[3], hh[0], hh[1], hh[2], hh[3]};
                o[cc] = __builtin_amdgcn_mfma_f32_32x32x16_bf16(pa, vf, o[cc], 0, 0, 0);
            }
        }
    }
    const float linv = 1.0f / l;
#pragma unroll
    for (int rr = 0; rr < 16; ++rr) { const int q = crow(rr, hi); const float li = __shfl(linv, q);
        const unsigned w = cvtpk(o[0][rr] * li, o[1][rr] * li); LAS bf16* op = (LAS bf16*)(wl + q * VP) + a; op[0] = (bf16)(w & 0xffffu); op[32] = (bf16)(w >> 16); }
#pragma unroll
    for (int i = 0; i < 4; ++i) { const v4u ov = *(const LAS v4u*)(wl + (8 * i + l8) * VP + c8 * 16);
        *(v4u*)(mixed + (size_t)(rowb + ((qs + 8 * i + l8) << s) + r) * D + colq + c8 * 8) = ov; }
    if (hi == 0) lse[(size_t)(rowb + ((qs + a) << s) + r) * 12 + g * 4 + h] = mxs + __builtin_amdgcn_logf(l);
}

__device__ __forceinline__ f32x4 kv_row(const rsrc_t rc, const rsrc_t rp, bool maybe_new, int W, int b, int idx, int sel, int g, int h, int c) {
    if (maybe_new) { const bool nw = idx >= W; const int idc = nw ? W - 1 : idx;
        const f32x4 cv = __builtin_bit_cast(f32x4, bld16(rc, ((b * W + idc) * 2 + sel) * 1024 + (h * 64 + 4 * c) * 4, 0));
        const v2u pw = bld8(rp, (MP + b * 8 + (nw ? idx - W : 0)) * (NIN * 2) + (768 + sel * 768 + g * 256 + h * 64 + 4 * c) * 2, 0);
        const f32x4 pv = {bflo(pw.x), bfhi(pw.x), bflo(pw.y), bfhi(pw.y)};
        return nw ? pv : cv; }
    return __builtin_bit_cast(f32x4, bld16(rc, ((b * W + idx) * 2 + sel) * 1024 + (h * 64 + 4 * c) * 4, 0));
}
__device__ __forceinline__ void sample_group(Frame& F, const rsrc_t rp, int b, int g, int h, int t, const int lane_in, f32x4& o_out, float& lse_out, float* kvout) {
    int lane = lane_in; asm volatile("" : "+v"(lane));
    const int rg = lane >> 4, c = lane & 15;
    const int W = 128 << (2 * g), sh = 2 * g;
    const rsrc_t rc = mk_rsrc(pick3(g, F.c0, F.c1, F.c2));
    const int qrow = MP + b * 8 + t;
    f32x4 q; { const v2u w = bld8(rp, qrow * (NIN * 2) + (g * 256 + h * 64 + 4 * c) * 2, 0); q = (f32x4){bflo(w.x), bfhi(w.x), bflo(w.y), bfhi(w.y)}; }
    f32x4 kv[33]; float sc[33];
    const bool cpy = t < (1 << (g + (g > 0 ? 1 : 0)));
    const rsrc_t ro = mk_rsrc(kvout); const int vo0 = (((b * W + W + t - 8 - (rg << sh)) * 2) * 256 + h * 64 + 4 * c) * 4, vstr = (4 << sh) * 2048;
#pragma unroll
    for (int i0 = 0; i0 < 33; i0 += 33) {
        asm volatile("" ::: "memory");
#pragma unroll
        for (int i = i0; i < i0 + 33 && i < 33; ++i) { int j = 4 * i + rg; j = j > 128 ? 128 : j; kv[i] = kv_row(rc, rp, i < 2, W, b, W + t - (j << sh), 0, g, h, c); }
#pragma unroll
        for (int i = i0; i < i0 + 33 && i < 33; ++i) { float p = (kv[i][0] * q[0] + kv[i][1] * q[1]) + (kv[i][2] * q[2] + kv[i][3] * q[3]);
            p += __shfl_xor(p, 1); p += __shfl_xor(p, 2); p += __shfl_xor(p, 4); p += __shfl_xor(p, 8);
            sc[i] = (4 * i + rg) <= 128 ? p * C2 : -INFINITY;
            { const int j = 4 * i + rg, idx = W + t - (j << sh); if (cpy && j <= 128 && idx >= 8 && idx < W) __builtin_amdgcn_raw_buffer_store_b128(__builtin_bit_cast(v4u, kv[i]), ro, vo0 - i * vstr, 0, 0); } } }
    float mx = sc[0];
#pragma unroll
    for (int i = 1; i < 33; ++i) mx = fmaxf(mx, sc[i]);
    mx = fmaxf(mx, __shfl_xor(mx, 16)); mx = fmaxf(mx, __shfl_xor(mx, 32));
    float l = 0.f;
#pragma unroll
    for (int i = 0; i < 33; ++i) { sc[i] = __builtin_amdgcn_exp2f(sc[i] - mx); l += sc[i]; }
    l += __shfl_xor(l, 16); l += __shfl_xor(l, 32);
    f32x4 o = {0.f, 0.f, 0.f, 0.f};
#pragma unroll
    for (int i0 = 0; i0 < 33; i0 += 33) {
        asm volatile("" ::: "memory");
#pragma unroll
        for (int i = i0; i < i0 + 33 && i < 33; ++i) { int j = 4 * i + rg; j = j > 128 ? 128 : j; kv[i] = kv_row(rc, rp, i < 2, W, b, W + t - (j << sh), 1, g, h, c); }
#pragma unroll
        for (int i = i0; i < i0 + 33 && i < 33; ++i) { o += kv[i] * sc[i];
            const int j = 4 * i + rg, idx = W + t - (j << sh); if (cpy && j <= 128 && idx >= 8 && idx < W) __builtin_amdgcn_raw_buffer_store_b128(__builtin_bit_cast(v4u, kv[i]), ro, vo0 - i * vstr + 1024, 0, 0); } }
#pragma unroll
    for (int e = 0; e < 4; ++e) { float v = o[e]; v += __shfl_xor(v, 16); v += __shfl_xor(v, 32); o[e] = v; }
    const float li = 1.0f / l;
    o_out = o * li; lse_out = mx + __builtin_amdgcn_logf(l);
}
__device__ __forceinline__ void sample_step(Frame& F, const rsrc_t rp, int task, int g, const int lane) {
    const int t = task & 7, h = (task >> 3) & 3, b = task >> 5, rg = lane >> 4, c = lane & 15;
    float* scr = F.PART + (size_t)task * 1024;
    f32x4 o; float ls; sample_group(F, rp, b, g, h, t, lane, o, ls, F.out + (g == 0 ? O_KVS0 : (g == 1 ? O_KVS1 : O_KVS2)));
    if (g < 2) { ((f32x4*)scr)[g * 64 + lane] = o; scr[768 + g * 64 + lane] = ls; return; }
    f32x4 o0 = ((const f32x4*)scr)[lane], o1 = ((const f32x4*)scr)[64 + lane], o2 = o;
    const float l0 = scr[768 + lane], l1 = scr[768 + 64 + lane], l2 = ls;
    const float mx = fmaxf(l0, fmaxf(l1, l2)); const float e0 = __builtin_amdgcn_exp2f(l0 - mx), e1 = __builtin_amdgcn_exp2f(l1 - mx), e2 = __builtin_amdgcn_exp2f(l2 - mx);
    const float inv = 1.0f / (e0 + e1 + e2);
    o0 = o0 * (e0 * inv); o1 = o1 * (e1 * inv); o2 = o2 * (e2 * inv);
    if (rg == 0) { bf16* op = F.MIX + (size_t)(MP + b * 8 + t) * D + h * 64 + 4 * c; v2u w;
        w.x = cvtpk(o0[0], o0[1]); w.y = cvtpk(o0[2], o0[3]); *(v2u*)(op) = w;
        w.x = cvtpk(o1[0], o1[1]); w.y = cvtpk(o1[2], o1[3]); *(v2u*)(op + 256) = w;
        w.x = cvtpk(o2[0], o2[1]); w.y = cvtpk(o2[2], o2[3]); *(v2u*)(op + 512) = w; }
}
}

__device__ __forceinline__ void unpack8(const v4u w, float (&f)[8]) { f[0] = bflo(w.x); f[1] = bfhi(w.x); f[2] = bflo(w.y); f[3] = bfhi(w.y); f[4] = bflo(w.z); f[5] = bfhi(w.z); f[6] = bflo(w.w); f[7] = bfhi(w.w); }
__device__ __forceinline__ void conv_u(const bf16* proj, size_t row, int ch, float (&u)[8]) {
    float cf[8], hf[8]; unpack8(*(const v4u*)(proj + row * NIN + 2560 + 8 * ch), cf); unpack8(*(const v4u*)(proj + row * NIN + 2816 + 8 * ch), hf);
#pragma unroll
    for (int e = 0; e < 8; ++e) u[e] = cf[e] * hf[e];
}
__device__ __forceinline__ void ld8f(const float* p, float (&u)[8]) { const f32x4 a = *(const f32x4*)p, b = *(const f32x4*)(p + 4); u[0] = a[0]; u[1] = a[1]; u[2] = a[2]; u[3] = a[3]; u[4] = b[0]; u[5] = b[1]; u[6] = b[2]; u[7] = b[3]; }

__device__ __forceinline__ void conv_item(Frame& F, int it_in) {
    int it = it_in; asm volatile("" : "+v"(it));

        const int ch = it & 31, row0 = (it >> 5) * 4; const bool smp = row0 >= MP;
        const int t0 = smp ? ((row0 - MP) & 7) : (row0 & (TP - 1)), b = smp ? ((row0 - MP) >> 3) : (row0 >> 13);
        v4u cw[6], hw[6], bw[4];
#pragma unroll
        for (int k = 0; k < 6; ++k) { const int row = row0 - 2 + k; if (k >= 2 || t0 > 0) { cw[k] = *(const v4u*)(F.PROJ + (size_t)row * NIN + 2560 + 8 * ch); hw[k] = *(const v4u*)(F.PROJ + (size_t)row * NIN + 2816 + 8 * ch); } else { cw[k] = (v4u){0u, 0u, 0u, 0u}; hw[k] = cw[k]; } }
#pragma unroll
        for (int k = 0; k < 4; ++k) bw[k] = *(const v4u*)(F.PROJ + (size_t)(row0 + k) * NIN + 2304 + 8 * ch);
        float w0[8], w1[8], w2[8]; ld8f(F.conv_w + 8 * ch, w0); ld8f(F.conv_w + 256 + 8 * ch, w1); ld8f(F.conv_w + 512 + 8 * ch, w2);
        float u[6][8];
#pragma unroll
        for (int k = 0; k < 6; ++k) { float cf[8], hf[8]; unpack8(cw[k], cf); unpack8(hw[k], hf);
#pragma unroll
            for (int e = 0; e < 8; ++e) u[k][e] = cf[e] * hf[e]; }
        if (smp && t0 == 0) { ld8f(F.sconv + ((size_t)b * 2 + 0) * 256 + 8 * ch, u[0]); ld8f(F.sconv + ((size_t)b * 2 + 1) * 256 + 8 * ch, u[1]); }
#pragma unroll
        for (int k = 0; k < 4; ++k) { float bg[8], y[8]; unpack8(bw[k], bg);
#pragma unroll
            for (int e = 0; e < 8; ++e) y[e] = bg[e] * (w0[e] * u[k][e] + w1[e] * u[k + 1][e] + w2[e] * u[k + 2][e]);
            v4u o; o.x = att::cvtpk(y[0], y[1]); o.y = att::cvtpk(y[2], y[3]); o.z = att::cvtpk(y[4], y[5]); o.w = att::cvtpk(y[6], y[7]);
            *(v4u*)(F.MIX + (size_t)(row0 + k) * D + 768 + 8 * ch) = o; }
}
__device__ __forceinline__ void p2_mixers(Frame& F, const int mask) {
    int tid_ = F.tid; asm volatile("" : "+v"(tid_));
    const int lane_ = tid_ & 63;
    const int gt = F.vcu * (NWAVES * 64) + tid_, NGT = F.G * NWAVES * 64;
    const int gw = F.vcu * NWAVES + F.wave, NGW = F.G * NWAVES;
    const att::rsrc_t rp = att::mk_rsrc(F.PROJ), rq = att::mk_rsrc(F.QKVP);
    constexpr int NSTASK = 128 * 4 * 8; int sstep = 0; const int nsteps = gw < NSTASK ? 3 * ((NSTASK - gw + NGW - 1) / NGW) : 0;
    { LAS unsigned char* wl = F.lds + F.wave * att::WTILE;
      constexpr int NCONV = (M / 4) * 32; int cit = gt;
      for (int su = F.vcu; su < 512 || sstep < nsteps || cit < NCONV; su += F.G) { const bool has_su = su < 512; const int b = su >> 6, h = (su >> 4) & 3, rg = su & 15;
#pragma unroll 1
        for (int i = 0; i < 6; ++i) { const int k = F.wave + 8 * i, g = k >> 4, kk = k & 15, tpr = 16 >> (2 * g), r = kk / tpr, j = rg * tpr + kk % tpr;
            if (has_su) att::prompt_tile(rq, F.MIX, F.LSE, wl, b, g, h, r, j, lane_);
            if (!(i & 1) && cit < NCONV) { conv_item(F, cit); cit += NGT; }
            if ((i & 1) && sstep < nsteps) { att::sample_step(F, rp, gw + (sstep / 3) * NGW, sstep % 3, lane_); ++sstep; } }
        if (!has_su) continue;
        asm volatile("s_waitcnt vmcnt(0)" ::: "memory"); __syncthreads(); __builtin_amdgcn_fence(__ATOMIC_ACQUIRE, "workgroup");
        const size_t row0 = (size_t)b * TP + rg * 512;
#pragma unroll 1
        for (int i0 = 0; i0 < 8; i0 += 4) { float ls[4][3]; v4u mw[4][3];
#pragma unroll
            for (int k = 0; k < 4; ++k) { const int it = tid_ + 512 * (i0 + k), ch = it & 7; const size_t row = row0 + (it >> 3);
#pragma unroll
                for (int g = 0; g < 3; ++g) { ls[k][g] = F.LSE[row * 12 + 4 * g + h]; mw[k][g] = *(const v4u*)(F.MIX + row * D + g * 256 + h * 64 + 8 * ch); } }
#pragma unroll
            for (int k = 0; k < 4; ++k) { const int it = tid_ + 512 * (i0 + k), ch = it & 7; const size_t row = row0 + (it >> 3);
                const float mx = fmaxf(ls[k][0], fmaxf(ls[k][1], ls[k][2])); const float e0 = __builtin_amdgcn_exp2f(ls[k][0] - mx), e1 = __builtin_amdgcn_exp2f(ls[k][1] - mx), e2 = __builtin_amdgcn_exp2f(ls[k][2] - mx);
                const float inv = 1.0f / (e0 + e1 + e2); const float al[3] = {e0 * inv, e1 * inv, e2 * inv};
#pragma unroll
                for (int g = 0; g < 3; ++g) { float f[8]; unpack8(mw[k][g], f);
                    v4u o; o.x = att::cvtpk(f[0] * al[g], f[1] * al[g]); o.y = att::cvtpk(f[2] * al[g], f[3] * al[g]); o.z = att::cvtpk(f[4] * al[g], f[5] * al[g]); o.w = att::cvtpk(f[6] * al[g], f[7] * al[g]);
                    *(v4u*)(F.MIX + row * D + g * 256 + h * 64 + 8 * ch) = o; } }
        }
      } }
    if (mask & 8) for (int g = 0; g < 3; ++g) {
        const int W = 128 << (2 * g); float* dst = F.out + (g == 0 ? O_KVP0 : (g == 1 ? O_KVP1 : O_KVP2));
        { const int NK = 8 * W * 64;
          for (int it0 = gt; it0 < NK; it0 += 4 * NGT) { v4u w[4];
#pragma unroll
            for (int k = 0; k < 4; ++k) { const int it = it0 + k * NGT; if (it < NK) { const int ch = it & 31, sel = (it >> 5) & 1, br = it >> 6, rr = br % W, b = br / W;
                const int t = TP - W + rr, sh = 2 * g, prow = (t & ((1 << sh) - 1)) * (TP >> sh) + (t >> sh);
                w[k] = *(const v4u*)(F.QKVP + ((size_t)(((((1 + sel) * 3 + g) * 4 + (ch >> 3)) * 8 + b) * TP + prow)) * 64 + 8 * (ch & 7)); } }
#pragma unroll
            for (int k = 0; k < 4; ++k) { const int it = it0 + k * NGT; if (it < NK) { float f[8]; unpack8(w[k], f);
                float* o = dst + (size_t)it * 8; *(f32x4*)o = (f32x4){f[0], f[1], f[2], f[3]}; *(f32x4*)(o + 4) = (f32x4){f[4], f[5], f[6], f[7]}; } } } }
        float* dsts = F.out + (g == 0 ? O_KVS0 : (g == 1 ? O_KVS1 : O_KVS2));
        for (int it = gt; it < 128 * 8 * 64; it += NGT) { const int ch = it & 31, sel = (it >> 5) & 1, bt = it >> 6, t = bt & 7, b = bt >> 3;
            float f[8]; unpack8(*(const v4u*)(F.PROJ + ((size_t)MP + b * 8 + t) * NIN + 768 + sel * 768 + g * 256 + 8 * ch), f);
            float* o = dsts + (((size_t)b * W + (W - 8 + t)) * 2 + sel) * 256 + 8 * ch; *(f32x4*)o = (f32x4){f[0], f[1], f[2], f[3]}; *(f32x4*)(o + 4) = (f32x4){f[4], f[5], f[6], f[7]}; }
    }
    for (int it = gt; it < 8 * 2 * 32; it += NGT) { const int ch = it & 31, j = (it >> 5) & 1, b = it >> 6; float u[8]; conv_u(F.PROJ, (size_t)b * TP + TP - 2 + j, ch, u);
        float* o = F.out + O_CVP + (size_t)it * 8; *(f32x4*)o = (f32x4){u[0], u[1], u[2], u[3]}; *(f32x4*)(o + 4) = (f32x4){u[4], u[5], u[6], u[7]}; }
    for (int it = gt; it < 128 * 2 * 32; it += NGT) { const int ch = it & 31, j = (it >> 5) & 1, b = it >> 6; float u[8]; conv_u(F.PROJ, (size_t)MP + b * 8 + 6 + j, ch, u);
        float* o = F.out + O_CVS + (size_t)it * 8; *(f32x4*)o = (f32x4){u[0], u[1], u[2], u[3]}; *(f32x4*)(o + 4) = (f32x4){u[4], u[5], u[6], u[7]}; }
}
__device__ __forceinline__ void p6_final(Frame& F) {
    const int gw = F.vcu * NWAVES + F.wave, NGW = F.G * NWAVES;
    f32x4 gf[4];
#pragma unroll
    for (int j = 0; j < 4; ++j) gf[j] = ((const f32x4*)F.g_fin)[2 * (F.lane + 64 * (j >> 1)) + (j & 1)];
    for (int m0 = gw * 4; m0 < M; m0 += NGW * 4) {
        float sp[4]; v4u v[4][2];
#pragma unroll
        for (int r = 0; r < 4; ++r) sp[r] = F.ST2[(size_t)(m0 + r) * 16 + (F.lane & 15)];
#pragma unroll
        for (int r = 0; r < 4; ++r)
#pragma unroll
            for (int j = 0; j < 2; ++j) v[r][j] = ((const v4u*)(F.MIX + (size_t)(m0 + r) * D))[F.lane + 64 * j];
#pragma unroll
        for (int r = 0; r < 4; ++r) { float ss = sp[r]; ss += __shfl_xor(ss, 1); ss += __shfl_xor(ss, 2); ss += __shfl_xor(ss, 4); ss += __shfl_xor(ss, 8);
            const float rstd = __builtin_amdgcn_rsqf(ss * (1.0f / D) + EPS);
#pragma unroll
            for (int j = 0; j < 2; ++j) { float f[8]; unpack8(v[r][j], f); f32x4* o = (f32x4*)(F.out + (size_t)(m0 + r) * D) + 2 * (F.lane + 64 * j);
                o[0] = (f32x4){f[0], f[1], f[2], f[3]} * rstd * gf[2 * j]; o[1] = (f32x4){f[4], f[5], f[6], f[7]} * rstd * gf[2 * j + 1]; } }
    }
}

__device__ __forceinline__ void p6_tail_reduce(Frame& F, const pg8::StaticOrder& S0, const int nfull, const int split) {
    const int gt = F.vcu * (NWAVES * 64) + F.tid, NGT = F.G * NWAVES * 64; const int ntail = S0.nwg - nfull;
    for (int it = gt; it < ntail * 256 * 32; it += NGT) {
        const int ch = it & 31, rw = (it >> 5) & 255, ti = it >> 13; pg8::Unit u; S0.tile(nfull + ti, u);
        const float* p = F.PART + (size_t)ti * split * 65536 + rw * 256 + ch * 8;
        f32x4 s0 = {0.f, 0.f, 0.f, 0.f}, s1 = s0;
#pragma unroll 1
        for (int k0 = 0; k0 < split; k0 += 8) { f32x4 a[8], b[8];
#pragma unroll
            for (int k = 0; k < 8; ++k) { const int kk = k0 + k < split ? k0 + k : 0; a[k] = *(const f32x4*)(p + (size_t)kk * 65536); b[k] = *(const f32x4*)(p + (size_t)kk * 65536 + 4); }
#pragma unroll
            for (int k = 0; k < 8; ++k) if (k0 + k < split) { s0 += a[k]; s1 += b[k]; } }
        const size_t row = (size_t)u.pm * 256 + rw; const size_t off = row * D + u.pn * 256 + ch * 8;
        float xr[8]; unpack8(*(const v4u*)(F.XB + off), xr);
        float o[8] = {s0[0] + xr[0], s0[1] + xr[1], s0[2] + xr[2], s0[3] + xr[3], s1[0] + xr[4], s1[1] + xr[5], s1[2] + xr[6], s1[3] + xr[7]};
        v4u w; w.x = att::cvtpk(o[0], o[1]); w.y = att::cvtpk(o[2], o[3]); w.z = att::cvtpk(o[4], o[5]); w.w = att::cvtpk(o[6], o[7]);
        *(v4u*)(F.MIX + off) = w;
        float ss = ((o[0] * o[0] + o[1] * o[1]) + (o[2] * o[2] + o[3] * o[3])) + ((o[4] * o[4] + o[5] * o[5]) + (o[6] * o[6] + o[7] * o[7]));
        ss += __shfl_xor(ss, 1); ss += __shfl_xor(ss, 2); ss += __shfl_xor(ss, 4); ss += __shfl_xor(ss, 8); ss += __shfl_xor(ss, 16);
        if (ch < 4) F.ST2[row * 16 + u.pn * 4 + ch] = ch == 0 ? ss : 0.f;
    }
}
__device__ __forceinline__ void tail_copy(Frame& F, int first, int count, int n_busy) {
    const int bid = (int)blockIdx.x; if (bid < n_busy) return;
    const int rank = bid - n_busy, nidle = F.G - n_busy, toff = F.tid * 16;
    const __amdgpu_buffer_rsrc_t rs_ = __builtin_amdgcn_make_buffer_rsrc((void*)F.c2, 0, 0x7fffffff, 0x00020000), rd_ = __builtin_amdgcn_make_buffer_rsrc((void*)(F.out + O_KVS2), 0, 0x7fffffff, 0x00020000);
    for (int k0 = rank * 4; k0 < count; k0 += nidle * 4) {
        v4u cp[8]; int dof[4];
#pragma unroll
        for (int k = 0; k < 4; ++k) { int blk = first + (k0 + k < count ? k0 + k : count - 1); blk = blk >= pg8::CP_NBLK ? pg8::CP_NBLK - 1 : blk; const int b = blk >> 7, q = blk & 127; dof[k] = ((b * 2048 + 16 * q) * 512) * 4;
            cp[2 * k] = __builtin_amdgcn_raw_buffer_load_b128(rs_, toff, dof[k] + 16384, 2); cp[2 * k + 1] = __builtin_amdgcn_raw_buffer_load_b128(rs_, toff, dof[k] + 16384 + 8192, 2); }
#pragma unroll
        for (int k = 0; k < 4; ++k) { __builtin_amdgcn_raw_buffer_store_b128(cp[2 * k], rd_, toff, dof[k], 2); __builtin_amdgcn_raw_buffer_store_b128(cp[2 * k + 1], rd_, toff, dof[k] + 8192, 2); }
    }
}
__device__ __forceinline__ void stagger_start(int us) {
    const unsigned long long t0 = __builtin_amdgcn_s_memrealtime(), dt = (unsigned long long)(((blockIdx.x >> 3) & 3) * us * 100);
    while (__builtin_amdgcn_s_memrealtime() - t0 < dt) __builtin_amdgcn_s_sleep(16);
}
#define XB_TMO      128
#define XB_XCNT(j)  (256  + 64 * (j))
#define XB_XSUB(j)  (1280 + 64 * (j))
#define XB_XGEN(j)  (2304 + 64 * (j))
#define XB_TOP      3328
#define XB_TOPGEN   3392
#define XCD_BAR_WORDS 3456
#define XB_SPIN_CAP (1u << 18)
__device__ __forceinline__ unsigned xb_ld(unsigned* p)              { return __hip_atomic_load(p, __ATOMIC_RELAXED, __HIP_MEMORY_SCOPE_AGENT); }
__device__ __forceinline__ unsigned xb_add(unsigned* p, unsigned v) { return __hip_atomic_fetch_add(p, v, __ATOMIC_RELAXED, __HIP_MEMORY_SCOPE_AGENT); }
__device__ __forceinline__ unsigned xb_xcc_id() { return (unsigned)__builtin_amdgcn_s_getreg((3 << 11) | 20) & 0xFu; }
#define XB_SPIN(cond, bar) do { unsigned _sp = 0; while (cond) { __builtin_amdgcn_s_sleep(1); \
    if ((++_sp & 255u) == 0u) { if (xb_ld(&(bar)[XB_TMO])) break; if (_sp > XB_SPIN_CAP) { atomicAdd(&(bar)[XB_TMO], 1u); break; } } } } while (0)
struct XcdBarrier { unsigned* bar; unsigned x, nloc, nx; };
__device__ __forceinline__ void xcd_barrier_complete(unsigned* bar, unsigned x, unsigned& nloc, unsigned& nx) {
    const unsigned G = gridDim.x * gridDim.y * gridDim.z;
    unsigned sum, cnt, mine, sp = 0u;
    for (;;) {
        sum = 0u; cnt = 0u; mine = 0u;
#pragma unroll
        for (unsigned j = 0; j < 16; ++j) { const unsigned c = xb_ld(&bar[XB_XCNT(j)]); sum += c; cnt += (c > 0u) ? 1u : 0u; mine = (j == x) ? c : mine; }
        if (sum == G) break;
        __builtin_amdgcn_s_sleep(1);
        if ((++sp & 255u) == 0u) { if (xb_ld(&bar[XB_TMO])) break; if (sp > XB_SPIN_CAP) { atomicAdd(&bar[XB_TMO], 1u); break; } }
    }
    nloc = mine > 0u ? mine : 1u; nx = cnt > 0u ? cnt : 1u;
}
__device__ __forceinline__ void xcd_barrier(XcdBarrier& b) {
    asm volatile("s_waitcnt vmcnt(0)" ::: "memory");
    __syncthreads();
    if (threadIdx.x == 0) {
        unsigned* bar = b.bar;
        __builtin_amdgcn_s_waitcnt(0);
        if (b.nloc == 0u) xcd_barrier_complete(bar, b.x, b.nloc, b.nx);
        const unsigned nloc = b.nloc, nx = b.nx;
        const unsigned old = xb_add(&bar[XB_XSUB(b.x)], 1u);
        const unsigned gen = old / nloc;
        if (old + 1u == (gen + 1u) * nloc) {
            __builtin_amdgcn_fence(__ATOMIC_RELEASE, "agent");
            asm volatile("s_waitcnt vmcnt(0)" ::: "memory");
            const unsigned og = xb_add(&bar[XB_TOP], 1u);
            const unsigned tg = og / nx;
            if (og + 1u == (tg + 1u) * nx) xb_add(&bar[XB_TOPGEN], 1u);
            else XB_SPIN(xb_ld(&bar[XB_TOPGEN]) == tg, bar);
            __builtin_amdgcn_fence(__ATOMIC_ACQUIRE, "agent");
            xb_add(&bar[XB_XGEN(b.x)], 1u);
            asm volatile("s_waitcnt vmcnt(0)" ::: "memory");
        } else {
            XB_SPIN(xb_ld(&bar[XB_XGEN(b.x)]) == gen, bar);
            __builtin_amdgcn_fence(__ATOMIC_ACQUIRE, "agent");
            asm volatile("s_waitcnt vmcnt(0)" ::: "memory");
        }
    }
    __syncthreads();
}
struct Args { const float* in[14]; float* out; unsigned char* ws; int ph_lo, ph_hi, probe, pad; };
__global__ void __launch_bounds__(NWAVES * 64, 2) mega_fwd(Args args) {
    extern __shared__ __attribute__((aligned(16))) unsigned char lds[];
    cg::grid_group grid = cg::this_grid();
    Frame F;
    F.lds = (LAS unsigned char*)lds;
    F.tid = threadIdx.x; F.lane = F.tid & 63; F.wave = __builtin_amdgcn_readfirstlane(F.tid >> 6);
    F.G = gridDim.x; { const int bx = blockIdx.x; F.vcu = (F.G % 8 == 0) ? (bx % 8) * (F.G / 8) + bx / 8 : bx; }
    unsigned char* ws = args.ws;
    F.xp = args.in[0]; F.xs = args.in[1]; F.c0 = args.in[2]; F.c1 = args.in[3]; F.c2 = args.in[4]; F.sconv = args.in[5]; F.g_attn = args.in[6]; F.w_in = args.in[7];
    F.conv_w = args.in[8]; F.w_out = args.in[9]; F.g_mlp = args.in[10]; F.w_up = args.in[11]; F.w_down = args.in[12]; F.g_fin = args.in[13]; F.out = args.out;
    F.Win_t = (bf16*)(ws + WS_WIN); F.Wout_t = (bf16*)(ws + WS_WOUT); F.Wup_t = (bf16*)(ws + WS_WUP); F.Wdn_t = (bf16*)(ws + WS_WDN);
    F.XB = (bf16*)(ws + WS_XB); F.PROJ = (bf16*)(ws + WS_PROJ); F.MIX = (bf16*)(ws + WS_MIX); F.HB = (bf16*)(ws + WS_HB); F.QKVP = (bf16*)(ws + WS_QKVP);
    F.RSTD0 = (float*)(ws + WS_RSTD0); F.ST1 = (float*)(ws + WS_ST1); F.ST2 = (float*)(ws + WS_ST2); F.LSE = (float*)(ws + WS_LSE); F.PART = (float*)(ws + WS_PART); F.PART = (float*)(ws + WS_PART); F.CNT = (unsigned*)(ws + WS_CNT);
    const int lo = args.ph_lo, hi = args.ph_hi;
    XcdBarrier xbar; xbar.bar = (unsigned*)(ws + WS_BAR); xbar.x = xb_xcc_id(); xbar.nloc = 0u; xbar.nx = 0u;
    if (hi - lo > 1 && threadIdx.x == 0) (void)xb_add(&xbar.bar[XB_XCNT(xbar.x)], 1u);
#define IN(k) (lo <= (k) && (k) < hi)
#define SEAM(k) do { if (IN(k) && IN((k) + 1)) xcd_barrier(xbar); } while (0)
    if (args.probe == 0x7fffffff) grid.sync();

    if (IN(0)) { p0_prologue(F); if (PROBE_REP == 0) p0_prologue(F); }
    SEAM(0);
    if (IN(1)) {
        pg8::Gemm g{F.XB, F.Win_t, M, NIN, D}; pg8::StaticOrder S; S.init(M, NIN, F.G, (int)blockIdx.x, REP_G1);
        pg8::EpiScaleBf16<0> E{F.PROJ, NIN, F.RSTD0, EPS, pg8::CopyJob{nullptr, nullptr, 0}, F.QKVP, MP};
        pg8::gemm_phase<pg8::EpiScaleBf16<0>, pg8::StaticOrder, PG8_ALIGN, PG8_SP2>(F.lds, g, S, E);
        tail_copy(F, 0, 4608, S.nwg % F.G);
    }
    SEAM(1);
    if (IN(2)) p2_mixers(F, 15);
    SEAM(2);
    if (IN(4)) {
        pg8::Gemm g{F.MIX, F.Wout_t, M, D, D}; pg8::StaticOrder S; S.init(M, D, F.G, (int)blockIdx.x, REP_G4);
        pg8::EpiResBf16 E{F.XB, F.XB, F.ST1};
        pg8::gemm_phase<pg8::EpiResBf16, pg8::StaticOrder, PG8_ALIGN, PG8_SP2>(F.lds, g, S, E);
        tail_copy(F, 4608, 6720, S.nwg % F.G);
    }
    SEAM(4);
    if (IN(5)) {
        pg8::Gemm g{F.XB, F.Wup_t, M, FF, D}; pg8::StaticOrder S; S.init(M, FF, F.G, (int)blockIdx.x, REP_G5);
        pg8::EpiScaleBf16<1> E{F.HB, FF, F.ST1, EPS, pg8::CopyJob{F.c2, F.out + O_KVS2, 0}, nullptr, 0};
        pg8::gemm_phase<pg8::EpiScaleBf16<1>, pg8::StaticOrder, PG8_ALIGN, PG8_SP2>(F.lds, g, S, E);
        tail_copy(F, 4608 + 6720, pg8::CP_NBLK - 4608 - 6720, S.nwg % F.G);
    }
    SEAM(5);
    if (IN(6)) {
        constexpr int NWG6 = (M / 256) * (D / 256);
        int nfull = (NWG6 / F.G) * F.G, ntail = NWG6 - nfull, split = P6_SPLIT; const int cap = F.G < 256 ? F.G : 256;
        while (split > 1 && ntail * split > cap) split >>= 1;
        if (ntail * split > cap || hi - lo == 1) { nfull = NWG6; ntail = 0; }
        pg8::Gemm g{F.HB, F.Wdn_t, M, D, FF}; pg8::StaticOrder S; S.init(M, D, F.G, (int)blockIdx.x, 1, nfull);
        pg8::EpiResBf16 E{F.XB, F.MIX, F.ST2};
        pg8::gemm_phase<pg8::EpiResBf16, pg8::StaticOrder, PG8_ALIGN, PG8_SP2>(F.lds, g, S, E);
        if (ntail > 0) {
            pg8::StaticOrder S0; S0.init(M, D, F.G, (int)blockIdx.x); const pg8::TailOrder T{S0, nfull, split};
            pg8::EpiPartial EP{F.PART, nfull};
            pg8::gemm_phase<pg8::EpiPartial, pg8::TailOrder, PG8_ALIGN, PG8_SP2>(F.lds, g, T, EP);
            xcd_barrier(xbar);
            p6_tail_reduce(F, S0, nfull, split);
        }
    }
    SEAM(6);
    if (IN(7)) p6_final(F);
#undef IN
#undef SEAM
}

extern "C" void kernel_launch(void* const* d_in, const int* in_sizes, int n_in, void* d_out, int out_size, void* d_ws, size_t ws_size, hipStream_t stream) {
    static int grid = 0;
    if (grid == 0) {
        if (n_in != 14 || in_sizes[0] != MP * D || (size_t)out_size != O_END || ws_size < WS_END) { fprintf(stderr, "kernel_launch: unexpected shapes (n_in %d, in0 %d, out %d, ws %zu); nothing launched\n", n_in, n_in > 0 ? in_sizes[0] : -1, out_size, ws_size); grid = -1; return; }
        int dev = 0, cus = 0, per_cu = 0;
        if (hipGetDevice(&dev) != hipSuccess || hipDeviceGetAttribute(&cus, hipDeviceAttributeMultiprocessorCount, dev) != hipSuccess) { grid = -1; return; }
        if (hipFuncSetAttribute((const void*)mega_fwd, hipFuncAttributeMaxDynamicSharedMemorySize, LDS_BYTES) != hipSuccess) { fprintf(stderr, "kernel_launch: hipFuncSetAttribute failed\n"); grid = -1; return; }
        if (hipOccupancyMaxActiveBlocksPerMultiprocessor(&per_cu, (const void*)mega_fwd, NWAVES * 64, LDS_BYTES) != hipSuccess || per_cu < 1) { fprintf(stderr, "kernel_launch: occupancy query failed (%d)\n", per_cu); (void)hipGetLastError(); grid = -1; return; }
        grid = cus;
    }
    if (grid < 0) return;
    Args a{};
    for (int i = 0; i < 14; ++i) a.in[i] = (const float*)d_in[i];
    a.out = (float*)d_out; a.ws = (unsigned char*)d_ws; a.probe = PROBE_P2MASK;
    if (MK_N_LAUNCHES == 1) {
        if (hipMemsetAsync((char*)d_ws + WS_BAR, 0, WS_BAR_BYTES, stream) != hipSuccess) { fprintf(stderr, "kernel_launch: hipMemsetAsync of the barrier words failed\n"); return; }
        a.ph_lo = 0; a.ph_hi = 8;
        void* kargs[] = {&a};
        const hipError_t e = hipLaunchCooperativeKernel((const void*)mega_fwd, dim3(grid), dim3(NWAVES * 64), kargs, LDS_BYTES, stream);
        if (e != hipSuccess) fprintf(stderr, "kernel_launch: cooperative launch failed: %s (grid %d)\n", hipGetErrorString(e), grid);
    } else {
        for (int p = 0; p < 8; ++p) { a.ph_lo = p; a.ph_hi = p + 1; hipLaunchKernelGGL(mega_fwd, dim3(grid), dim3(NWAVES * 64), LDS_BYTES, stream, a); }
    }
}
```
